# Optimizing an MI355X kernel written in HIP

```python
import jax, jax.numpy as jnp
from jax import lax
import numpy as np

D_MODEL = 1024
BATCH = 2
SEQ = 8192
DEPTH = 2
DEC_BATCH = 32
DEC_SEQ = 64
PAST_LEN = 1024

CHUNK = 64
Q_BLOCK = 128
A_HEADS = 4
A_HEAD_DIM = 128
A_WIDTH = A_HEADS * A_HEAD_DIM
B_HEADS = 4
B_HEAD_DIM = 64
B_WIDTH = B_HEADS * B_HEAD_DIM
C_GROUPS = 4
C_GROUP_DIM = 64
C_WIDTH = C_GROUPS * C_GROUP_DIM
POOL_WINDOWS = (2, 4, 8, 16)
POOL_STATE = 15
D_MIX = A_WIDTH + B_WIDTH + C_WIDTH
SPLIT_SIZES = (A_WIDTH, A_WIDTH, A_WIDTH, A_WIDTH, B_WIDTH, B_WIDTH, B_WIDTH, B_WIDTH, C_WIDTH, C_WIDTH)
D_IN = 4 * A_WIDTH + 4 * B_WIDTH + 2 * C_WIDTH
N_MEM = 256
X_HEADS = 4
X_HEAD_DIM = D_MODEL // X_HEADS
EPS = 1e-6

kernel_name = 'hybrid_stream_encoder_step'

F32 = jnp.float32


def rms_norm(x, g):
    xf = x.astype(F32)
    y = xf * lax.rsqrt(jnp.mean(xf * xf, axis=-1, keepdims=True) + EPS)
    return (y * g.astype(F32)).astype(x.dtype)


def hgrn2_scan(q, k, v, g, s0):
    bsz, L, H, _ = q.shape
    c = L if L <= CHUNK else CHUNK
    n = L // c
    causal = jnp.tril(jnp.ones((c, c), dtype=bool))[None, :, :, None, None]

    def to_chunks(t):
        return jnp.moveaxis(t.reshape(bsz, n, c, H, t.shape[-1]), 1, 0)

    def step(s, inp):
        qc, kc, vc, gc = inp
        G = jnp.cumsum(gc, axis=1)
        o = jnp.einsum('bthk,bhkv->bthv', qc * jnp.exp(G), s)
        diff = G[:, :, None] - G[:, None, :]
        decay = jnp.exp(jnp.where(causal, diff, -jnp.inf))
        att = jnp.einsum('bthk,btshk,bshk->bhts', qc, decay, kc)
        o = o + jnp.einsum('bhts,bshv->bthv', att, vc)
        GL = G[:, -1]
        s_new = jnp.exp(GL)[..., None] * s + jnp.einsum('bshk,bshv->bhkv', kc * jnp.exp(GL[:, None] - G), vc)
        return s_new, o

    s_fin, o = lax.scan(step, s0, (to_chunks(q), to_chunks(k), to_chunks(v), to_chunks(g)))
    return jnp.moveaxis(o, 0, 1).reshape(bsz, L, H, -1), s_fin


def sb_block(q, q_pos, k, v, k_pos):
    z = jnp.einsum('bqhd,bkhd->bhqk', q, k).astype(F32) * (B_HEAD_DIM ** -0.5)
    mask = (k_pos[None, :] < q_pos[:, None])[None, None]
    log_1m = jnp.where(mask, jax.nn.log_sigmoid(-z), 0.0)
    after = lax.cumsum(log_1m, axis=3, reverse=True) - log_1m
    w = jnp.where(mask, jnp.exp(jax.nn.log_sigmoid(z) + after), 0.0)
    return jnp.einsum('bhqk,bkhd->bqhd', w.astype(v.dtype), v)


def sb_attention(q, k, v, q_pos, k_pos):
    bsz, Lq, H, D = q.shape
    if Lq <= Q_BLOCK:
        return sb_block(q, q_pos, k, v, k_pos)
    nb = Lq // Q_BLOCK
    qb = jnp.moveaxis(q.reshape(bsz, nb, Q_BLOCK, H, D), 1, 0)
    pb = q_pos.reshape(nb, Q_BLOCK)
    ob = lax.map(lambda a: sb_block(a[0], a[1], k, v, k_pos), (qb, pb))
    return jnp.moveaxis(ob, 0, 1).reshape(bsz, Lq, H, D)


def pool_mix(u, prev, pos0, w_pool, pool_scale):
    bsz, L, _ = u.shape
    ext = jnp.concatenate([prev, u], axis=1)
    ef = ext.astype(F32)
    P = jnp.concatenate([jnp.zeros((bsz, 1, C_WIDTH), F32), jnp.cumsum(ef, axis=1)], axis=1)
    pos = pos0 + jnp.arange(L)
    outs = []
    for gi, w in enumerate(POOL_WINDOWS):
        lo_c, hi_c = gi * C_GROUP_DIM, (gi + 1) * C_GROUP_DIM
        hi = P[:, POOL_STATE + 1:POOL_STATE + 1 + L, lo_c:hi_c]
        lo = P[:, POOL_STATE + 1 - w:POOL_STATE + 1 - w + L, lo_c:hi_c]
        cnt = jnp.minimum(pos + 1, w).astype(F32)[None, :, None]
        outs.append((hi - lo) / cnt - ef[:, POOL_STATE:, lo_c:hi_c])
    d = jnp.concatenate(outs, axis=-1).reshape(bsz, L, C_GROUPS, C_GROUP_DIM)
    y = jnp.einsum('blgc,gcd->blgd', d, w_pool.astype(F32)).reshape(bsz, L, C_WIDTH) * pool_scale.astype(F32)
    return y.astype(u.dtype), ext[:, -POOL_STATE:]


def mem_kv(mem, g, w_k, w_v):
    bsz = mem.shape[0]
    m = rms_norm(mem, g)
    return ((m @ w_k).reshape(bsz, N_MEM, X_HEADS, X_HEAD_DIM),
            (m @ w_v).reshape(bsz, N_MEM, X_HEADS, X_HEAD_DIM))


def cross_attn(h, mem_k, mem_v, w_q, w_o):
    bsz, L, _ = h.shape
    q = (h @ w_q).reshape(bsz, L, X_HEADS, X_HEAD_DIM)
    s = jnp.einsum('blhd,bmhd->bhlm', q, mem_k.astype(h.dtype)).astype(F32) * (X_HEAD_DIM ** -0.5)
    p = jax.nn.softmax(s, axis=-1).astype(h.dtype)
    o = jnp.einsum('bhlm,bmhd->blhd', p, mem_v.astype(h.dtype)).reshape(bsz, L, D_MODEL)
    return o @ w_o


def trunk_layer(x, mem_k, mem_v, sb_k_past, sb_v_past, s0, pool_prev,
                n_pre, n_post, w_in, lb, onorm_g, w_pool, pool_scale, w_out,
                nx_pre, nx_post, w_xq, w_xo):
    bsz, L, _ = x.shape
    past = sb_k_past.shape[1]
    h = rms_norm(x, n_pre)
    split_idx = [int(i) for i in np.cumsum(SPLIT_SIZES)[:-1]]
    aq, af, ai, ag, bq, bk, bv, bg, cu, cg = jnp.split(h @ w_in, split_idx, axis=-1)

    fl = af.astype(F32)
    log_f = jnp.logaddexp(jnp.log(lb), jnp.log1p(-lb) + jax.nn.log_sigmoid(fl))
    k_a = (1.0 - lb) * jax.nn.sigmoid(-fl)
    q_a = jax.nn.silu(aq.astype(F32)) * (A_HEAD_DIM ** -0.5)
    ah = lambda t: t.reshape(bsz, L, A_HEADS, A_HEAD_DIM)
    o_a, s_new = hgrn2_scan(ah(q_a), ah(k_a), ah(ai.astype(F32)), ah(log_f), s0.astype(F32))
    o_a = o_a * lax.rsqrt(jnp.mean(o_a * o_a, axis=-1, keepdims=True) + EPS) * onorm_g.astype(F32).reshape(A_HEADS, A_HEAD_DIM)
    a_out = (o_a.reshape(bsz, L, A_WIDTH) * jax.nn.silu(ag.astype(F32))).astype(x.dtype)

    bh = lambda t: t.reshape(bsz, L, B_HEADS, B_HEAD_DIM)
    k_b, v_b = bh(bk), bh(bv)
    k_all = jnp.concatenate([sb_k_past.astype(x.dtype), k_b], axis=1)
    v_all = jnp.concatenate([sb_v_past.astype(x.dtype), v_b], axis=1)
    o_b = sb_attention(bh(bq), k_all, v_all, past + jnp.arange(L), jnp.arange(past + L))
    b_out = o_b.reshape(bsz, L, B_WIDTH) * jax.nn.silu(bg)

    c_pool, pool_new = pool_mix(cu, pool_prev.astype(x.dtype), past, w_pool, pool_scale)
    c_out = c_pool * jax.nn.silu(cg)

    mix = jnp.concatenate([a_out, b_out, c_out], axis=-1) @ w_out
    x = x + rms_norm(mix, n_post)
    x = x + rms_norm(cross_attn(rms_norm(x, nx_pre), mem_k, mem_v, w_xq, w_xo), nx_post)
    return x, k_b, v_b, s_new.astype(x.dtype), pool_new


def setup_inputs(seed: int = 0) -> dict:
    key = jax.random.key(seed)
    ks = jax.random.split(key, 24)

    def nrm(k, shape, scale=1.0):
        return jax.random.normal(k, shape, F32) * scale

    def gain(k, shape, s=0.05):
        return 1.0 + s * jax.random.normal(k, shape, F32)

    return {
        'x_prompt': nrm(ks[0], (BATCH, SEQ, D_MODEL)),
        'x_sample': nrm(ks[1], (DEC_BATCH, DEC_SEQ, D_MODEL)),
        'mem_prompt': nrm(ks[2], (BATCH, N_MEM, D_MODEL)),
        'cache_sb_k': nrm(ks[3], (DEPTH, DEC_BATCH, PAST_LEN, B_HEADS, B_HEAD_DIM)),
        'cache_sb_v': nrm(ks[4], (DEPTH, DEC_BATCH, PAST_LEN, B_HEADS, B_HEAD_DIM)),
        'state_hgrn': nrm(ks[5], (DEPTH, DEC_BATCH, A_HEADS, A_HEAD_DIM, A_HEAD_DIM), 0.3),
        'state_pool': nrm(ks[6], (DEPTH, DEC_BATCH, POOL_STATE, C_WIDTH)),
        'cache_mem_k': nrm(ks[7], (DEPTH, DEC_BATCH, N_MEM, X_HEADS, X_HEAD_DIM)),
        'cache_mem_v': nrm(ks[8], (DEPTH, DEC_BATCH, N_MEM, X_HEADS, X_HEAD_DIM)),
        'norm_mix_pre': gain(ks[9], (DEPTH, D_MODEL)),
        'norm_mix_post': gain(ks[10], (DEPTH, D_MODEL)),
        'w_in': nrm(ks[11], (DEPTH, D_MODEL, D_IN), D_MODEL ** -0.5),
        'hgrn_lb_logits': nrm(ks[12], (DEPTH, A_WIDTH), 0.5),
        'hgrn_onorm_g': gain(ks[13], (DEPTH, A_WIDTH)),
        'w_pool': nrm(ks[14], (DEPTH, C_GROUPS, C_GROUP_DIM, C_GROUP_DIM), C_GROUP_DIM ** -0.5),
        'pool_scale': gain(ks[15], (DEPTH, C_WIDTH), 0.1),
        'w_out': nrm(ks[16], (DEPTH, D_MIX, D_MODEL), D_MIX ** -0.5),
        'norm_x_pre': gain(ks[17], (DEPTH, D_MODEL)),
        'norm_x_post': gain(ks[18], (DEPTH, D_MODEL)),
        'norm_mem': gain(ks[19], (DEPTH, D_MODEL)),
        'w_xq': nrm(ks[20], (DEPTH, D_MODEL, D_MODEL), D_MODEL ** -0.5),
        'w_xk': nrm(ks[21], (DEPTH, D_MODEL, D_MODEL), D_MODEL ** -0.5),
        'w_xv': nrm(ks[22], (DEPTH, D_MODEL, D_MODEL), D_MODEL ** -0.5),
        'w_xo': nrm(ks[23], (DEPTH, D_MODEL, D_MODEL), D_MODEL ** -0.5),
    }


def reference(x_prompt, x_sample, mem_prompt, cache_sb_k, cache_sb_v, state_hgrn, state_pool,
              cache_mem_k, cache_mem_v, norm_mix_pre, norm_mix_post, w_in, hgrn_lb_logits,
              hgrn_onorm_g, w_pool, pool_scale, w_out, norm_x_pre, norm_x_post, norm_mem,
              w_xq, w_xk, w_xv, w_xo):
    lbs = jax.nn.softmax(hgrn_lb_logits.astype(F32), axis=0)
    lower_bounds = jnp.maximum(jnp.cumsum(lbs, axis=0) - lbs[0], 0.0)

    bsz_p = x_prompt.shape[0]
    empty_kv = jnp.zeros((bsz_p, 0, B_HEADS, B_HEAD_DIM), x_prompt.dtype)
    s_zero = jnp.zeros((bsz_p, A_HEADS, A_HEAD_DIM, A_HEAD_DIM), F32)
    pool_zero = jnp.zeros((bsz_p, POOL_STATE, C_WIDTH), x_prompt.dtype)

    xp, xs = x_prompt, x_sample
    p_k, p_v, p_s, p_pool, p_mk, p_mv = [], [], [], [], [], []
    s_k, s_v, s_s, s_pool = [], [], [], []
    for l in range(DEPTH):
        lw = (norm_mix_pre[l], norm_mix_post[l], w_in[l], lower_bounds[l], hgrn_onorm_g[l],
              w_pool[l], pool_scale[l], w_out[l], norm_x_pre[l], norm_x_post[l], w_xq[l], w_xo[l])
        mk, mv = mem_kv(mem_prompt, norm_mem[l], w_xk[l], w_xv[l])
        xp, kb, vb, sn, pn = trunk_layer(xp, mk, mv, empty_kv, empty_kv, s_zero, pool_zero, *lw)
        p_k.append(kb); p_v.append(vb); p_s.append(sn); p_pool.append(pn); p_mk.append(mk); p_mv.append(mv)
        xs, kb, vb, sn, pn = trunk_layer(xs, cache_mem_k[l], cache_mem_v[l], cache_sb_k[l], cache_sb_v[l],
                                         state_hgrn[l], state_pool[l], *lw)
        s_k.append(kb); s_v.append(vb); s_s.append(sn); s_pool.append(pn)

    return (xp, xs,
            jnp.stack(p_k), jnp.stack(p_v), jnp.stack(p_s), jnp.stack(p_pool), jnp.stack(p_mk), jnp.stack(p_mv),
            jnp.stack(s_k), jnp.stack(s_v), jnp.stack(s_s), jnp.stack(s_pool))
```

```cpp
#include <hip/hip_runtime.h>
#include <hip/hip_cooperative_groups.h>
#include <cstdio>
namespace cg = cooperative_groups;

typedef unsigned short u16;
typedef __attribute__((ext_vector_type(8))) short bf16x8;
typedef __attribute__((ext_vector_type(16))) float f32x16;
#define DI __device__ __forceinline__
#define MFMA32(a, b, c) __builtin_amdgcn_mfma_f32_32x32x16_bf16((a), (b), (c), 0, 0, 0)
#define SBAR() __builtin_amdgcn_sched_barrier(0)

#ifndef MULTI_LAUNCH
#define MULTI_LAUNCH 0
#endif

constexpr int DM = 1024, DIN = 3584, NROWS = 18432, NPROMPT = 16384;
constexpr int SEQ = 8192, DEC_B = 32, DEC_S = 64, PAST = 1024, DEPTH = 2;
constexpr int NTHREADS = 512;
constexpr int PITCH = 2064;
constexpr float EPS = 1e-6f;
constexpr int C_AQ = 0, C_AF = 512, C_AI = 1024, C_AG = 1536, C_BQ = 2048, C_BK = 2304, C_BV = 2560, C_BG = 2816, C_CU = 3072, C_CG = 3328;
constexpr size_t O_Y = 0;
constexpr size_t O_PSBK = (size_t)NROWS * DM;
constexpr size_t O_PSBV = O_PSBK + (size_t)DEPTH * 2 * SEQ * 256;
constexpr size_t O_PHS = O_PSBV + (size_t)DEPTH * 2 * SEQ * 256;
constexpr size_t O_PPOOL = O_PHS + (size_t)DEPTH * 2 * 4 * 16384;
constexpr size_t O_PMK = O_PPOOL + (size_t)DEPTH * 2 * 15 * 256;
constexpr size_t O_PMV = O_PMK + (size_t)DEPTH * 2 * 256 * 1024;
constexpr size_t O_SSBK = O_PMV + (size_t)DEPTH * 2 * 256 * 1024;
constexpr size_t O_SSBV = O_SSBK + (size_t)DEPTH * DEC_B * DEC_S * 256;
constexpr size_t O_SHS = O_SSBV + (size_t)DEPTH * DEC_B * DEC_S * 256;
constexpr size_t O_SPOOL = O_SHS + (size_t)DEPTH * DEC_B * 4 * 16384;
constexpr size_t WS_WIN = 0;
constexpr size_t WS_WSQ = WS_WIN + (size_t)DEPTH * DIN * DM * 2;
constexpr size_t WS_WPT = WS_WSQ + (size_t)DEPTH * 5 * DM * DM * 2;
constexpr size_t WS_LB = WS_WPT + (size_t)DEPTH * 4 * 64 * 64 * 2;
constexpr size_t WS_PROJ = WS_LB + (size_t)DEPTH * 512 * 4;
constexpr size_t WS_GF = WS_PROJ + (size_t)NROWS * DIN * 2;
constexpr size_t WS_MIX = WS_GF + (size_t)NROWS * 512 * 4;
constexpr size_t WS_DS = WS_MIX + (size_t)NROWS * DM * 2;
constexpr int NCHUNK = 1152;
constexpr size_t WS_DEC = WS_DS + (size_t)NCHUNK * 16384 * 4;
constexpr size_t WS_SPT = WS_DEC + (size_t)NCHUNK * 128 * 4;
constexpr size_t WS_END = WS_SPT + (size_t)NCHUNK * 16384 * 2;
constexpr int LDS_PANEL = 64 * PITCH;
constexpr int LDS_RED = LDS_PANEL;
constexpr int LDS_TOT = LDS_RED + 2048;
constexpr int LDS_RMAX = LDS_TOT + 256;
constexpr int LDS_RSUM = LDS_RMAX + 2048;
constexpr int LDS_LINV = LDS_RSUM + 2048;
constexpr int LDS_BYTES = LDS_LINV + 256;

struct Params {
  const float* x_prompt; const float* x_sample; const float* mem_prompt;
  const float* cache_sb_k; const float* cache_sb_v; const float* state_hgrn; const float* state_pool;
  const float* cache_mem_k; const float* cache_mem_v;
  const float* norm_mix_pre; const float* norm_mix_post; const float* w_in; const float* lb_logits;
  const float* onorm_g; const float* w_pool; const float* pool_scale; const float* w_out;
  const float* norm_x_pre; const float* norm_x_post; const float* norm_mem;
  const float* w_xq; const float* w_xk; const float* w_xv; const float* w_xo;
  float* out; unsigned char* ws; int ph_lo, ph_hi;
};

DI u16 f2bf(float x) { unsigned u = __float_as_uint(x); u += 0x7fffu + ((u >> 16) & 1u); return (u16)(u >> 16); }
DI float bf2f(u16 v) { return __uint_as_float(((unsigned)v) << 16); }
DI unsigned pack2(float a, float b) { return (unsigned)f2bf(a) | ((unsigned)f2bf(b) << 16); }
DI int crow(int i, int h) { return (i & 3) + 8 * (i >> 2) + 4 * h; }
DI float silu(float v) { return v / (1.f + __expf(-v)); }
DI float wave_sum(float v) { for (int o = 32; o >= 1; o >>= 1) v += __shfl_xor(v, o); return v; }
DI float half_sum(float v) { for (int o = 16; o >= 1; o >>= 1) v += __shfl_xor(v, o); return v; }
DI bf16x8 cvt8(float4 a, float4 b) {
  union { bf16x8 v; unsigned u[4]; } r;
  r.u[0] = pack2(a.x, a.y); r.u[1] = pack2(a.z, a.w); r.u[2] = pack2(b.x, b.y); r.u[3] = pack2(b.z, b.w);
  return r.v;
}
DI void st_u16(void* base, unsigned boff, u16 v) { *(u16*)((char*)base + boff) = v; }
DI void st_f32(void* base, unsigned boff, float v) { *(float*)((char*)base + boff) = v; }
DI float ld_f32(const void* base, unsigned boff) { return *(const float*)((const char*)base + boff); }
DI u16 ld_u16(const void* base, unsigned boff) { return *(const u16*)((const char*)base + boff); }
DI unsigned opaque(unsigned x) { asm volatile("" : "+v"(x)); return x; }
DI f32x16 zero16() { f32x16 z; for (int i = 0; i < 16; ++i) z[i] = 0.f; return z; }

template <int NT>
DI void gemm_panel(const unsigned char* panel, const u16* __restrict__ Wt, int ncol0, f32x16 (&acc)[2][NT], int lane) {
  const int r = lane & 31, h = lane >> 5;
  const u16* bp = Wt + (size_t)(ncol0 + r) * 1024 + 32 * h;
  const unsigned char* ap = panel + r * PITCH + 64 * h;
  bf16x8 B[4][NT];
#define LOADB(t, dst) { const int kk_ = (((t) >> 2) << 6) + (((t) & 3) << 3); _Pragma("unroll") for (int nt = 0; nt < NT; ++nt) dst[nt] = *(const bf16x8*)(bp + (size_t)nt * 32 * 1024 + kk_); }
  LOADB(0, B[0]); LOADB(1, B[1]);
#pragma unroll 1
  for (int kb = 0; kb < 16; ++kb) {
#pragma unroll
    for (int s = 0; s < 4; ++s) {
      const int t2 = (kb * 4 + s + 2) & 63;
      LOADB(t2, B[(s + 2) & 3]);
      const bf16x8 a0 = *(const bf16x8*)(ap + kb * 128 + s * 16);
      const bf16x8 a1 = *(const bf16x8*)(ap + 32 * PITCH + kb * 128 + s * 16);
#pragma unroll
      for (int nt = 0; nt < NT; ++nt) { acc[0][nt] = MFMA32(a0, B[s][nt], acc[0][nt]); acc[1][nt] = MFMA32(a1, B[s][nt], acc[1][nt]); }
    }
  }
#undef LOADB
}

DI void row_rstd(const f32x16 (&acc)[2][4], float* red, float* tot, int w, int lane, int tid) {
  const int r = lane & 31, h = lane >> 5;
#pragma unroll
  for (int mt = 0; mt < 2; ++mt)
#pragma unroll
    for (int i = 0; i < 16; ++i) {
      float v = 0.f;
#pragma unroll
      for (int nt = 0; nt < 4; ++nt) v += acc[mt][nt][i] * acc[mt][nt][i];
      v = half_sum(v);
      if (r == 0) red[w * 64 + mt * 32 + crow(i, h)] = v;
    }
  __syncthreads();
  if (tid < 64) { float s = 0.f; for (int ww = 0; ww < 8; ++ww) s += red[ww * 64 + tid]; tot[tid] = rsqrtf(s * (1.f / 1024.f) + EPS); }
  __syncthreads();
}

DI void load_norm_panel(const float* __restrict__ src, const float* __restrict__ gain, unsigned char* panel, int w, int lane) {
  for (int rr = 0; rr < 8; ++rr) {
    const int row = w * 8 + rr;
    const float4* s = (const float4*)(src + (size_t)row * 1024);
    float4 v[4]; float ss = 0.f;
#pragma unroll
    for (int j = 0; j < 4; ++j) { v[j] = s[lane + 64 * j]; ss += v[j].x * v[j].x + v[j].y * v[j].y + v[j].z * v[j].z + v[j].w * v[j].w; }
    ss = wave_sum(ss);
    const float rstd = rsqrtf(ss * (1.f / 1024.f) + EPS);
#pragma unroll
    for (int j = 0; j < 4; ++j) {
      const float4 g = ((const float4*)gain)[lane + 64 * j];
      uint2 o; o.x = pack2(v[j].x * rstd * g.x, v[j].y * rstd * g.y); o.y = pack2(v[j].z * rstd * g.z, v[j].w * rstd * g.w);
      *(uint2*)(panel + row * PITCH + (lane + 64 * j) * 8) = o;
    }
  }
}

DI void win_gemm(const Params& p, int l, int R0, int w, int lane_) {
  extern __shared__ __attribute__((aligned(16))) unsigned char lds[];
  const unsigned char* panel = lds;
  const u16* Wt = (const u16*)(p.ws + WS_WIN) + (size_t)l * DIN * DM;
  const float* LB = (const float*)(p.ws + WS_LB) + l * 512;
  const int grp = R0 >= NPROMPT;
  const int b = grp ? (R0 - NPROMPT) >> 6 : R0 >> 13;
  const int t0 = grp ? 0 : (R0 & (SEQ - 1));
#pragma unroll 1
  for (int c = 0; c < 7; ++c) {
    const int lane = (int)opaque((unsigned)lane_);
    const int r = lane & 31, h = lane >> 5;
    f32x16 acc[2][2];
    acc[0][0] = zero16(); acc[0][1] = zero16(); acc[1][0] = zero16(); acc[1][1] = zero16();
    const int nb = c * 512 + w * 64;
    gemm_panel<2>(panel, Wt, nb, acc, lane);
    const int region = nb >> 8;
#define ROFF(mt, i) ((mt) * 32 + ((i) & 3) + 8 * ((i) >> 2))
    if (region == 2 || region == 3) {
      float* gfb = (float*)(p.ws + WS_GF);
      const unsigned go = ((unsigned)(R0 + 4 * h) * 512u + (unsigned)(nb - C_AF) + r) * 4u;
#pragma unroll
      for (int nt = 0; nt < 2; ++nt) {
        const float lb = LB[nb - C_AF + nt * 32 + r];
        const bool lbpos = lb > 0.f;
        const float la = lbpos ? logf(lb) : 0.f, l1m = log1pf(-lb);
#pragma unroll
        for (int mt = 0; mt < 2; ++mt)
#pragma unroll
          for (int i = 0; i < 16; ++i) {
            const float v = acc[mt][nt][i];
            const float ls = fminf(v, 0.f) - __logf(1.f + __expf(-fabsf(v)));
            const float bb = l1m + ls;
            const float mx = fmaxf(la, bb);
            const float res = lbpos ? mx + __logf(1.f + __expf(-fabsf(la - bb))) : bb;
            st_f32(gfb, go + (ROFF(mt, i) * 512 + nt * 32) * 4, res);
            if ((i & 7) == 7) SBAR();
          }
      }
    } else {
      const bool dosilu = region < 2 || region == 6 || region == 7 || region == 11 || region == 13;
      const float sc = region < 2 ? 0.08838834764831845f : (region == 8 ? 0.125f : 1.f);
      u16* pjb = (u16*)(p.ws + WS_PROJ);
      const unsigned po = ((unsigned)(R0 + 4 * h) * (unsigned)DIN + (unsigned)nb + r) * 2u;
#pragma unroll
      for (int nt = 0; nt < 2; ++nt)
#pragma unroll
        for (int mt = 0; mt < 2; ++mt)
#pragma unroll
          for (int i = 0; i < 16; ++i) {
            const float v = acc[mt][nt][i];
            const float t = (dosilu ? silu(v) : v) * sc;
            st_u16(pjb, po + (ROFF(mt, i) * DIN + nt * 32) * 2, f2bf(t));
            if ((i & 7) == 7) SBAR();
          }
      if (region == 9 || region == 10) {
        const unsigned oo = (unsigned)((grp ? (region == 9 ? O_SSBK : O_SSBV) + ((size_t)(l * DEC_B + b) * DEC_S + t0 + 4 * h) * 256
                                : (region == 9 ? O_PSBK : O_PSBV) + ((size_t)(l * 2 + b) * SEQ + t0 + 4 * h) * 256) + (nb & 255) + r) * 4u;
#pragma unroll
        for (int nt = 0; nt < 2; ++nt)
#pragma unroll
          for (int mt = 0; mt < 2; ++mt)
#pragma unroll
            for (int i = 0; i < 16; ++i) { st_f32(p.out, oo + (ROFF(mt, i) * 256 + nt * 32) * 4, acc[mt][nt][i]); if ((i & 7) == 7) SBAR(); }
      } else if (region == 12 && (grp || t0 == SEQ - 64)) {
        const unsigned oo = (unsigned)((grp ? O_SPOOL + (size_t)(l * DEC_B + b) * 15 * 256 : O_PPOOL + (size_t)(l * 2 + b) * 15 * 256) + (nb & 255) + r) * 4u;
#pragma unroll
        for (int nt = 0; nt < 2; ++nt)
#pragma unroll
          for (int i = 0; i < 16; ++i) {
            const int tl = 32 + crow(i, h);
            if (tl >= 49) st_f32(p.out, oo + (unsigned)((tl - 49) * 256 + nt * 32) * 4u, acc[1][nt][i]);
          }
      }
    }
#undef ROFF
  }
}

DI void convert_tile(const float* __restrict__ src, u16* __restrict__ dst, int K, int N, int k0, int n0, unsigned char* lds, int tid) {
  u16* T = (u16*)lds;
  {
    const int kk = tid >> 3, n8 = (tid & 7) * 8;
    const float4* s = (const float4*)(src + (size_t)(k0 + kk) * N + n0 + n8);
    const float4 a = s[0], bq = s[1];
    T[(n8 + 0) * 72 + kk] = f2bf(a.x); T[(n8 + 1) * 72 + kk] = f2bf(a.y); T[(n8 + 2) * 72 + kk] = f2bf(a.z); T[(n8 + 3) * 72 + kk] = f2bf(a.w);
    T[(n8 + 4) * 72 + kk] = f2bf(bq.x); T[(n8 + 5) * 72 + kk] = f2bf(bq.y); T[(n8 + 6) * 72 + kk] = f2bf(bq.z); T[(n8 + 7) * 72 + kk] = f2bf(bq.w);
  }
  __syncthreads();
  {
    const int n = tid >> 3, k8 = (tid & 7) * 8;
    const uint4 v = *(const uint4*)(T + n * 72 + k8);
    *(uint4*)(dst + (size_t)(n0 + n) * K + k0 + k8) = v;
  }
  __syncthreads();
}

__device__ void phase0(const Params& p, unsigned char* lds, int tid) {
  constexpr int PER_L = 896 + 1280;
  const int ntask = DEPTH * PER_L + DEPTH * 4;
  for (int task = blockIdx.x; task < ntask; task += gridDim.x) {
    if (task < DEPTH * PER_L) {
      const int l = task / PER_L, rr = task % PER_L;
      if (rr < 896) {
        const int kt = rr / 56, nt = rr % 56;
        convert_tile(p.w_in + (size_t)l * DM * DIN, (u16*)(p.ws + WS_WIN) + (size_t)l * DIN * DM, DM, DIN, kt * 64, nt * 64, lds, tid);
      } else {
        const int m = (rr - 896) >> 8, tt = (rr - 896) & 255;
        const float* src = (m == 0 ? p.w_out : m == 1 ? p.w_xq : m == 2 ? p.w_xk : m == 3 ? p.w_xv : p.w_xo) + (size_t)l * DM * DM;
        convert_tile(src, (u16*)(p.ws + WS_WSQ) + (size_t)(l * 5 + m) * DM * DM, DM, DM, (tt >> 4) * 64, (tt & 15) * 64, lds, tid);
      }
    } else {
      const int j = task - DEPTH * PER_L;
      convert_tile(p.w_pool + (size_t)j * 4096, (u16*)(p.ws + WS_WPT) + (size_t)j * 4096, 64, 64, 0, 0, lds, tid);
    }
  }
  if (blockIdx.x == 0) {
    float* LB = (float*)(p.ws + WS_LB);
    for (int c = tid; c < 512; c += NTHREADS) {
      float a[DEPTH], mx = -3.0e38f;
      for (int l = 0; l < DEPTH; ++l) { a[l] = p.lb_logits[l * 512 + c]; mx = fmaxf(mx, a[l]); }
      float s = 0.f; for (int l = 0; l < DEPTH; ++l) { a[l] = expf(a[l] - mx); s += a[l]; }
      float cum = 0.f; const float first = a[0] / s;
      for (int l = 0; l < DEPTH; ++l) { cum += a[l] / s; LB[l * 512 + c] = fmaxf(cum - first, 0.f); }
    }
  }
}

__device__ void phase1(const Params& p, unsigned char* lds, int tid_) {
  const int ntask = 288 + 16;
  for (int task = blockIdx.x; task < ntask; task += gridDim.x) {
    const int tid = (int)opaque((unsigned)tid_);
    const int w = tid >> 6, lane = tid & 63, r = lane & 31, h = lane >> 5;
    if (task < 288) {
      const int R0 = task * 64;
      const float* src = R0 < NPROMPT ? p.x_prompt + (size_t)R0 * DM : p.x_sample + (size_t)(R0 - NPROMPT) * DM;
      load_norm_panel(src, p.norm_mix_pre, lds, w, lane);
      __syncthreads();
      win_gemm(p, 0, R0, w, lane);
      __syncthreads();
    } else {
      const int j = task - 288, l = j >> 3, mt8 = j & 7;
      load_norm_panel(p.mem_prompt + (size_t)mt8 * 64 * DM, p.norm_mem + l * DM, lds, w, lane);
      __syncthreads();
      for (int kv = 0; kv < 2; ++kv) {
        f32x16 acc[2][4];
        for (int a = 0; a < 2; ++a) for (int c = 0; c < 4; ++c) acc[a][c] = zero16();
        gemm_panel<4>(lds, (const u16*)(p.ws + WS_WSQ) + (size_t)(l * 5 + 2 + kv) * DM * DM, w * 128, acc, lane);
        float* dst = p.out + (kv ? O_PMV : O_PMK) + ((size_t)l * 512 + mt8 * 64) * DM;
        const unsigned so = opaque((unsigned)((4 * h) * DM + w * 128 + r) * 4u);
#pragma unroll
        for (int mt = 0; mt < 2; ++mt)
#pragma unroll
          for (int nt = 0; nt < 4; ++nt)
#pragma unroll
            for (int i = 0; i < 16; ++i) { st_f32(dst, so + (unsigned)((mt * 32 + (i & 3) + 8 * (i >> 2)) * DM + nt * 32) * 4u, acc[mt][nt][i]); if ((i & 7) == 7) SBAR(); }
      }
      __syncthreads();
    }
  }
}

DI void hgrn_load_G(const float* __restrict__ GF, int R0, int hd, float (&g)[16], float (&G)[16], float& GL, float& Gm, float* qtot, int tid) {
  const int k = tid & 127, q4 = tid >> 7;
  float run = 0.f;
#pragma unroll
  for (int j = 0; j < 16; ++j) { g[j] = GF[(size_t)(R0 + q4 * 16 + j) * 512 + hd * 128 + k]; run += g[j]; G[j] = run; }
  qtot[q4 * 128 + k] = run;
  __syncthreads();
  const float q0 = qtot[k], q1 = qtot[128 + k], q2 = qtot[256 + k], q3 = qtot[384 + k];
  const float off = (q4 > 0 ? q0 : 0.f) + (q4 > 1 ? q1 : 0.f) + (q4 > 2 ? q2 : 0.f);
#pragma unroll
  for (int j = 0; j < 16; ++j) G[j] += off;
  GL = q0 + q1 + q2 + q3; Gm = q0 + q1;
}
DI void chunk_rows(int task, int& R0, int& hd) {
  if (task < 1024) { const int sh = task >> 7, c = task & 127; R0 = (sh >> 2) * SEQ + c * 64; hd = sh & 3; }
  else { const int sh = task - 1024; R0 = NPROMPT + (sh >> 2) * 64; hd = sh & 3; }
}

__device__ void hgrn_passA(const Params& p, int task, unsigned char* lds, int tid) {
  const int w = tid >> 6, lane = tid & 63, r = lane & 31, h = lane >> 5;
  float* qtot = (float*)lds;
  u16* KT = (u16*)(lds + 2048);
  u16* VT = (u16*)(lds + 2048 + 128 * 144);
  const u16* PROJ = (const u16*)(p.ws + WS_PROJ);
  int R0, hd; chunk_rows(task, R0, hd);
  float g[16], G[16], GL, Gm;
  hgrn_load_G((const float*)(p.ws + WS_GF), R0, hd, g, G, GL, Gm, qtot, tid);
  const int k = tid & 127, q4 = tid >> 7;
#pragma unroll
  for (int j = 0; j < 16; ++j) {
    const int s = q4 * 16 + j;
    KT[k * 72 + s] = f2bf((1.f - __expf(g[j])) * __expf(GL - G[j]));
    VT[k * 72 + s] = PROJ[(size_t)(R0 + s) * DIN + C_AI + hd * 128 + k];
  }
  if (q4 == 0) ((float*)(p.ws + WS_DEC))[(size_t)task * 128 + k] = __expf(GL);
  __syncthreads();
  const int vt = w >> 1, kt0 = (w & 1) * 2;
  f32x16 acc[2]; acc[0] = zero16(); acc[1] = zero16();
#pragma unroll
  for (int ss = 0; ss < 4; ++ss) {
    const bf16x8 a = *(const bf16x8*)(VT + (vt * 32 + r) * 72 + 16 * ss + 8 * h);
#pragma unroll
    for (int q = 0; q < 2; ++q) {
      const bf16x8 bb = *(const bf16x8*)(KT + ((kt0 + q) * 32 + r) * 72 + 16 * ss + 8 * h);
      acc[q] = MFMA32(a, bb, acc[q]);
    }
  }
  float* DS = (float*)(p.ws + WS_DS) + (size_t)task * 16384;
#pragma unroll
  for (int q = 0; q < 2; ++q)
#pragma unroll
    for (int i = 0; i < 16; ++i) DS[(vt * 32 + crow(i, h)) * 128 + (kt0 + q) * 32 + r] = acc[q][i];
  __syncthreads();
}

__device__ void hgrn_scan_unit(const Params& p, int l, int unit, unsigned char* lds, int tid) {
  float* tmp = (float*)lds;
  const float* DS = (const float*)(p.ws + WS_DS);
  const float* DEC = (const float*)(p.ws + WS_DEC);
  u16* SPT = (u16*)(p.ws + WS_SPT);
  int sh, vs;
  if (unit < 128) { sh = unit >> 4; vs = unit & 15; } else { sh = 8 + ((unit - 128) >> 4); vs = (unit - 128) & 15; }
  const int v0 = vs * 8;
  const int v = tid >> 6, k2 = (tid & 63) * 2;
  const int ka = tid >> 2, va = (tid & 3) * 2;
  float s0 = 0.f, s1 = 0.f;
  int task0, nch; float* fin;
  if (sh < 8) { task0 = sh * 128; nch = 128; fin = p.out + O_PHS + ((size_t)l * 8 + sh) * 16384; }
  else {
    const int ss = sh - 8; task0 = 1024 + ss; nch = 1; fin = p.out + O_SHS + ((size_t)l * 128 + ss) * 16384;
    const float* st = p.state_hgrn + ((size_t)l * 128 + ss) * 16384;
    const float2 x = *(const float2*)(st + (size_t)ka * 128 + v0 + va);
    tmp[va * 130 + ka] = x.x; tmp[(va + 1) * 130 + ka] = x.y;
    __syncthreads();
    s0 = tmp[v * 130 + k2]; s1 = tmp[v * 130 + k2 + 1];
    __syncthreads();
  }
  const size_t eoff = (size_t)(v0 + v) * 128 + k2;
#pragma unroll 4
  for (int c = 0; c < nch; ++c) {
    const size_t tb = (size_t)(task0 + c);
    const float2 d = *(const float2*)(DS + tb * 16384 + eoff);
    const float2 dc = *(const float2*)(DEC + tb * 128 + k2);
    *(unsigned*)(SPT + tb * 16384 + eoff) = pack2(s0, s1);
    s0 = dc.x * s0 + d.x; s1 = dc.y * s1 + d.y;
  }
  tmp[v * 130 + k2] = s0; tmp[v * 130 + k2 + 1] = s1;
  __syncthreads();
  float2 o; o.x = tmp[va * 130 + ka]; o.y = tmp[(va + 1) * 130 + ka];
  *(float2*)(fin + (size_t)ka * 128 + v0 + va) = o;
  __syncthreads();
}

__device__ void hgrn_passC(const Params& p, int l, int task, unsigned char* lds, int tid) {
  const int w = tid >> 6, lane = tid & 63, r = lane & 31, h = lane >> 5;
  float* qtot = (float*)lds;
  u16* Qm = (u16*)(lds + 2048);
  u16* Km = (u16*)(lds + 2048 + 17408);
  u16* QS = (u16*)(lds + 2048 + 2 * 17408);
  u16* VT = (u16*)(lds + 2048 + 3 * 17408);
  u16* ATT = (u16*)(lds + 2048 + 3 * 17408 + 18432);
  float* psum = (float*)(lds + 2048 + 3 * 17408 + 18432 + 9216);
  const u16* PROJ = (const u16*)(p.ws + WS_PROJ);
  int R0, hd; chunk_rows(task, R0, hd);
  float g[16], G[16], GL, Gm;
  hgrn_load_G((const float*)(p.ws + WS_GF), R0, hd, g, G, GL, Gm, qtot, tid);
  {
    const int k = tid & 127, q4 = tid >> 7;
#pragma unroll
    for (int j = 0; j < 16; ++j) {
      const int s = q4 * 16 + j;
      const float q = bf2f(PROJ[(size_t)(R0 + s) * DIN + C_AQ + hd * 128 + k]);
      const float d1 = fminf(fmaxf(G[j] - Gm, -80.f), 80.f);
      Qm[s * 136 + k] = f2bf(q * __expf(d1));
      Km[s * 136 + k] = f2bf((1.f - __expf(g[j])) * __expf(-d1));
      QS[s * 136 + k] = f2bf(q * __expf(G[j]));
      VT[k * 72 + s] = PROJ[(size_t)(R0 + s) * DIN + C_AI + hd * 128 + k];
    }
  }
  __syncthreads();
  if (w < 4) {
    const int tt = w >> 1, st = w & 1;
    f32x16 a = zero16();
    if (st <= tt) {
#pragma unroll
      for (int sk = 0; sk < 8; ++sk) {
        const bf16x8 fa = *(const bf16x8*)(Qm + (tt * 32 + r) * 136 + 16 * sk + 8 * h);
        const bf16x8 fb = *(const bf16x8*)(Km + (st * 32 + r) * 136 + 16 * sk + 8 * h);
        a = MFMA32(fa, fb, a);
      }
    }
    const int s = st * 32 + r;
#pragma unroll
    for (int i = 0; i < 16; ++i) {
      const int t = tt * 32 + crow(i, h);
      ATT[t * 72 + s] = (st <= tt && s <= t) ? f2bf(a[i]) : (u16)0;
    }
  }
  __syncthreads();
  const int tt = w >> 2, vt = w & 3;
  f32x16 o = zero16();
#pragma unroll
  for (int ss = 0; ss < 4; ++ss) {
    const bf16x8 fa = *(const bf16x8*)(ATT + (tt * 32 + r) * 72 + 16 * ss + 8 * h);
    const bf16x8 fb = *(const bf16x8*)(VT + (vt * 32 + r) * 72 + 16 * ss + 8 * h);
    o = MFMA32(fa, fb, o);
  }
  const u16* SP = (const u16*)(p.ws + WS_SPT) + (size_t)task * 16384 + (size_t)(vt * 32 + r) * 128 + 8 * h;
#pragma unroll
  for (int sk = 0; sk < 8; ++sk) {
    const bf16x8 fa = *(const bf16x8*)(QS + (tt * 32 + r) * 136 + 16 * sk + 8 * h);
    const bf16x8 fb = *(const bf16x8*)(SP + 16 * sk);
    o = MFMA32(fa, fb, o);
  }
#pragma unroll
  for (int i = 0; i < 16; ++i) {
    const float v = half_sum(o[i] * o[i]);
    if (r == 0) psum[vt * 64 + tt * 32 + crow(i, h)] = v;
  }
  __syncthreads();
  const int v = vt * 32 + r;
  const float og = p.onorm_g[l * 512 + hd * 128 + v];
  u16* MIX = (u16*)(p.ws + WS_MIX);
#pragma unroll
  for (int i = 0; i < 16; ++i) {
    const int t = tt * 32 + crow(i, h);
    const float ssq = psum[t] + psum[64 + t] + psum[128 + t] + psum[192 + t];
    const float rstd = rsqrtf(ssq * (1.f / 128.f) + EPS);
    const size_t row = (size_t)(R0 + t);
    const float gate = bf2f(PROJ[row * DIN + C_AG + hd * 128 + v]);
    MIX[row * DM + hd * 128 + v] = f2bf(o[i] * rstd * og * gate);
  }
  __syncthreads();
}

__device__ void sb_wave(const Params& p, int l, int grp, int b, int head, int q0, int lane) {
  const int r = lane & 31, h = lane >> 5;
  const u16* PROJ = (const u16*)(p.ws + WS_PROJ);
  const int Rbase = grp ? NPROMPT + b * 64 : b * SEQ;
  const int past = grp ? PAST : 0;
  const float* ck = p.cache_sb_k + (size_t)(l * DEC_B + b) * PAST * 256;
  const float* cv = p.cache_sb_v + (size_t)(l * DEC_B + b) * PAST * 256;
  bf16x8 qf[4];
#pragma unroll
  for (int s = 0; s < 4; ++s) qf[s] = *(const bf16x8*)(PROJ + (size_t)(Rbase + q0 + r) * DIN + C_BQ + head * 64 + 16 * s + 8 * h);
  const int qpos = past + q0 + r;
  float carry = 0.f;
  f32x16 O[2]; O[0] = zero16(); O[1] = zero16();
  const int T0 = (past + q0) >> 5;
  for (int T = T0; T >= 0; --T) {
    const bool isnew = T * 32 >= past;
    f32x16 z = zero16();
    if (isnew) {
      const u16* kp = PROJ + (size_t)(Rbase + T * 32 - past + r) * DIN + C_BK + head * 64 + 8 * h;
#pragma unroll
      for (int s = 0; s < 4; ++s) { const bf16x8 a = *(const bf16x8*)(kp + 16 * s); z = MFMA32(a, qf[s], z); }
    } else {
      const float* kp = ck + (size_t)(T * 32 + r) * 256 + head * 64 + 8 * h;
#pragma unroll
      for (int s = 0; s < 4; ++s) { const float4 f0 = *(const float4*)(kp + 16 * s), f1 = *(const float4*)(kp + 16 * s + 4); z = MFMA32(cvt8(f0, f1), qf[s], z); }
    }
    float lsm[16]; bool msk[16];
#pragma unroll
    for (int i = 0; i < 16; ++i) {
      msk[i] = (T * 32 + crow(i, h)) < qpos;
      const float sp = fmaxf(z[i], 0.f) + __logf(1.f + __expf(-fabsf(z[i])));
      lsm[i] = msk[i] ? -sp : 0.f;
    }
    float town[4], toth[4];
#pragma unroll
    for (int g = 0; g < 4; ++g) {
      lsm[4 * g + 2] += lsm[4 * g + 3]; lsm[4 * g + 1] += lsm[4 * g + 2]; lsm[4 * g + 0] += lsm[4 * g + 1];
      town[g] = lsm[4 * g];
    }
#pragma unroll
    for (int g = 0; g < 4; ++g) toth[g] = __shfl_xor(town[g], 32);
    float spair = 0.f;
    float ag[4];
#pragma unroll
    for (int g = 3; g >= 0; --g) { ag[g] = spair + (h == 0 ? toth[g] : 0.f); spair += town[g] + toth[g]; }
    union { bf16x8 v; unsigned u[4]; } pf[2];
#pragma unroll
    for (int i = 0; i < 16; i += 2) {
      const float w0 = msk[i] ? __expf(z[i] + lsm[i] + ag[i >> 2] + carry) : 0.f;
      const float w1 = msk[i + 1] ? __expf(z[i + 1] + lsm[i + 1] + ag[i >> 2] + carry) : 0.f;
      pf[i >> 3].u[(i & 7) >> 1] = pack2(w0, w1);
    }
    carry += spair;
#pragma unroll
    for (int s = 0; s < 2; ++s)
#pragma unroll
      for (int dt = 0; dt < 2; ++dt) {
        union { bf16x8 v; u16 e[8]; } vf;
        if (isnew) {
          const u16* vp = PROJ + (size_t)(Rbase + T * 32 - past) * DIN + C_BV + head * 64 + dt * 32 + r;
#pragma unroll
          for (int j = 0; j < 8; ++j) vf.e[j] = vp[(size_t)(16 * s + 8 * (j >> 2) + 4 * h + (j & 3)) * DIN];
        } else {
          const float* vp = cv + (size_t)(T * 32) * 256 + head * 64 + dt * 32 + r;
#pragma unroll
          for (int j = 0; j < 8; ++j) vf.e[j] = f2bf(vp[(size_t)(16 * s + 8 * (j >> 2) + 4 * h + (j & 3)) * 256]);
        }
        O[dt] = MFMA32(pf[s].v, vf.v, O[dt]);
      }
    if (__all(carry < -110.f)) break;
  }
  u16* MIX = (u16*)(p.ws + WS_MIX);
#pragma unroll
  for (int dt = 0; dt < 2; ++dt)
#pragma unroll
    for (int i = 0; i < 16; ++i) {
      const size_t row = (size_t)(Rbase + q0 + crow(i, h));
      const int d = head * 64 + dt * 32 + r;
      const float gate = bf2f(PROJ[row * DIN + C_BG + d]);
      MIX[row * DM + 512 + d] = f2bf(O[dt][i] * gate);
    }
}

__device__ void pool_tile(const Params& p, int l, int R0, unsigned char* lds, int tid) {
  const int w = tid >> 6, lane = tid & 63, r = lane & 31, h = lane >> 5;
  float* E = (float*)lds;
  u16* D = (u16*)(lds + 79 * 1024);
  const u16* PROJ = (const u16*)(p.ws + WS_PROJ);
  const int grp = R0 >= NPROMPT;
  const int b = grp ? (R0 - NPROMPT) >> 6 : R0 >> 13;
  const int t0 = grp ? 0 : (R0 & (SEQ - 1));
  const int past = grp ? PAST : 0;
  for (int e = tid; e < 79 * 256; e += NTHREADS) {
    const int j = e >> 8, c = e & 255;
    const int t = t0 - 15 + j;
    float v = 0.f;
    if (t >= 0) v = bf2f(PROJ[(size_t)(R0 - t0 + t) * DIN + C_CU + c]);
    else if (grp) v = p.state_pool[((size_t)(l * DEC_B + b) * 15 + (15 + t)) * 256 + c];
    E[e] = v;
  }
  __syncthreads();
  for (int e = tid; e < 64 * 256; e += NTHREADS) {
    const int t = e >> 8, c = e & 255;
    const int wdw = 2 << (c >> 6);
    float s = 0.f;
    for (int j = 0; j < wdw; ++j) s += E[(15 + t - j) * 256 + c];
    const int pos = past + t0 + t;
    const float cnt = (float)min(pos + 1, wdw);
    D[t * 264 + c] = f2bf(s / cnt - E[(15 + t) * 256 + c]);
  }
  __syncthreads();
  const int g = w >> 1, mt = w & 1;
  const u16* WP = (const u16*)(p.ws + WS_WPT) + (size_t)(l * 4 + g) * 4096;
  f32x16 acc[2]; acc[0] = zero16(); acc[1] = zero16();
#pragma unroll
  for (int s = 0; s < 4; ++s) {
    const bf16x8 a = *(const bf16x8*)(D + (mt * 32 + r) * 264 + g * 64 + 16 * s + 8 * h);
#pragma unroll
    for (int nt = 0; nt < 2; ++nt) {
      const bf16x8 bb = *(const bf16x8*)(WP + (nt * 32 + r) * 64 + 16 * s + 8 * h);
      acc[nt] = MFMA32(a, bb, acc[nt]);
    }
  }
  u16* MIX = (u16*)(p.ws + WS_MIX);
#pragma unroll
  for (int nt = 0; nt < 2; ++nt) {
    const int d = g * 64 + nt * 32 + r;
    const float sc = p.pool_scale[l * 256 + d];
#pragma unroll
    for (int i = 0; i < 16; ++i) {
      const size_t row = (size_t)(R0 + mt * 32 + crow(i, h));
      const float gate = bf2f(PROJ[row * DIN + C_CG + d]);
      MIX[row * DM + 768 + d] = f2bf(acc[nt][i] * sc * gate);
    }
  }
  __syncthreads();
}

__device__ void phase_mix1(const Params& p, int l, unsigned char* lds, int tid) {
  const int w = tid >> 6, lane = tid & 63;
  const int ntask = 288 + NCHUNK + 288;
  for (int task = blockIdx.x; task < ntask; task += gridDim.x) {
    if (task < 288) {
      if (task < 256) { const int b = task >> 7, rem = task & 127; sb_wave(p, l, 0, b, rem >> 5, (rem & 31) * 256 + w * 32, lane); }
      else { sb_wave(p, l, 1, task - 256, w >> 1, (w & 1) * 32, lane); }
    } else if (task < 288 + NCHUNK) hgrn_passA(p, task - 288, lds, tid);
    else pool_tile(p, l, (task - 288 - NCHUNK) * 64, lds, tid);
  }
}

__device__ void chain_tile(const Params& p, int l, int R0, unsigned char* lds, int tid_) {
  const int tid = (int)opaque((unsigned)tid_);
  const int w = tid >> 6, lane = tid & 63, r = lane & 31, h = lane >> 5;
  unsigned char* panel = lds;
  float* red = (float*)(lds + LDS_RED); float* tot = (float*)(lds + LDS_TOT);
  float* rmax = (float*)(lds + LDS_RMAX); float* rsum = (float*)(lds + LDS_RSUM); float* linv = (float*)(lds + LDS_LINV);
  const int grp = R0 >= NPROMPT;
  const int b = grp ? (R0 - NPROMPT) >> 6 : R0 >> 13;
  const u16* WSQ = (const u16*)(p.ws + WS_WSQ) + (size_t)l * 5 * DM * DM;
  float* Y = p.out + O_Y;
  const float* xsrc = (l == 0) ? (grp ? p.x_sample - (size_t)NPROMPT * DM : p.x_prompt) : (const float*)Y;
  const unsigned yo_ = ((unsigned)(R0 + 4 * h) * (unsigned)DM + (unsigned)(w * 128 + r)) * 4u;
  {
    const u16* MIX = (const u16*)(p.ws + WS_MIX) + (size_t)R0 * DM;
    for (int e = tid; e < 64 * 128; e += NTHREADS) {
      const int row = e >> 7, c16 = e & 127;
      *(uint4*)(panel + row * PITCH + c16 * 16) = *(const uint4*)(MIX + (size_t)row * DM + c16 * 8);
    }
  }
  __syncthreads();
  f32x16 acc[2][4];
#define ZACC() { _Pragma("unroll") for (int a_ = 0; a_ < 2; ++a_) _Pragma("unroll") for (int c_ = 0; c_ < 4; ++c_) acc[a_][c_] = zero16(); }
  ZACC();
  gemm_panel<4>(panel, WSQ + (size_t)0 * DM * DM, w * 128, acc, lane);
  row_rstd(acc, red, tot, w, lane, tid);
  {
    const float* npost = p.norm_mix_post + l * DM;
    const unsigned yo = opaque(yo_);
#pragma unroll
    for (int nt = 0; nt < 4; ++nt) {
      const int col = w * 128 + nt * 32 + r; const float gn = npost[col];
#pragma unroll
      for (int mt = 0; mt < 2; ++mt)
#pragma unroll
        for (int i = 0; i < 16; ++i) {
          const unsigned bo = yo + (unsigned)((mt * 32 + (i & 3) + 8 * (i >> 2)) * DM + nt * 32) * 4u;
          const float x1 = ld_f32(xsrc, bo) + acc[mt][nt][i] * tot[4 * h + mt * 32 + (i & 3) + 8 * (i >> 2)] * gn;
          acc[mt][nt][i] = x1; st_f32(Y, bo, x1);
          if ((i & 7) == 7) SBAR();
        }
    }
  }
  row_rstd(acc, red, tot, w, lane, tid);
  {
    const float* g2 = p.norm_x_pre + l * DM;
    const unsigned pwo = opaque((unsigned)(4 * h * PITCH + (w * 128 + r) * 2));
#pragma unroll
    for (int nt = 0; nt < 4; ++nt) {
      const int col = w * 128 + nt * 32 + r; const float gn = g2[col];
#pragma unroll
      for (int mt = 0; mt < 2; ++mt)
#pragma unroll
        for (int i = 0; i < 16; ++i)
          *(u16*)(panel + pwo + (mt * 32 + (i & 3) + 8 * (i >> 2)) * PITCH + nt * 64) = f2bf(acc[mt][nt][i] * tot[4 * h + mt * 32 + (i & 3) + 8 * (i >> 2)] * gn);
    }
  }
  __syncthreads();
  ZACC();
  gemm_panel<4>(panel, WSQ + (size_t)1 * DM * DM, w * 128, acc, lane);
  __syncthreads();
  { const unsigned pwo = opaque((unsigned)(4 * h * PITCH + (w * 128 + r) * 2));
#pragma unroll
  for (int nt = 0; nt < 4; ++nt) {
    const int col = w * 128 + nt * 32 + r; (void)col;
#pragma unroll
    for (int mt = 0; mt < 2; ++mt)
#pragma unroll
      for (int i = 0; i < 16; ++i)
        *(u16*)(panel + pwo + (mt * 32 + (i & 3) + 8 * (i >> 2)) * PITCH + nt * 64) = f2bf(acc[mt][nt][i] * 0.0625f);
  } }
  __syncthreads();
  {
    const float* Kmem = grp ? p.cache_mem_k + (size_t)(l * DEC_B + b) * 256 * 1024 : p.out + O_PMK + (size_t)(l * 2 + b) * 256 * 1024;
    const float* Vmem = grp ? p.cache_mem_v + (size_t)(l * DEC_B + b) * 256 * 1024 : p.out + O_PMV + (size_t)(l * 2 + b) * 256 * 1024;
#pragma unroll 1
    for (int hh = 0; hh < 4; ++hh) {
      f32x16 st[2]; st[0] = zero16(); st[1] = zero16();
      const float* kp = Kmem + ((size_t)(w * 32 + r) * 4 + hh) * 256 + 32 * h;
#pragma unroll 1
      for (int kb = 0; kb < 4; ++kb) {
        float4 f[8];
#pragma unroll
        for (int j = 0; j < 8; ++j) f[j] = ((const float4*)(kp + kb * 64))[j];
#pragma unroll
        for (int s = 0; s < 4; ++s) {
          const bf16x8 a = cvt8(f[2 * s], f[2 * s + 1]);
#pragma unroll
          for (int nt = 0; nt < 2; ++nt) {
            const bf16x8 bq = *(const bf16x8*)(panel + (nt * 32 + r) * PITCH + (hh * 256 + kb * 64 + 32 * h + 8 * s) * 2);
            st[nt] = MFMA32(a, bq, st[nt]);
          }
        }
      }
#pragma unroll
      for (int nt = 0; nt < 2; ++nt) {
        float m = st[nt][0];
#pragma unroll
        for (int i = 1; i < 16; ++i) m = fmaxf(m, st[nt][i]);
        m = fmaxf(m, __shfl_xor(m, 32));
        if (h == 0) rmax[w * 64 + nt * 32 + r] = m;
      }
      __syncthreads();
#pragma unroll
      for (int nt = 0; nt < 2; ++nt) {
        float gm = rmax[nt * 32 + r];
#pragma unroll
        for (int ww = 1; ww < 8; ++ww) gm = fmaxf(gm, rmax[ww * 64 + nt * 32 + r]);
        float sum = 0.f;
#pragma unroll
        for (int i = 0; i < 16; ++i) { const float pv = __expf(st[nt][i] - gm); st[nt][i] = pv; sum += pv; }
        sum += __shfl_xor(sum, 32);
        if (h == 0) rsum[w * 64 + nt * 32 + r] = sum;
#pragma unroll
        for (int g = 0; g < 4; ++g) {
          uint2 o; o.x = pack2(st[nt][4 * g], st[nt][4 * g + 1]); o.y = pack2(st[nt][4 * g + 2], st[nt][4 * g + 3]);
          *(uint2*)(panel + (nt * 32 + r) * PITCH + (hh * 256 + w * 32 + 8 * g + 4 * h) * 2) = o;
        }
      }
      __syncthreads();
      if (tid < 64) { float s = 0.f; for (int ww = 0; ww < 8; ++ww) s += rsum[ww * 64 + tid]; linv[tid] = 1.f / s; }
      f32x16 o2[2]; o2[0] = zero16(); o2[1] = zero16();
      const float* vp = Vmem + (size_t)hh * 256 + w * 32 + r;
#pragma unroll 4
      for (int s = 0; s < 16; ++s) {
        float vv[8];
#pragma unroll
        for (int j = 0; j < 8; ++j) vv[j] = vp[(size_t)(16 * s + 8 * h + j) * 1024];
        union { bf16x8 v; unsigned u[4]; } bv;
        bv.u[0] = pack2(vv[0], vv[1]); bv.u[1] = pack2(vv[2], vv[3]); bv.u[2] = pack2(vv[4], vv[5]); bv.u[3] = pack2(vv[6], vv[7]);
#pragma unroll
        for (int mt = 0; mt < 2; ++mt) {
          const bf16x8 a = *(const bf16x8*)(panel + (mt * 32 + r) * PITCH + (hh * 256 + 16 * s + 8 * h) * 2);
          o2[mt] = MFMA32(a, bv.v, o2[mt]);
        }
      }
      __syncthreads();
#pragma unroll
      for (int mt = 0; mt < 2; ++mt)
#pragma unroll
        for (int i = 0; i < 16; ++i) {
          const int q = mt * 32 + crow(i, h);
          *(u16*)(panel + q * PITCH + (hh * 256 + w * 32 + r) * 2) = f2bf(o2[mt][i] * linv[q]);
        }
    }
  }
  __syncthreads();
  ZACC();
  gemm_panel<4>(panel, WSQ + (size_t)4 * DM * DM, w * 128, acc, lane);
  row_rstd(acc, red, tot, w, lane, tid);
  {
    const float* g3 = p.norm_x_post + l * DM;
    const unsigned yo = opaque(yo_);
#pragma unroll
    for (int nt = 0; nt < 4; ++nt) {
      const int col = w * 128 + nt * 32 + r; const float gn = g3[col];
#pragma unroll
      for (int mt = 0; mt < 2; ++mt)
#pragma unroll
        for (int i = 0; i < 16; ++i) {
          const unsigned bo = yo + (unsigned)((mt * 32 + (i & 3) + 8 * (i >> 2)) * DM + nt * 32) * 4u;
          const float x2 = ld_f32(Y, bo) + acc[mt][nt][i] * tot[4 * h + mt * 32 + (i & 3) + 8 * (i >> 2)] * gn;
          acc[mt][nt][i] = x2; st_f32(Y, bo, x2);
          if ((i & 7) == 7) SBAR();
        }
    }
  }
  if (l + 1 < DEPTH) {
    row_rstd(acc, red, tot, w, lane, tid);
    const float* g4 = p.norm_mix_pre + (l + 1) * DM;
    const unsigned pwo = opaque((unsigned)(4 * h * PITCH + (w * 128 + r) * 2));
#pragma unroll
    for (int nt = 0; nt < 4; ++nt) {
      const int col = w * 128 + nt * 32 + r; const float gn = g4[col];
#pragma unroll
      for (int mt = 0; mt < 2; ++mt)
#pragma unroll
        for (int i = 0; i < 16; ++i)
          *(u16*)(panel + pwo + (mt * 32 + (i & 3) + 8 * (i >> 2)) * PITCH + nt * 64) = f2bf(acc[mt][nt][i] * tot[4 * h + mt * 32 + (i & 3) + 8 * (i >> 2)] * gn);
    }
    __syncthreads();
    win_gemm(p, l + 1, R0, w, lane);
  }
  __syncthreads();
#undef ZACC
}

__global__ void __launch_bounds__(NTHREADS) hybrid_fwd(Params p) {
  extern __shared__ __attribute__((aligned(16))) unsigned char lds[];
  cg::grid_group grid = cg::this_grid();
  for (int ph = p.ph_lo; ph < p.ph_hi; ++ph) {
    const int tid = (int)opaque(threadIdx.x);
    if (ph == 0) phase0(p, lds, tid);
    else if (ph == 1) phase1(p, lds, tid);
    else {
      const int l = (ph - 2) >> 2, sub = (ph - 2) & 3;
      if (sub == 0) phase_mix1(p, l, lds, tid);
      else if (sub == 1) { for (int u = blockIdx.x; u < 128 + 2048; u += gridDim.x) hgrn_scan_unit(p, l, u, lds, tid); }
      else if (sub == 2) { for (int t = blockIdx.x; t < NCHUNK; t += gridDim.x) hgrn_passC(p, l, t, lds, tid); }
      else { for (int t = blockIdx.x; t < 288; t += gridDim.x) chain_tile(p, l, t * 64, lds, tid); }
    }
    if (ph + 1 < p.ph_hi) grid.sync();
  }
}

extern "C" void kernel_launch(void* const* d_in, const int* in_sizes, int n_in, void* d_out, int out_size, void* d_ws, size_t ws_size, hipStream_t stream) {
  static int grid_blocks = 0;
  if (!grid_blocks) {
    int dev = 0, cus = 0, per_cu = 0;
    hipGetDevice(&dev);
    hipDeviceGetAttribute(&cus, hipDeviceAttributeMultiprocessorCount, dev);
    hipFuncSetAttribute((const void*)hybrid_fwd, hipFuncAttributeMaxDynamicSharedMemorySize, LDS_BYTES);
    hipOccupancyMaxActiveBlocksPerMultiprocessor(&per_cu, (const void*)hybrid_fwd, NTHREADS, LDS_BYTES);
    if (per_cu < 1) { fprintf(stderr, "occupancy query returned %d\n", per_cu); per_cu = 1; }
    grid_blocks = cus * per_cu;
    if (ws_size < WS_END) fprintf(stderr, "workspace too small: %zu < %zu\n", ws_size, (size_t)WS_END);
  }
  Params p{};
  const float* const* in = (const float* const*)d_in;
  p.x_prompt = in[0]; p.x_sample = in[1]; p.mem_prompt = in[2]; p.cache_sb_k = in[3]; p.cache_sb_v = in[4];
  p.state_hgrn = in[5]; p.state_pool = in[6]; p.cache_mem_k = in[7]; p.cache_mem_v = in[8];
  p.norm_mix_pre = in[9]; p.norm_mix_post = in[10]; p.w_in = in[11]; p.lb_logits = in[12]; p.onorm_g = in[13];
  p.w_pool = in[14]; p.pool_scale = in[15]; p.w_out = in[16]; p.norm_x_pre = in[17]; p.norm_x_post = in[18];
  p.norm_mem = in[19]; p.w_xq = in[20]; p.w_xk = in[21]; p.w_xv = in[22]; p.w_xo = in[23];
  p.out = (float*)d_out; p.ws = (unsigned char*)d_ws;
  const int NPH = 2 + 4 * DEPTH;
#if MULTI_LAUNCH
  for (int ph = 0; ph < NPH; ++ph) {
    p.ph_lo = ph; p.ph_hi = ph + 1;
    hipLaunchKernelGGL(hybrid_fwd, dim3(grid_blocks), dim3(NTHREADS), LDS_BYTES, stream, p);
  }
#else
  p.ph_lo = 0; p.ph_hi = NPH;
  void* args[] = {&p};
  hipError_t e = hipLaunchCooperativeKernel((const void*)hybrid_fwd, dim3(grid_blocks), dim3(NTHREADS), args, LDS_BYTES, stream);
  if (e != hipSuccess) fprintf(stderr, "cooperative launch failed: %s (grid %d)\n", hipGetErrorString(e), grid_blocks);
#endif
}
```

```cpp
#include <hip/hip_runtime.h>
#include <hip/hip_cooperative_groups.h>
#include <cstdio>
namespace cg = cooperative_groups;

typedef unsigned short u16;
typedef __attribute__((ext_vector_type(8))) short bf16x8;
typedef __attribute__((ext_vector_type(16))) float f32x16;
#define DI __device__ __forceinline__
#define MFMA32(a, b, c) __builtin_amdgcn_mfma_f32_32x32x16_bf16((a), (b), (c), 0, 0, 0)
#define SBAR() __builtin_amdgcn_sched_barrier(0)

#ifndef GEMM_PD
#define GEMM_PD 3
#endif
#ifndef SAMPLE_LEAD
#define SAMPLE_LEAD 4
#endif

constexpr int DM = 1024, DIN = 3584, NROWS = 18432, NPROMPT = 16384;
constexpr int SEQ = 8192, DEC_B = 32, DEC_S = 64, PAST = 1024, DEPTH = 2;
constexpr int NTHREADS = 512;
constexpr int PITCH = 2064;
constexpr float EPS = 1e-6f;
constexpr int C_AQ = 0, C_AF = 512, C_AI = 1024, C_AG = 1536, C_BQ = 2048, C_BK = 2304, C_BV = 2560, C_BG = 2816, C_CU = 3072, C_CG = 3328;
constexpr size_t O_Y = 0;
constexpr size_t O_PSBK = (size_t)NROWS * DM;
constexpr size_t O_PSBV = O_PSBK + (size_t)DEPTH * 2 * SEQ * 256;
constexpr size_t O_PHS = O_PSBV + (size_t)DEPTH * 2 * SEQ * 256;
constexpr size_t O_PPOOL = O_PHS + (size_t)DEPTH * 2 * 4 * 16384;
constexpr size_t O_PMK = O_PPOOL + (size_t)DEPTH * 2 * 15 * 256;
constexpr size_t O_PMV = O_PMK + (size_t)DEPTH * 2 * 256 * 1024;
constexpr size_t O_SSBK = O_PMV + (size_t)DEPTH * 2 * 256 * 1024;
constexpr size_t O_SSBV = O_SSBK + (size_t)DEPTH * DEC_B * DEC_S * 256;
constexpr size_t O_SHS = O_SSBV + (size_t)DEPTH * DEC_B * DEC_S * 256;
constexpr size_t O_SPOOL = O_SHS + (size_t)DEPTH * DEC_B * 4 * 16384;
constexpr size_t WS_WIN = 0;
constexpr size_t WS_WSQ = WS_WIN + (size_t)DEPTH * DIN * DM * 2;
constexpr size_t WS_WPT = WS_WSQ + (size_t)DEPTH * 5 * DM * DM * 2;
constexpr size_t WS_LB = WS_WPT + (size_t)DEPTH * 4 * 64 * 64 * 2;
constexpr size_t WS_PROJ = WS_LB + (size_t)DEPTH * 2 * 512 * 4;
constexpr size_t WS_GF = WS_PROJ + (size_t)NROWS * DIN * 2;
constexpr size_t WS_MIX = WS_GF + (size_t)NROWS * 512 * 4;
constexpr size_t WS_DS = WS_MIX + (size_t)NROWS * DM * 2;
constexpr int NCHUNK = 1152;
constexpr size_t WS_DEC = WS_DS + (size_t)NCHUNK * 16384 * 4;
constexpr size_t WS_SPT = WS_DEC + (size_t)NCHUNK * 128 * 4;
constexpr size_t WS_H = WS_MIX;
constexpr size_t WS_CTR = WS_SPT + (size_t)NCHUNK * 16384 * 2;
constexpr size_t WS_XB = WS_CTR + 256;
constexpr size_t WS_KF = WS_XB + 16384;
constexpr size_t WS_VF = WS_KF + (size_t)DEPTH * 2 * 4 * 8 * 16 * 512 * 2;
constexpr size_t WS_KFS = WS_VF + (size_t)DEPTH * 2 * 4 * 8 * 16 * 512 * 2;
constexpr size_t WS_VFS = WS_KFS + (size_t)DEC_B * 4 * 8 * 16 * 512 * 2;
constexpr size_t WS_END = WS_VFS + (size_t)DEC_B * 4 * 8 * 16 * 512 * 2;
constexpr int LDS_PANEL = 64 * PITCH;
constexpr int LDS_RED = LDS_PANEL;
constexpr int LDS_TOT = LDS_RED + 2048;
constexpr int LDS_RMAX = LDS_TOT + 256;
constexpr int LDS_RSUM = LDS_RMAX + 2048;
constexpr int LDS_LINV = LDS_RSUM + 2048;
constexpr int LDS_TASK = LDS_LINV + 256;
constexpr int LDS_XB = LDS_TASK + 16;
constexpr int LDS_BYTES = LDS_XB + 16;

struct Params {
  const float* x_prompt; const float* x_sample; const float* mem_prompt;
  const float* cache_sb_k; const float* cache_sb_v; const float* state_hgrn; const float* state_pool;
  const float* cache_mem_k; const float* cache_mem_v;
  const float* norm_mix_pre; const float* norm_mix_post; const float* w_in; const float* lb_logits;
  const float* onorm_g; const float* w_pool; const float* pool_scale; const float* w_out;
  const float* norm_x_pre; const float* norm_x_post; const float* norm_mem;
  const float* w_xq; const float* w_xk; const float* w_xv; const float* w_xo;
  float* out; unsigned char* ws; int ph_lo, ph_hi;
};

namespace pg8 {
#define PG8_LAS __attribute__((address_space(3)))
typedef unsigned short bf16_t;
typedef short bf16x8 __attribute__((ext_vector_type(8)));
typedef float f32x4 __attribute__((ext_vector_type(4)));
typedef unsigned u32x4 __attribute__((ext_vector_type(4)));
constexpr int BM = 256, BK = 64, HALF = 128, HTB = HALF * BK * 2  , STAGE_BYTES = 8 * HTB, NXCD = 8, WGM = 8;

__host__ __device__ __forceinline__ int lds_byte(int r, int c) { const int st = (r >> 4) * 2 + (c >> 5), rr = r & 15, cc = c & 31, ob = rr * 64 + cc * 2; return st * 1024 + (ob ^ (((ob >> 9) & 1) << 5)); }
__host__ __device__ __forceinline__ void stage_rc(int b, int& R, int& C) { const int st = b / 1024, sb = b % 1024, swz = sb ^ (((sb >> 9) & 1) << 5); R = (st >> 1) * 16 + swz / 64; C = (st & 1) * 32 + (swz % 64) / 2; }
__host__ __device__ __forceinline__ int perm32(int rho) { const int n = rho >> 4, i = rho & 15; return 8 * (i >> 2) + 4 * n + (i & 3); }

struct Unit { int pm, pn; };
struct Gemm { const bf16_t* A; const bf16_t* Bt; int M, N, K; };

struct StaticOrder {
    int nM, nN, nwg, G, c;
    __host__ __device__ void init(int M, int N, int G_, int c_) { nM = M / BM; nN = N / BM; nwg = nM * nN; G = G_; c = c_; }
    __host__ __device__ bool next(int i, Unit& u) const {
        const long L = (long)i * G + c; if (L >= nwg) return false;
        int wgid = (int)L; { const int q = nwg / NXCD, r = nwg % NXCD, xcd = wgid % NXCD, off = wgid / NXCD; wgid = (xcd < r ? xcd * (q + 1) : r * (q + 1) + (xcd - r) * q) + off; }
        const int nig = WGM * nN, gid = wgid / nig, fm = gid * WGM, gsz = (nM - fm) < WGM ? (nM - fm) : WGM;
        u.pm = fm + ((wgid % nig) % gsz); u.pn = (wgid % nig) / gsz; return true;
    }
    __device__ __forceinline__ void a_ready(const Unit&) const {}
    __device__ __forceinline__ void done(const Unit&) const {}
};

__device__ __forceinline__ unsigned cvt_pk_bf16(float lo, float hi) { unsigned r; asm volatile("v_cvt_pk_bf16_f32 %0, %1, %2" : "=v"(r) : "v"(lo), "v"(hi)); return r; }
struct EpiWin {
    static constexpr bool PERM = true, AFTER_DRAIN = false;
    bf16_t* PROJ; float* GF; float* out; const float* LB; int l; int rbase;
    __device__ __forceinline__ void operator()(const f32x4 (&acc)[2][2][4][2], const Unit& u, int wr, int wc, int fr, int fq) const {
        const int region = u.pn;
        const int row0 = rbase + u.pm * BM + wr * 64 + fr, cl0 = wc * 32 + 8 * fq;
        const bool dosilu = region < 2 || region == 6 || region == 7 || region == 11 || region == 13;
        const float sc = region < 2 ? 0.08838834764831845f : (region == 8 ? 0.125f : 1.f);
#pragma unroll
        for (int bj = 0; bj < 2; ++bj) {
            const int cl = cl0 + bj * HALF;
            f32x4 la4[2], l1m4[2];
            if (region == 2 || region == 3) {
                const float* lp = LB + (region - 2) * 256 + cl;
                la4[0] = *(const f32x4*)lp; la4[1] = *(const f32x4*)(lp + 4); l1m4[0] = *(const f32x4*)(lp + 512); l1m4[1] = *(const f32x4*)(lp + 516);
            }
#pragma unroll
            for (int ai = 0; ai < 2; ++ai)
#pragma unroll
                for (int m = 0; m < 4; ++m) {
                    const int row = row0 + ai * HALF + m * 16;
                    float v[8];
#pragma unroll
                    for (int j = 0; j < 4; ++j) { v[j] = acc[ai][bj][m][0][j]; v[4 + j] = acc[ai][bj][m][1][j]; }
                    if (region == 2 || region == 3) {
                        float o[8];
#pragma unroll
                        for (int j = 0; j < 8; ++j) {
                            const float ls = fminf(v[j], 0.f) - __logf(1.f + __expf(-fabsf(v[j])));
                            const float la = la4[j >> 2][j & 3];
                            const float bb = l1m4[j >> 2][j & 3] + ls; const float mx = fmaxf(la, bb);
                            o[j] = mx + __logf(1.f + __expf(-fabsf(la - bb)));
                        }
                        float* gp = GF + (size_t)row * 512 + (region - 2) * 256 + cl;
                        *(f32x4*)gp = (f32x4){o[0], o[1], o[2], o[3]}; *(f32x4*)(gp + 4) = (f32x4){o[4], o[5], o[6], o[7]};
                    } else {
                        float t[8];
#pragma unroll
                        for (int j = 0; j < 8; ++j) t[j] = (dosilu ? v[j] * __builtin_amdgcn_rcpf(1.f + __expf(-v[j])) : v[j]) * sc;
                        u32x4 w; w.x = cvt_pk_bf16(t[0], t[1]); w.y = cvt_pk_bf16(t[2], t[3]); w.z = cvt_pk_bf16(t[4], t[5]); w.w = cvt_pk_bf16(t[6], t[7]);
                        *(u32x4*)(PROJ + (size_t)row * 3584 + region * 256 + cl) = w;
                        if (region == 9 || region == 10 || region == 12) {
                            const bool smp = row >= 16384;
                            const int b = smp ? (row - 16384) >> 6 : row >> 13, tt = smp ? (row - 16384) & 63 : row & 8191;
                            if (region != 12) {
                                const unsigned o = smp ? (unsigned)(region == 9 ? O_SSBK : O_SSBV) + (unsigned)((l * 32 + b) * 64 + tt) * 256u : (unsigned)(region == 9 ? O_PSBK : O_PSBV) + (unsigned)((l * 2 + b) * 8192 + tt) * 256u;
                                float* op = out + (o + (unsigned)cl);
                                *(f32x4*)op = (f32x4){v[0], v[1], v[2], v[3]}; *(f32x4*)(op + 4) = (f32x4){v[4], v[5], v[6], v[7]};
                            } else {
                                const int L = smp ? 64 : 8192;
                                if (tt >= L - 15) {
                                    const unsigned o = (smp ? (unsigned)O_SPOOL + (unsigned)(l * 32 + b) * 3840u : (unsigned)O_PPOOL + (unsigned)(l * 2 + b) * 3840u) + (unsigned)(tt - (L - 15)) * 256u;
                                    float* op = out + (o + (unsigned)cl);
                                    *(f32x4*)op = (f32x4){v[0], v[1], v[2], v[3]}; *(f32x4*)(op + 4) = (f32x4){v[4], v[5], v[6], v[7]};
                                }
                            }
                        }
                    }
                }
        }
    }
};

template <class Epi, class Sched, bool STAMP = false>
__device__ __forceinline__ void gemm_phase(PG8_LAS unsigned char* lds, const Gemm g, const Sched& S, const Epi& E, unsigned long long* stamps, int tid_in) {
    const int tid = tid_in, wid = __builtin_amdgcn_readfirstlane(tid >> 6), lane = tid & 63, wr = wid >> 2, wc = wid & 3, fr = lane & 15, fq = lane >> 4;
    const int K = g.K, nt = K / BK;
    int ts_lo = 0, ts_hi = 0, nts = 0; const unsigned long long rt_entry = STAMP ? (unsigned long long)wall_clock64() : 0ull;
#define PG8_STAMP() do { if (STAMP && wid == 0 && nts < 64) { const unsigned long long _c = (unsigned long long)clock64(); \
        ts_lo = (lane == nts) ? (int)(unsigned)_c : ts_lo; ts_hi = (lane == nts) ? (int)(unsigned)(_c >> 32) : ts_hi; ++nts; } } while (0)
    PG8_STAMP();
    unsigned voffA[2], voffB[2];
#pragma unroll
    for (int i = 0; i < 2; ++i) { int R, C; stage_rc(tid * 16 + i * 8192, R, C); const int Rb = Epi::PERM ? ((R & ~31) + perm32(R & 31)) : R;
        voffA[i] = (unsigned)(R * K + C) * 2u; voffB[i] = (unsigned)(Rb * K + C) * 2u; }
    const size_t kstep = (size_t)(BK * 2);
    const size_t hstep = (size_t)HALF * K * 2;
    const size_t tstep = 2 * hstep;
    const unsigned ldsw = (unsigned)wid * 1024u;
    const int aoff = lds_byte(wr * 64 + fr, fq * 8), boff = lds_byte(wc * 32 + fr, fq * 8);
#define PG8_SA(b, h) (((b) * 2 + (h)) * HTB)
#define PG8_SB(b, h) ((4 + (b) * 2 + (h)) * HTB)
#define PG8_STAGE(bufoff, gbase, voff) do { _Pragma("unroll") for (int _i = 0; _i < 2; ++_i) \
        __builtin_amdgcn_global_load_lds((const unsigned*)((const char*)(gbase) + (voff)[_i]), (PG8_LAS unsigned*)(lds + (bufoff) + ldsw + _i * 8192), 16, 0, 0); } while (0)
#define PG8_LDA(dst, b, h) do { _Pragma("unroll") for (int m = 0; m < 4; ++m) _Pragma("unroll") for (int k = 0; k < 2; ++k) dst[m][k] = *(const PG8_LAS bf16x8*)(lds + PG8_SA(b, h) + aoff + m * 2048 + k * 1024); } while (0)
#define PG8_LDB(dst, b, h) do { _Pragma("unroll") for (int n = 0; n < 2; ++n) _Pragma("unroll") for (int k = 0; k < 2; ++k) dst[n][k] = *(const PG8_LAS bf16x8*)(lds + PG8_SB(b, h) + boff + n * 2048 + k * 1024); } while (0)
#define PG8_MMA(ai, bj, At, Bt) do { __builtin_amdgcn_s_setprio(1); _Pragma("unroll") for (int m = 0; m < 4; ++m) _Pragma("unroll") for (int n = 0; n < 2; ++n) _Pragma("unroll") for (int k = 0; k < 2; ++k) \
        acc[ai][bj][m][n] = __builtin_amdgcn_mfma_f32_16x16x32_bf16(Bt[n][k], At[m][k], acc[ai][bj][m][n], 0, 0, 0); __builtin_amdgcn_s_setprio(0); } while (0)
#define PG8_WAIT_V(n) asm volatile("s_waitcnt vmcnt(" #n ")" ::: "memory")
#define PG8_WAIT_L(n) asm volatile("s_waitcnt lgkmcnt(" #n ")" ::: "memory")
#define PG8_BAR __builtin_amdgcn_s_barrier()
#define PG8_SCHED __builtin_amdgcn_sched_barrier(0)
    Unit cur, nxt; int ui = 0;
    if (!S.next(0, cur)) return;
    f32x4 acc[2][2][4][2];
#pragma unroll
    for (int a = 0; a < 2; ++a)
#pragma unroll
        for (int b = 0; b < 2; ++b)
#pragma unroll
            for (int m = 0; m < 4; ++m)
#pragma unroll
                for (int n = 0; n < 2; ++n) acc[a][b][m][n] = (f32x4){0.f, 0.f, 0.f, 0.f};
    bf16x8 At[4][2], B0[2][2], B1[2][2];
    const char* cA = (const char*)g.A + (size_t)cur.pm * tstep; const char* cB = (const char*)g.Bt + (size_t)cur.pn * tstep;
    S.a_ready(cur);
    PG8_STAGE(PG8_SB(0, 0), cB, voffB); PG8_STAGE(PG8_SA(0, 0), cA, voffA); PG8_STAGE(PG8_SB(0, 1), cB + hstep, voffB); PG8_STAGE(PG8_SA(0, 1), cA + hstep, voffA);
    if (wr == 1) PG8_BAR;
    PG8_WAIT_V(4); PG8_BAR;
    PG8_STAGE(PG8_SB(1, 0), cB + kstep, voffB); PG8_STAGE(PG8_SA(1, 0), cA + kstep, voffA); PG8_STAGE(PG8_SB(1, 1), cB + hstep + kstep, voffB);
    PG8_WAIT_V(6); PG8_BAR;
    PG8_STAMP();
    for (;;) {
        const bool has_next = S.next(ui + 1, nxt);
        const char* nA = has_next ? (const char*)g.A + (size_t)nxt.pm * tstep : cA; const char* nB = has_next ? (const char*)g.Bt + (size_t)nxt.pn * tstep : cB;
        for (int t = 0; t < nt; t += 2) {
            const bool last = (t == nt - 2);
            const char* a1 = cA + (size_t)(t + 1) * kstep;
            const char* a2 = last ? nA : cA + (size_t)(t + 2) * kstep; const char* b2 = last ? nB : cB + (size_t)(t + 2) * kstep;
            const char* a3 = a2 + kstep; const char* b3 = b2 + kstep;
            if (last && has_next) S.a_ready(nxt);
            PG8_LDB(B0, 0, 0); PG8_SCHED; PG8_LDA(At, 0, 0); PG8_STAGE(PG8_SA(1, 1), a1 + hstep, voffA);
            PG8_WAIT_L(8); PG8_BAR; PG8_WAIT_L(0); PG8_MMA(0, 0, At, B0); PG8_BAR; PG8_SCHED;
            PG8_LDB(B1, 0, 1); PG8_STAGE(PG8_SB(0, 0), b2, voffB);
            PG8_BAR; PG8_WAIT_L(0); PG8_MMA(0, 1, At, B1); PG8_BAR;
            PG8_LDA(At, 0, 1); PG8_STAGE(PG8_SA(0, 0), a2, voffA);
            PG8_BAR; PG8_WAIT_L(0); PG8_MMA(1, 0, At, B0); PG8_BAR; PG8_SCHED;
            PG8_STAGE(PG8_SB(0, 1), b2 + hstep, voffB);
            PG8_WAIT_V(6); PG8_BAR; PG8_MMA(1, 1, At, B1); PG8_BAR;
            PG8_LDB(B0, 1, 0); PG8_SCHED; PG8_LDA(At, 1, 0); PG8_STAGE(PG8_SA(0, 1), a2 + hstep, voffA);
            PG8_WAIT_L(8); PG8_BAR; PG8_WAIT_L(0); PG8_MMA(0, 0, At, B0); PG8_BAR; PG8_SCHED;
            PG8_LDB(B1, 1, 1); PG8_STAGE(PG8_SB(1, 0), b3, voffB);
            PG8_BAR; PG8_WAIT_L(0); PG8_MMA(0, 1, At, B1); PG8_BAR;
            PG8_LDA(At, 1, 1); PG8_STAGE(PG8_SA(1, 0), a3, voffA);
            PG8_BAR; PG8_WAIT_L(0); PG8_MMA(1, 0, At, B0); PG8_BAR; PG8_SCHED;
            PG8_STAGE(PG8_SB(1, 1), b3 + hstep, voffB);
            PG8_WAIT_V(6); PG8_BAR; PG8_MMA(1, 1, At, B1); PG8_BAR;
        }
        PG8_STAMP();
        if constexpr (!Epi::AFTER_DRAIN) { E(acc, cur, wr, wc, fr, fq); S.done(cur); }
        PG8_STAMP();
        if (!has_next) break;
#pragma unroll
        for (int a = 0; a < 2; ++a)
#pragma unroll
            for (int b = 0; b < 2; ++b)
#pragma unroll
                for (int m = 0; m < 4; ++m)
#pragma unroll
                    for (int n = 0; n < 2; ++n) acc[a][b][m][n] = (f32x4){0.f, 0.f, 0.f, 0.f};
        cur = nxt; cA = nA; cB = nB; ++ui;
    }
    PG8_WAIT_V(0);
    if (wr == 0) PG8_BAR;
    PG8_BAR;
    if constexpr (Epi::AFTER_DRAIN) { E.fused(acc, cur, wr, wc, fr, fq, lds, wid, lane); S.done(cur); }
    PG8_STAMP();
    if (STAMP && wid == 0) { stamps[lane] = lane < nts ? (((unsigned long long)(unsigned)ts_hi << 32) | (unsigned)ts_lo) : 0ull;
        if (lane == 62) stamps[62] = rt_entry; if (lane == 63) stamps[63] = (unsigned long long)wall_clock64(); }
#undef PG8_STAMP
#undef PG8_SA
#undef PG8_SB
#undef PG8_STAGE
#undef PG8_LDA
#undef PG8_LDB
#undef PG8_MMA
#undef PG8_WAIT_V
#undef PG8_WAIT_L
#undef PG8_BAR
#undef PG8_SCHED
}
}

#define XB_TMO      128
#define XB_XCNT(j)  (256  + 64 * (j))
#define XB_XSUB(j)  (1280 + 64 * (j))
#define XB_XGEN(j)  (2304 + 64 * (j))
#define XB_TOP      3328
#define XB_TOPGEN   3392
#define XCD_BAR_WORDS 3456
#define XB_SPIN_CAP (1u << 18)
#define LAS __attribute__((address_space(3)))

__device__ __forceinline__ unsigned xb_ld(unsigned* p)              { return __hip_atomic_load(p, __ATOMIC_RELAXED, __HIP_MEMORY_SCOPE_AGENT); }
__device__ __forceinline__ unsigned xb_add(unsigned* p, unsigned v) { return __hip_atomic_fetch_add(p, v, __ATOMIC_RELAXED, __HIP_MEMORY_SCOPE_AGENT); }
__device__ __forceinline__ unsigned xb_xcc_id() { return (unsigned)__builtin_amdgcn_s_getreg((3 << 11) | 20) & 0xFu; }
#define XB_SPIN(cond, bar) do { unsigned _sp = 0; while (cond) { __builtin_amdgcn_s_sleep(1); \
    if ((++_sp & 255u) == 0u) { if (xb_ld(&(bar)[XB_TMO])) break; if (_sp > XB_SPIN_CAP) { atomicAdd(&(bar)[XB_TMO], 1u); break; } } } } while (0)

struct XcdBarrier {
    unsigned* bar; unsigned x;
    volatile LAS unsigned* st;
};

__device__ __forceinline__ XcdBarrier xcd_barrier_post(unsigned* bar, volatile LAS unsigned* st) {
    XcdBarrier b; b.bar = bar; b.x = xb_xcc_id(); b.st = st;
    if (threadIdx.x == 0) (void)xb_add(&bar[XB_XCNT(b.x)], 1u);
    return b;
}
__device__ __forceinline__ void xcd_barrier_complete(unsigned* bar, unsigned x, unsigned& nloc, unsigned& nx) {
    const unsigned G = gridDim.x * gridDim.y * gridDim.z;
    unsigned sum, cnt, mine, sp = 0u;
    for (;;) {
        sum = 0u; cnt = 0u; mine = 0u;
#pragma unroll
        for (unsigned j = 0; j < 16; ++j) { const unsigned c = xb_ld(&bar[XB_XCNT(j)]); sum += c; cnt += (c > 0u) ? 1u : 0u; mine = (j == x) ? c : mine; }
        if (sum == G) break;
        __builtin_amdgcn_s_sleep(1);
        if ((++sp & 255u) == 0u) { if (xb_ld(&bar[XB_TMO])) break; if (sp > XB_SPIN_CAP) { atomicAdd(&bar[XB_TMO], 1u); break; } }
    }
    nloc = mine > 0u ? mine : 1u; nx = cnt > 0u ? cnt : 1u;
}

__device__ __forceinline__ void xcd_barrier(const XcdBarrier& b) {
    asm volatile("s_waitcnt vmcnt(0)" ::: "memory");
    __syncthreads();
    if (threadIdx.x == 0) {
        unsigned* bar = b.bar;
        __builtin_amdgcn_s_waitcnt(0);
        unsigned nloc = b.st[0], nx = b.st[1];
        if (nloc == 0u) { xcd_barrier_complete(bar, b.x, nloc, nx); b.st[0] = nloc; b.st[1] = nx; }
        const unsigned old = xb_add(&bar[XB_XSUB(b.x)], 1u);
        const unsigned gen = old / nloc;
        if (old + 1u == (gen + 1u) * nloc) {
            __builtin_amdgcn_fence(__ATOMIC_RELEASE, "agent");
            asm volatile("s_waitcnt vmcnt(0)" ::: "memory");
            const unsigned og = xb_add(&bar[XB_TOP], 1u);
            const unsigned tg = og / nx;
            if (og + 1u == (tg + 1u) * nx) xb_add(&bar[XB_TOPGEN], 1u);
            else XB_SPIN(xb_ld(&bar[XB_TOPGEN]) == tg, bar);
            __builtin_amdgcn_fence(__ATOMIC_ACQUIRE, "agent");
            xb_add(&bar[XB_XGEN(b.x)], 1u);
            asm volatile("s_waitcnt vmcnt(0)" ::: "memory");
        } else {
            XB_SPIN(xb_ld(&bar[XB_XGEN(b.x)]) == gen, bar);
            __builtin_amdgcn_fence(__ATOMIC_ACQUIRE, "agent");
            asm volatile("s_waitcnt vmcnt(0)" ::: "memory");
        }
    }
    __syncthreads();
}


DI u16 f2bf(float x) { unsigned u = __float_as_uint(x); u += 0x7fffu + ((u >> 16) & 1u); return (u16)(u >> 16); }
DI float bf2f(u16 v) { return __uint_as_float(((unsigned)v) << 16); }
DI unsigned pack2(float a, float b) { return (unsigned)f2bf(a) | ((unsigned)f2bf(b) << 16); }
DI int crow(int i, int h) { return (i & 3) + 8 * (i >> 2) + 4 * h; }
DI float silu(float v) { return v / (1.f + __expf(-v)); }
DI float wave_sum(float v) { for (int o = 32; o >= 1; o >>= 1) v += __shfl_xor(v, o); return v; }
DI float half_sum(float v) { for (int o = 16; o >= 1; o >>= 1) v += __shfl_xor(v, o); return v; }
DI bf16x8 cvt8(float4 a, float4 b) {
  union { bf16x8 v; unsigned u[4]; } r;
  r.u[0] = pack2(a.x, a.y); r.u[1] = pack2(a.z, a.w); r.u[2] = pack2(b.x, b.y); r.u[3] = pack2(b.z, b.w);
  return r.v;
}
DI void st_u16(void* base, unsigned boff, u16 v) { *(u16*)((char*)base + boff) = v; }
DI void st_f32(void* base, unsigned boff, float v) { *(float*)((char*)base + boff) = v; }
DI float ld_f32(const void* base, unsigned boff) { return *(const float*)((const char*)base + boff); }
DI u16 ld_u16(const void* base, unsigned boff) { return *(const u16*)((const char*)base + boff); }
DI unsigned opaque(unsigned x) { asm volatile("" : "+v"(x)); return x; }
DI int next_task(int* ctr, unsigned char* lds, int tid) {
  int* slot = (int*)(lds + LDS_TASK);
  __syncthreads();
  if (tid == 0) *slot = atomicAdd(ctr, 1);
  __syncthreads();
  return *slot;
}
DI f32x16 zero16() { f32x16 z; for (int i = 0; i < 16; ++i) z[i] = 0.f; return z; }

template <int NT, int MT>
DI void gemm_panel(const unsigned char* panel, const u16* __restrict__ Wt, int ncol0, f32x16 (&acc)[MT][NT], int lane) {
  const int r = lane & 31, h = lane >> 5;
  const char* bu = (const char*)(Wt + (size_t)(ncol0 >> 5) * 64 * 512);
  const unsigned loff = (unsigned)lane * 16u;
  const unsigned char* ap = panel + r * PITCH + 16 * h;
  constexpr int PD = (NT == 4) ? GEMM_PD : 6;
  bf16x8 B[8][NT];
#define LOADB(t, dst) { _Pragma("unroll") for (int nt = 0; nt < NT; ++nt) dst[nt] = *(const bf16x8*)(bu + (size_t)((nt * 64 + (t)) * 1024) + loff); }
#pragma unroll
  for (int t = 0; t < PD; ++t) LOADB(t, B[t]);
#pragma unroll 1
  for (int kb = 0; kb < 8; ++kb) {
#pragma unroll
    for (int s = 0; s < 8; ++s) {
      const int t2 = (kb * 8 + s + PD) & 63;
      LOADB(t2, B[(s + PD) & 7]);
      SBAR();
      const bf16x8 a0 = *(const bf16x8*)(ap + kb * 256 + s * 32);
      bf16x8 a1 = a0; if (MT == 2) a1 = *(const bf16x8*)(ap + 32 * PITCH + kb * 256 + s * 32);
#pragma unroll
      for (int nt = 0; nt < NT; ++nt) { acc[0][nt] = MFMA32(a0, B[s][nt], acc[0][nt]); if (MT == 2) acc[MT - 1][nt] = MFMA32(a1, B[s][nt], acc[MT - 1][nt]); }
      SBAR();
    }
  }
#undef LOADB
}

template <int MT>
DI void row_rstd(const f32x16 (&acc)[MT][4], float* red, float* tot, int w, int lane, int tid) {
  const int r = lane & 31, h = lane >> 5;
#pragma unroll
  for (int mt = 0; mt < MT; ++mt)
#pragma unroll
    for (int i = 0; i < 16; ++i) {
      float v = 0.f;
#pragma unroll
      for (int nt = 0; nt < 4; ++nt) v += acc[mt][nt][i] * acc[mt][nt][i];
      v = half_sum(v);
      if (r == 0) red[w * 64 + mt * 32 + crow(i, h)] = v;
    }
  __syncthreads();
  if (tid < 64) { float s = 0.f; for (int ww = 0; ww < 8; ++ww) s += red[ww * 64 + tid]; tot[tid] = rsqrtf(s * (1.f / 1024.f) + EPS); }
  __syncthreads();
}

DI void load_norm_panel(const float* __restrict__ src, const float* __restrict__ gain, unsigned char* panel, int w, int lane) {
  float4 g[4];
#pragma unroll
  for (int j = 0; j < 4; ++j) g[j] = ((const float4*)gain)[lane + 64 * j];
#pragma unroll 1
  for (int rb = 0; rb < 2; ++rb) {
    float4 v[4][4];
#pragma unroll
    for (int rr = 0; rr < 4; ++rr)
#pragma unroll
      for (int j = 0; j < 4; ++j) v[rr][j] = ((const float4*)(src + (size_t)(w * 8 + rb * 4 + rr) * 1024))[lane + 64 * j];
    SBAR();
#pragma unroll
    for (int rr = 0; rr < 4; ++rr) {
      const int row = w * 8 + rb * 4 + rr;
      float ss = 0.f;
#pragma unroll
      for (int j = 0; j < 4; ++j) ss += v[rr][j].x * v[rr][j].x + v[rr][j].y * v[rr][j].y + v[rr][j].z * v[rr][j].z + v[rr][j].w * v[rr][j].w;
      ss = wave_sum(ss);
      const float rstd = rsqrtf(ss * (1.f / 1024.f) + EPS);
#pragma unroll
      for (int j = 0; j < 4; ++j) {
        uint2 o; o.x = pack2(v[rr][j].x * rstd * g[j].x, v[rr][j].y * rstd * g[j].y); o.y = pack2(v[rr][j].z * rstd * g[j].z, v[rr][j].w * rstd * g[j].w);
        *(uint2*)(panel + row * PITCH + (lane + 64 * j) * 8) = o;
      }
    }
  }
}

DI void norm_rows_to_global(const float* __restrict__ src, const float* __restrict__ gain, u16* __restrict__ dst, int w, int lane) {
  float4 g[4];
#pragma unroll
  for (int j = 0; j < 4; ++j) g[j] = ((const float4*)gain)[lane + 64 * j];
#pragma unroll 1
  for (int rb = 0; rb < 2; ++rb) {
    float4 v[4][4];
#pragma unroll
    for (int rr = 0; rr < 4; ++rr)
#pragma unroll
      for (int j = 0; j < 4; ++j) v[rr][j] = ((const float4*)(src + (size_t)(w * 8 + rb * 4 + rr) * 1024))[lane + 64 * j];
    SBAR();
#pragma unroll
    for (int rr = 0; rr < 4; ++rr) {
      const int row = w * 8 + rb * 4 + rr;
      float ss = 0.f;
#pragma unroll
      for (int j = 0; j < 4; ++j) ss += v[rr][j].x * v[rr][j].x + v[rr][j].y * v[rr][j].y + v[rr][j].z * v[rr][j].z + v[rr][j].w * v[rr][j].w;
      ss = wave_sum(ss);
      const float rstd = rsqrtf(ss * (1.f / 1024.f) + EPS);
#pragma unroll
      for (int j = 0; j < 4; ++j) {
        uint2 o; o.x = pack2(v[rr][j].x * rstd * g[j].x, v[rr][j].y * rstd * g[j].y); o.y = pack2(v[rr][j].z * rstd * g[j].z, v[rr][j].w * rstd * g[j].w);
        *(uint2*)(dst + (size_t)row * 1024 + (lane + 64 * j) * 4) = o;
      }
    }
  }
}

template <bool FRAG>
DI void convert_tile(const float* __restrict__ src, u16* __restrict__ dst, int K, int N, int k0, int n0, unsigned char* lds, int tid) {
  u16* T = (u16*)lds;
  {
    const int kk = tid >> 3, n8 = (tid & 7) * 8;
    const float4* s = (const float4*)(src + (size_t)(k0 + kk) * N + n0 + n8);
    const float4 a = s[0], bq = s[1];
    T[(n8 + 0) * 72 + kk] = f2bf(a.x); T[(n8 + 1) * 72 + kk] = f2bf(a.y); T[(n8 + 2) * 72 + kk] = f2bf(a.z); T[(n8 + 3) * 72 + kk] = f2bf(a.w);
    T[(n8 + 4) * 72 + kk] = f2bf(bq.x); T[(n8 + 5) * 72 + kk] = f2bf(bq.y); T[(n8 + 6) * 72 + kk] = f2bf(bq.z); T[(n8 + 7) * 72 + kk] = f2bf(bq.w);
  }
  __syncthreads();
  {
    const int n = tid >> 3, k8 = (tid & 7) * 8;
    const uint4 v = *(const uint4*)(T + n * 72 + k8);
    if (FRAG) {
      const int ng = n0 + n, kg = k0 + k8;
      const size_t off = (((size_t)(ng >> 5) * (K >> 4) + (kg >> 4)) * 64 + ((kg >> 3) & 1) * 32 + (ng & 31)) * 8;
      *(uint4*)(dst + off) = v;
    } else *(uint4*)(dst + (size_t)(n0 + n) * K + k0 + k8) = v;
  }
  __syncthreads();
}

template <bool FRAG>
DI void convert_strip(const float* __restrict__ src, u16* __restrict__ dst, int K, int N, int k0, int n0, unsigned char* lds, int tid) {
  const int kk = tid >> 3, n8 = (tid & 7) * 8;
  float4 a[4], bq[4];
#pragma unroll
  for (int q = 0; q < 4; ++q) { const float4* sp = (const float4*)(src + (size_t)(k0 + kk) * N + n0 + q * 64 + n8); a[q] = sp[0]; bq[q] = sp[1]; }
  SBAR();
#pragma unroll
  for (int q = 0; q < 4; ++q) {
    u16* T = (u16*)(lds + q * 9216);
    T[(n8 + 0) * 72 + kk] = f2bf(a[q].x); T[(n8 + 1) * 72 + kk] = f2bf(a[q].y); T[(n8 + 2) * 72 + kk] = f2bf(a[q].z); T[(n8 + 3) * 72 + kk] = f2bf(a[q].w);
    T[(n8 + 4) * 72 + kk] = f2bf(bq[q].x); T[(n8 + 5) * 72 + kk] = f2bf(bq[q].y); T[(n8 + 6) * 72 + kk] = f2bf(bq[q].z); T[(n8 + 7) * 72 + kk] = f2bf(bq[q].w);
  }
  __syncthreads();
  {
    const int n = tid >> 3, k8 = (tid & 7) * 8;
#pragma unroll
    for (int q = 0; q < 4; ++q) {
      const uint4 v = *(const uint4*)((const u16*)(lds + q * 9216) + n * 72 + k8);
      const int ng = n0 + q * 64 + n, kg = k0 + k8;
      if (FRAG) {
        const size_t off = (((size_t)(ng >> 5) * (K >> 4) + (kg >> 4)) * 64 + ((kg >> 3) & 1) * 32 + (ng & 31)) * 8;
        *(uint4*)(dst + off) = v;
      } else *(uint4*)(dst + (size_t)ng * K + kg) = v;
    }
  }
  __syncthreads();
}
__device__ __forceinline__ void phase0(const Params& p, unsigned char* lds, int tid) {
  constexpr int PER_L = 224 + 320;
  const int ntask = DEPTH * PER_L + DEPTH * 4 + 288;
  for (int task = blockIdx.x; task < ntask; task += gridDim.x) {
    if (task >= DEPTH * PER_L + DEPTH * 4) {
      const int R0 = (task - (DEPTH * PER_L + DEPTH * 4)) * 64;
      const float* src = R0 < NPROMPT ? p.x_prompt + (size_t)R0 * DM : p.x_sample + (size_t)(R0 - NPROMPT) * DM;
      norm_rows_to_global(src, p.norm_mix_pre, (u16*)(p.ws + WS_H) + (size_t)R0 * DM, __builtin_amdgcn_readfirstlane(tid >> 6), tid & 63);
    } else if (task < DEPTH * PER_L) {
      const int l = task / PER_L, rr = task % PER_L;
      if (rr < 224) {
        const int kt = rr / 14, nt = rr % 14;
        convert_strip<false>(p.w_in + (size_t)l * DM * DIN, (u16*)(p.ws + WS_WIN) + (size_t)l * DIN * DM, DM, DIN, kt * 64, nt * 256, lds, tid);
      } else {
        const int m = (rr - 224) >> 6, tt = (rr - 224) & 63;
        const float* src = (m == 0 ? p.w_out : m == 1 ? p.w_xq : m == 2 ? p.w_xk : m == 3 ? p.w_xv : p.w_xo) + (size_t)l * DM * DM;
        convert_strip<true>(src, (u16*)(p.ws + WS_WSQ) + (size_t)(l * 5 + m) * DM * DM, DM, DM, (tt >> 2) * 64, (tt & 3) * 256, lds, tid);
      }
    } else {
      const int j = task - DEPTH * PER_L;
      convert_tile<false>(p.w_pool + (size_t)j * 4096, (u16*)(p.ws + WS_WPT) + (size_t)j * 4096, 64, 64, 0, 0, lds, tid);
    }
  }
  if (blockIdx.x == 0) {
    if (tid < 64) ((int*)(p.ws + WS_CTR))[tid] = 0;
    float* LB = (float*)(p.ws + WS_LB);
    for (int c = tid; c < 512; c += NTHREADS) {
      float a[DEPTH], mx = -3.0e38f;
      for (int l = 0; l < DEPTH; ++l) { a[l] = p.lb_logits[l * 512 + c]; mx = fmaxf(mx, a[l]); }
      float s = 0.f; for (int l = 0; l < DEPTH; ++l) { a[l] = expf(a[l] - mx); s += a[l]; }
      float cum = 0.f; const float first = a[0] / s;
      for (int l = 0; l < DEPTH; ++l) { cum += a[l] / s; const float lb = fmaxf(cum - first, 0.f); LB[l * 1024 + c] = lb > 0.f ? logf(lb) : -1e30f; LB[l * 1024 + 512 + c] = log1pf(-lb); }
    }
  }
}

__device__ __forceinline__ void memkv_task(const Params& p, int j, unsigned char* lds, int tid_) {
  const int tid = (int)opaque((unsigned)tid_);
  const int w = __builtin_amdgcn_readfirstlane(tid >> 6), lane = tid & 63, r = lane & 31, h = lane >> 5;
  const int l = j >> 3, mt8 = j & 7;
  load_norm_panel(p.mem_prompt + (size_t)mt8 * 64 * DM, p.norm_mem + l * DM, lds, w, lane);
  __syncthreads();
  for (int kv = 0; kv < 2; ++kv) {
    f32x16 acc[2][4];
    for (int a = 0; a < 2; ++a) for (int c = 0; c < 4; ++c) acc[a][c] = zero16();
    gemm_panel<4, 2>(lds, (const u16*)(p.ws + WS_WSQ) + (size_t)(l * 5 + 2 + kv) * DM * DM, w * 128, acc, lane);
    float* dst = p.out + (kv ? O_PMV : O_PMK) + ((size_t)l * 512 + mt8 * 64) * DM;
    const unsigned so = opaque((unsigned)((4 * h) * DM + w * 128 + r) * 4u);
#pragma unroll
    for (int mt = 0; mt < 2; ++mt)
#pragma unroll
      for (int nt = 0; nt < 4; ++nt)
#pragma unroll
        for (int i = 0; i < 16; ++i) { st_f32(dst, so + (unsigned)((mt * 32 + (i & 3) + 8 * (i >> 2)) * DM + nt * 32) * 4u, acc[mt][nt][i]); if ((i & 7) == 7) SBAR(); }
    {
      const int b = mt8 >> 2, hh = w >> 1;
      const int lq = (int)opaque((unsigned)lane), r = lq & 31, h = lq >> 5;
      u16* fb = (u16*)(p.ws + (kv ? WS_VF : WS_KF)) + (size_t)((l * 2 + b) * 4 + hh) * 8 * 16 * 512;
#pragma unroll
      for (int mt = 0; mt < 2; ++mt)
#pragma unroll
        for (int nt = 0; nt < 4; ++nt)
#pragma unroll
          for (int i = 0; i < 16; ++i) {
            const int m = (mt8 & 3) * 64 + mt * 32 + crow(i, h);
            const int d = (w & 1) * 128 + nt * 32 + r;
            unsigned off;
            if (!kv) off = (unsigned)((((m >> 5) * 16 + (d >> 4)) * 64 + 32 * ((d >> 3) & 1) + (m & 31)) * 8 + (d & 7));
            else off = (unsigned)((((d >> 5) * 16 + (m >> 4)) * 64 + 32 * ((m >> 3) & 1) + (d & 31)) * 8 + (m & 7));
            st_u16(fb, off * 2u, f2bf(acc[mt][nt][i]));
            if ((i & 7) == 7) SBAR();
          }
    }
  }
  __syncthreads();
}

__device__ __forceinline__ void kvconv_task(const Params& p, int l, int task, int tid) {
  const int b = task >> 4, kv = (task >> 3) & 1, sub = task & 7;
  const float* src = (kv ? p.cache_mem_v : p.cache_mem_k) + (size_t)(l * DEC_B + b) * 256 * 1024;
  u16* dst = (u16*)(p.ws + (kv ? WS_VFS : WS_KFS)) + (size_t)b * 4 * 8 * 16 * 512;
  if (!kv) {
#pragma unroll 1
    for (int it = sub * 8; it < sub * 8 + 8; it += 8) {
      float4 a[8], c[8];
#pragma unroll
      for (int q = 0; q < 8; ++q) { const int pc = (it + q) * NTHREADS + tid; const float* sp = src + (size_t)pc * 8; a[q] = *(const float4*)sp; c[q] = *(const float4*)(sp + 4); }
      SBAR();
#pragma unroll
      for (int q = 0; q < 8; ++q) {
        const int pc = (it + q) * NTHREADS + tid;
        const int m = pc >> 7, hh = (pc >> 5) & 3, d8 = pc & 31;
        const unsigned off = (unsigned)((((hh * 8 + (m >> 5)) * 16 + (d8 >> 1)) * 64 + 32 * (d8 & 1) + (m & 31)) * 8);
        uint4 o; o.x = pack2(a[q].x, a[q].y); o.y = pack2(a[q].z, a[q].w); o.z = pack2(c[q].x, c[q].y); o.w = pack2(c[q].z, c[q].w);
        *(uint4*)(dst + off) = o;
      }
    }
  } else {
#pragma unroll 1
    for (int it = sub * 8; it < sub * 8 + 8; it += 2) {
      float v[2][8];
#pragma unroll
      for (int q = 0; q < 2; ++q) {
        const int pc = (it + q) * NTHREADS + tid;
        const int m8 = pc >> 10, cc = pc & 1023;
#pragma unroll
        for (int j = 0; j < 8; ++j) v[q][j] = src[(size_t)(m8 * 8 + j) * 1024 + cc];
      }
      SBAR();
#pragma unroll
      for (int q = 0; q < 2; ++q) {
        const int pc = (it + q) * NTHREADS + tid;
        const int m8 = pc >> 10, hh = (pc >> 8) & 3, d = pc & 255;
        const unsigned off = (unsigned)((((hh * 8 + (d >> 5)) * 16 + (m8 >> 1)) * 64 + 32 * (m8 & 1) + (d & 31)) * 8);
        uint4 o; o.x = pack2(v[q][0], v[q][1]); o.y = pack2(v[q][2], v[q][3]); o.z = pack2(v[q][4], v[q][5]); o.w = pack2(v[q][6], v[q][7]);
        *(uint4*)(dst + off) = o;
      }
    }
  }
}

DI void hgrn_load_G(const float* __restrict__ GF, int R0, int hd, float (&g)[16], float (&G)[16], float& GL, float& Gm, float* qtot, int tid) {
  const int k = tid & 127, q4 = tid >> 7;
  float run = 0.f;
#pragma unroll
  for (int j = 0; j < 16; ++j) g[j] = GF[(size_t)(R0 + q4 * 16 + j) * 512 + hd * 128 + k];
  SBAR();
#pragma unroll
  for (int j = 0; j < 16; ++j) { run += g[j]; G[j] = run; }
  qtot[q4 * 128 + k] = run;
  __syncthreads();
  const float q0 = qtot[k], q1 = qtot[128 + k], q2 = qtot[256 + k], q3 = qtot[384 + k];
  const float off = (q4 > 0 ? q0 : 0.f) + (q4 > 1 ? q1 : 0.f) + (q4 > 2 ? q2 : 0.f);
#pragma unroll
  for (int j = 0; j < 16; ++j) G[j] += off;
  GL = q0 + q1 + q2 + q3; Gm = q0 + q1;
}
DI void chunk_rows(int task, int& R0, int& hd) {
  if (task < 1024) { const int sh = task >> 7, c = task & 127; R0 = (sh >> 2) * SEQ + c * 64; hd = sh & 3; }
  else { const int sh = task - 1024; R0 = NPROMPT + (sh >> 2) * 64; hd = sh & 3; }
}

__device__ __forceinline__ void hgrn_passA(const Params& p, int task, unsigned char* lds, int tid) {
  const int w = __builtin_amdgcn_readfirstlane(tid >> 6), lane = tid & 63, r = lane & 31, h = lane >> 5;
  float* qtot = (float*)lds;
  u16* KT = (u16*)(lds + 2048);
  u16* VT = (u16*)(lds + 2048 + 128 * 144);
  const u16* PROJ = (const u16*)(p.ws + WS_PROJ);
  int R0, hd; chunk_rows(task, R0, hd);
  const int k = tid & 127, q4 = tid >> 7;
  u16 vraw[16];
#pragma unroll
  for (int j = 0; j < 16; ++j) vraw[j] = PROJ[(size_t)(R0 + q4 * 16 + j) * DIN + C_AI + hd * 128 + k];
  float g[16], G[16], GL, Gm;
  hgrn_load_G((const float*)(p.ws + WS_GF), R0, hd, g, G, GL, Gm, qtot, tid);
#pragma unroll
  for (int j = 0; j < 16; ++j) {
    const int s = q4 * 16 + j;
    KT[k * 72 + s] = f2bf((1.f - __expf(g[j])) * __expf(GL - G[j]));
    VT[k * 72 + s] = vraw[j];
  }
  if (q4 == 0) ((float*)(p.ws + WS_DEC))[(size_t)task * 128 + k] = __expf(GL);
  __syncthreads();
  const int vt = w >> 1, kt0 = (w & 1) * 2;
  f32x16 acc[2]; acc[0] = zero16(); acc[1] = zero16();
#pragma unroll
  for (int ss = 0; ss < 4; ++ss) {
    const bf16x8 a = *(const bf16x8*)(VT + (vt * 32 + r) * 72 + 16 * ss + 8 * h);
#pragma unroll
    for (int q = 0; q < 2; ++q) {
      const bf16x8 bb = *(const bf16x8*)(KT + ((kt0 + q) * 32 + r) * 72 + 16 * ss + 8 * h);
      acc[q] = MFMA32(a, bb, acc[q]);
    }
  }
  float* DS = (float*)(p.ws + WS_DS) + (size_t)task * 16384;
#pragma unroll
  for (int q = 0; q < 2; ++q)
#pragma unroll
    for (int i = 0; i < 16; ++i) DS[(vt * 32 + crow(i, h)) * 128 + (kt0 + q) * 32 + r] = acc[q][i];
  __syncthreads();
}

__device__ __forceinline__ void hgrn_scan_unit(const Params& p, int l, int unit, unsigned char* lds, int tid) {
  float* tmp = (float*)lds;
  const float* DS = (const float*)(p.ws + WS_DS);
  const float* DEC = (const float*)(p.ws + WS_DEC);
  u16* SPT = (u16*)(p.ws + WS_SPT);
  if (unit < 128) {
    const int sh = unit >> 4, v0 = (unit & 15) * 8;
    const int v = tid >> 6, k2 = (tid & 63) * 2;
    const int ka = tid >> 2, va = (tid & 3) * 2;
    float s0 = 0.f, s1 = 0.f;
    const unsigned eoff = (unsigned)((v0 + v) * 128 + k2);
    const float* dsb = DS + (size_t)(sh * 128) * 16384;
    const float* dcb = DEC + (size_t)(sh * 128) * 128;
    u16* spb = SPT + (size_t)(sh * 128) * 16384;
#pragma unroll 1
    for (int c0 = 0; c0 < 128; c0 += 16) {
      float2 d[16], dc[16];
#pragma unroll
      for (int j = 0; j < 16; ++j) { d[j] = *(const float2*)(dsb + (size_t)(c0 + j) * 16384 + eoff); dc[j] = *(const float2*)(dcb + (c0 + j) * 128 + k2); }
      SBAR();
#pragma unroll
      for (int j = 0; j < 16; ++j) {
        *(unsigned*)(spb + (size_t)(c0 + j) * 16384 + eoff) = pack2(s0, s1);
        s0 = dc[j].x * s0 + d[j].x; s1 = dc[j].y * s1 + d[j].y;
      }
    }
    tmp[v * 130 + k2] = s0; tmp[v * 130 + k2 + 1] = s1;
    __syncthreads();
    float2 o; o.x = tmp[va * 130 + ka]; o.y = tmp[(va + 1) * 130 + ka];
    *(float2*)(p.out + O_PHS + ((size_t)l * 8 + sh) * 16384 + (size_t)ka * 128 + v0 + va) = o;
    __syncthreads();
  } else {
    const int u = unit - 128, ss = u >> 2, v0 = (u & 3) * 32;
    const int task = 1024 + ss;
    const int ka = tid >> 2, va = (tid & 3) * 8;
    const int v = tid >> 4, k8 = (tid & 15) * 8;
    const float* st = p.state_hgrn + ((size_t)l * 128 + ss) * 16384 + (size_t)ka * 128 + v0 + va;
    const float4 x0 = *(const float4*)st, x1 = *(const float4*)(st + 4);
    const float* dp = DS + (size_t)task * 16384 + (size_t)(v0 + v) * 128 + k8;
    const float4 d0 = *(const float4*)dp, d1 = *(const float4*)(dp + 4);
    const float* cp = DEC + (size_t)task * 128 + k8;
    const float4 c0 = *(const float4*)cp, c1 = *(const float4*)(cp + 4);
    SBAR();
    tmp[(va + 0) * 129 + ka] = x0.x; tmp[(va + 1) * 129 + ka] = x0.y; tmp[(va + 2) * 129 + ka] = x0.z; tmp[(va + 3) * 129 + ka] = x0.w;
    tmp[(va + 4) * 129 + ka] = x1.x; tmp[(va + 5) * 129 + ka] = x1.y; tmp[(va + 6) * 129 + ka] = x1.z; tmp[(va + 7) * 129 + ka] = x1.w;
    __syncthreads();
    float sv[8];
#pragma unroll
    for (int j = 0; j < 8; ++j) sv[j] = tmp[v * 129 + k8 + j];
    uint4 pk; pk.x = pack2(sv[0], sv[1]); pk.y = pack2(sv[2], sv[3]); pk.z = pack2(sv[4], sv[5]); pk.w = pack2(sv[6], sv[7]);
    *(uint4*)(SPT + (size_t)task * 16384 + (size_t)(v0 + v) * 128 + k8) = pk;
    __syncthreads();
    tmp[v * 129 + k8 + 0] = c0.x * sv[0] + d0.x; tmp[v * 129 + k8 + 1] = c0.y * sv[1] + d0.y; tmp[v * 129 + k8 + 2] = c0.z * sv[2] + d0.z; tmp[v * 129 + k8 + 3] = c0.w * sv[3] + d0.w;
    tmp[v * 129 + k8 + 4] = c1.x * sv[4] + d1.x; tmp[v * 129 + k8 + 5] = c1.y * sv[5] + d1.y; tmp[v * 129 + k8 + 6] = c1.z * sv[6] + d1.z; tmp[v * 129 + k8 + 7] = c1.w * sv[7] + d1.w;
    __syncthreads();
    float4 o0, o1;
    o0.x = tmp[(va + 0) * 129 + ka]; o0.y = tmp[(va + 1) * 129 + ka]; o0.z = tmp[(va + 2) * 129 + ka]; o0.w = tmp[(va + 3) * 129 + ka];
    o1.x = tmp[(va + 4) * 129 + ka]; o1.y = tmp[(va + 5) * 129 + ka]; o1.z = tmp[(va + 6) * 129 + ka]; o1.w = tmp[(va + 7) * 129 + ka];
    float* fp = p.out + O_SHS + ((size_t)l * 128 + ss) * 16384 + (size_t)ka * 128 + v0 + va;
    *(float4*)fp = o0; *(float4*)(fp + 4) = o1;
    __syncthreads();
  }
}

__device__ __forceinline__ void hgrn_passC(const Params& p, int l, int task, unsigned char* lds, int tid) {
  const int w = __builtin_amdgcn_readfirstlane(tid >> 6), lane = tid & 63, r = lane & 31, h = lane >> 5;
  float* qtot = (float*)lds;
  u16* Qm = (u16*)(lds + 2048);
  u16* Km = (u16*)(lds + 2048 + 17408);
  u16* QS = (u16*)(lds + 2048 + 2 * 17408);
  u16* VT = (u16*)(lds + 2048 + 3 * 17408);
  u16* ATT = (u16*)(lds + 2048 + 3 * 17408 + 18432);
  float* psum = (float*)(lds + 2048 + 3 * 17408 + 18432 + 9216);
  const u16* PROJ = (const u16*)(p.ws + WS_PROJ);
  int R0, hd; chunk_rows(task, R0, hd);
  bf16x8 spf[8];
  {
    const u16* SPp = (const u16*)(p.ws + WS_SPT) + (size_t)task * 16384 + (size_t)((w & 3) * 32 + r) * 128 + 8 * h;
#pragma unroll
    for (int sk = 0; sk < 8; ++sk) spf[sk] = *(const bf16x8*)(SPp + 16 * sk);
  }
  const float og = p.onorm_g[l * 512 + hd * 128 + (w & 3) * 32 + r];
  u16 graw[16];
#pragma unroll
  for (int i = 0; i < 16; ++i) graw[i] = PROJ[(size_t)(R0 + (w >> 2) * 32 + crow(i, h)) * DIN + C_AG + hd * 128 + (w & 3) * 32 + r];
  u16 qraw[16], vraw[16];
  {
    const int k = tid & 127, q4 = tid >> 7;
#pragma unroll
    for (int j = 0; j < 16; ++j) { qraw[j] = PROJ[(size_t)(R0 + q4 * 16 + j) * DIN + C_AQ + hd * 128 + k]; vraw[j] = PROJ[(size_t)(R0 + q4 * 16 + j) * DIN + C_AI + hd * 128 + k]; }
  }
  float g[16], G[16], GL, Gm;
  hgrn_load_G((const float*)(p.ws + WS_GF), R0, hd, g, G, GL, Gm, qtot, tid);
  {
    const int k = tid & 127, q4 = tid >> 7;
#pragma unroll
    for (int j = 0; j < 16; ++j) {
      const int s = q4 * 16 + j;
      const float q = bf2f(qraw[j]);
      const float d1 = fminf(fmaxf(G[j] - Gm, -80.f), 80.f);
      Qm[s * 136 + k] = f2bf(q * __expf(d1));
      Km[s * 136 + k] = f2bf((1.f - __expf(g[j])) * __expf(-d1));
      QS[s * 136 + k] = f2bf(q * __expf(G[j]));
      VT[k * 72 + s] = vraw[j];
    }
  }
  __syncthreads();
  if (w < 4) {
    const int tt = w >> 1, st = w & 1;
    f32x16 a = zero16();
    if (st <= tt) {
#pragma unroll
      for (int sk = 0; sk < 8; ++sk) {
        const bf16x8 fa = *(const bf16x8*)(Qm + (tt * 32 + r) * 136 + 16 * sk + 8 * h);
        const bf16x8 fb = *(const bf16x8*)(Km + (st * 32 + r) * 136 + 16 * sk + 8 * h);
        a = MFMA32(fa, fb, a);
      }
    }
    const int s = st * 32 + r;
#pragma unroll
    for (int i = 0; i < 16; ++i) {
      const int t = tt * 32 + crow(i, h);
      ATT[t * 72 + s] = (st <= tt && s <= t) ? f2bf(a[i]) : (u16)0;
    }
  }
  __syncthreads();
  const int tt = w >> 2, vt = w & 3;
  f32x16 o = zero16();
#pragma unroll
  for (int ss = 0; ss < 4; ++ss) {
    const bf16x8 fa = *(const bf16x8*)(ATT + (tt * 32 + r) * 72 + 16 * ss + 8 * h);
    const bf16x8 fb = *(const bf16x8*)(VT + (vt * 32 + r) * 72 + 16 * ss + 8 * h);
    o = MFMA32(fa, fb, o);
  }
#pragma unroll
  for (int sk = 0; sk < 8; ++sk) {
    const bf16x8 fa = *(const bf16x8*)(QS + (tt * 32 + r) * 136 + 16 * sk + 8 * h);
    o = MFMA32(fa, spf[sk], o);
  }
#pragma unroll
  for (int i = 0; i < 16; ++i) {
    const float v = half_sum(o[i] * o[i]);
    if (r == 0) psum[vt * 64 + tt * 32 + crow(i, h)] = v;
  }
  __syncthreads();
  const int v = vt * 32 + r;
  u16* MIX = (u16*)(p.ws + WS_MIX);
#pragma unroll
  for (int i = 0; i < 16; ++i) {
    const int t = tt * 32 + crow(i, h);
    const float ssq = psum[t] + psum[64 + t] + psum[128 + t] + psum[192 + t];
    const float rstd = rsqrtf(ssq * (1.f / 128.f) + EPS);
    const size_t row = (size_t)(R0 + t);
    MIX[row * DM + hd * 128 + v] = f2bf(o[i] * rstd * og * bf2f(graw[i]));
  }
  __syncthreads();
}

__device__ __forceinline__ void sb_wave(const Params& p, int l, int grp, int b, int head, int q0, int lane) {
  const int r = lane & 31, h = lane >> 5;
  const u16* PROJ = (const u16*)(p.ws + WS_PROJ);
  const int Rbase = grp ? NPROMPT + b * 64 : b * SEQ;
  const int past = grp ? PAST : 0;
  const float* ck = p.cache_sb_k + (size_t)(l * DEC_B + b) * PAST * 256;
  const float* cv = p.cache_sb_v + (size_t)(l * DEC_B + b) * PAST * 256;
  bf16x8 qf[4];
#pragma unroll
  for (int s = 0; s < 4; ++s) qf[s] = *(const bf16x8*)(PROJ + (size_t)(Rbase + q0 + r) * DIN + C_BQ + head * 64 + 16 * s + 8 * h);
  const int qpos = past + q0 + r;
  float carry = 0.f;
  f32x16 O[2]; O[0] = zero16(); O[1] = zero16();
  const int T0 = (past + q0) >> 5;
  unsigned raw[64];
#define SB_ISSUE(T_) do { const int Tn_ = (T_); \
    if (Tn_ * 32 >= past) { \
      const u16* kp_ = PROJ + (size_t)(Rbase + Tn_ * 32 - past + r) * DIN + C_BK + head * 64 + 8 * h; \
      _Pragma("unroll") for (int s_ = 0; s_ < 4; ++s_) { const uint4 t_ = *(const uint4*)(kp_ + 16 * s_); raw[4 * s_] = t_.x; raw[4 * s_ + 1] = t_.y; raw[4 * s_ + 2] = t_.z; raw[4 * s_ + 3] = t_.w; } \
      const u16* vp_ = PROJ + (size_t)(Rbase + Tn_ * 32 - past + 4 * h) * DIN + C_BV + head * 64 + r; \
      _Pragma("unroll") for (int e_ = 0; e_ < 32; ++e_) raw[16 + e_] = vp_[(size_t)(16 * (e_ >> 4) + 8 * ((e_ >> 2) & 1) + (e_ & 3)) * DIN + ((e_ >> 3) & 1) * 32]; \
    } else { \
      const float* kp_ = ck + (size_t)(Tn_ * 32 + r) * 256 + head * 64 + 8 * h; \
      _Pragma("unroll") for (int s_ = 0; s_ < 8; ++s_) { const uint4 t_ = *(const uint4*)(kp_ + 16 * (s_ >> 1) + 4 * (s_ & 1)); raw[4 * s_] = t_.x; raw[4 * s_ + 1] = t_.y; raw[4 * s_ + 2] = t_.z; raw[4 * s_ + 3] = t_.w; } \
      const float* vp_ = cv + (size_t)(Tn_ * 32 + 4 * h) * 256 + head * 64 + r; \
      _Pragma("unroll") for (int e_ = 0; e_ < 32; ++e_) raw[32 + e_] = __float_as_uint(vp_[(size_t)(16 * (e_ >> 4) + 8 * ((e_ >> 2) & 1) + (e_ & 3)) * 256 + ((e_ >> 3) & 1) * 32]); \
    } } while (0)
  SB_ISSUE(T0);
  for (int T = T0; T >= 0; --T) {
    const bool isnew = T * 32 >= past;
    union { bf16x8 v; unsigned u[4]; } kf[4], vf[2][2];
    if (isnew) {
#pragma unroll
      for (int s = 0; s < 4; ++s)
#pragma unroll
        for (int j = 0; j < 4; ++j) kf[s].u[j] = raw[4 * s + j];
#pragma unroll
      for (int s = 0; s < 2; ++s)
#pragma unroll
        for (int dt = 0; dt < 2; ++dt)
#pragma unroll
          for (int j = 0; j < 4; ++j) vf[s][dt].u[j] = (raw[16 + s * 16 + dt * 8 + 2 * j] & 0xffffu) | (raw[16 + s * 16 + dt * 8 + 2 * j + 1] << 16);
    } else {
#pragma unroll
      for (int s = 0; s < 4; ++s)
#pragma unroll
        for (int j = 0; j < 4; ++j) kf[s].u[j] = pack2(__uint_as_float(raw[8 * s + 2 * j]), __uint_as_float(raw[8 * s + 2 * j + 1]));
#pragma unroll
      for (int s = 0; s < 2; ++s)
#pragma unroll
        for (int dt = 0; dt < 2; ++dt)
#pragma unroll
          for (int j = 0; j < 4; ++j) vf[s][dt].u[j] = pack2(__uint_as_float(raw[32 + s * 16 + dt * 8 + 2 * j]), __uint_as_float(raw[32 + s * 16 + dt * 8 + 2 * j + 1]));
    }
    if (T > 0) SB_ISSUE(T - 1);
    SBAR();
    f32x16 z = zero16();
#pragma unroll
    for (int s = 0; s < 4; ++s) z = MFMA32(kf[s].v, qf[s], z);
    float lsm[16]; bool msk[16];
#pragma unroll
    for (int i = 0; i < 16; ++i) {
      msk[i] = (T * 32 + crow(i, h)) < qpos;
      const float sp = fmaxf(z[i], 0.f) + __logf(1.f + __expf(-fabsf(z[i])));
      lsm[i] = msk[i] ? -sp : 0.f;
    }
    float town[4], toth[4];
#pragma unroll
    for (int g = 0; g < 4; ++g) {
      lsm[4 * g + 2] += lsm[4 * g + 3]; lsm[4 * g + 1] += lsm[4 * g + 2]; lsm[4 * g + 0] += lsm[4 * g + 1];
      town[g] = lsm[4 * g];
    }
#pragma unroll
    for (int g = 0; g < 4; ++g) toth[g] = __shfl_xor(town[g], 32);
    float spair = 0.f;
    float ag[4];
#pragma unroll
    for (int g = 3; g >= 0; --g) { ag[g] = spair + (h == 0 ? toth[g] : 0.f); spair += town[g] + toth[g]; }
    union { bf16x8 v; unsigned u[4]; } pf[2];
#pragma unroll
    for (int i = 0; i < 16; i += 2) {
      const float w0 = msk[i] ? __expf(z[i] + lsm[i] + ag[i >> 2] + carry) : 0.f;
      const float w1 = msk[i + 1] ? __expf(z[i + 1] + lsm[i + 1] + ag[i >> 2] + carry) : 0.f;
      pf[i >> 3].u[(i & 7) >> 1] = pack2(w0, w1);
    }
    carry += spair;
#pragma unroll
    for (int s = 0; s < 2; ++s)
#pragma unroll
      for (int dt = 0; dt < 2; ++dt) O[dt] = MFMA32(pf[s].v, vf[s][dt].v, O[dt]);
    if (__all(carry < -110.f)) break;
  }
#undef SB_ISSUE
  u16* MIX = (u16*)(p.ws + WS_MIX);
#pragma unroll
  for (int dt = 0; dt < 2; ++dt)
#pragma unroll
    for (int i = 0; i < 16; ++i) {
      const size_t row = (size_t)(Rbase + q0 + crow(i, h));
      const int d = head * 64 + dt * 32 + r;
      const float gate = bf2f(PROJ[row * DIN + C_BG + d]);
      MIX[row * DM + 512 + d] = f2bf(O[dt][i] * gate);
    }
}

__device__ __forceinline__ void pool_tile(const Params& p, int l, int R0, unsigned char* lds, int tid) {
  const int w = __builtin_amdgcn_readfirstlane(tid >> 6), lane = tid & 63, r = lane & 31, h = lane >> 5;
  float* E = (float*)lds;
  const int g = w >> 1, mt = w & 1;
  float psc[2];
#pragma unroll
  for (int nt = 0; nt < 2; ++nt) psc[nt] = p.pool_scale[l * 256 + g * 64 + nt * 32 + r];
  u16 pg[2][16];
#pragma unroll
  for (int nt = 0; nt < 2; ++nt)
#pragma unroll
    for (int i = 0; i < 16; ++i) pg[nt][i] = ((const u16*)(p.ws + WS_PROJ))[(size_t)(R0 + mt * 32 + crow(i, h)) * DIN + C_CG + g * 64 + nt * 32 + r];
  u16* D = (u16*)(lds + 79 * 1024);
  const u16* PROJ = (const u16*)(p.ws + WS_PROJ);
  const int grp = R0 >= NPROMPT;
  const int b = grp ? (R0 - NPROMPT) >> 6 : R0 >> 13;
  const int t0 = grp ? 0 : (R0 & (SEQ - 1));
  const int past = grp ? PAST : 0;
  {
    const int c4 = (tid & 63) * 4, rg = tid >> 6;
    uint2 raw[10];
#pragma unroll
    for (int q = 0; q < 10; ++q) {
      const int j = rg + 8 * q, t = t0 - 15 + j;
      raw[q] = make_uint2(0u, 0u);
      if (j < 79 && t >= 0) raw[q] = *(const uint2*)(PROJ + (size_t)(R0 - t0 + t) * DIN + C_CU + c4);
    }
    SBAR();
#pragma unroll
    for (int q = 0; q < 10; ++q) {
      const int j = rg + 8 * q, t = t0 - 15 + j;
      if (j < 79) {
        float4 v;
        if (t >= 0) { v.x = bf2f((u16)(raw[q].x & 0xffff)); v.y = bf2f((u16)(raw[q].x >> 16)); v.z = bf2f((u16)(raw[q].y & 0xffff)); v.w = bf2f((u16)(raw[q].y >> 16)); }
        else if (grp) v = *(const float4*)(p.state_pool + ((size_t)(l * DEC_B + b) * 15 + (15 + t)) * 256 + c4);
        else v = make_float4(0.f, 0.f, 0.f, 0.f);
        *(float4*)(E + j * 256 + c4) = v;
      }
    }
  }
  __syncthreads();
  for (int e = tid; e < 64 * 256; e += NTHREADS) {
    const int t = e >> 8, c = e & 255;
    const int wdw = 2 << (c >> 6);
    float s = 0.f;
    for (int j = 0; j < wdw; ++j) s += E[(15 + t - j) * 256 + c];
    const int pos = past + t0 + t;
    const float cnt = (float)min(pos + 1, wdw);
    D[t * 264 + c] = f2bf(s / cnt - E[(15 + t) * 256 + c]);
  }
  __syncthreads();
  const u16* WP = (const u16*)(p.ws + WS_WPT) + (size_t)(l * 4 + g) * 4096;
  f32x16 acc[2]; acc[0] = zero16(); acc[1] = zero16();
#pragma unroll
  for (int s = 0; s < 4; ++s) {
    const bf16x8 a = *(const bf16x8*)(D + (mt * 32 + r) * 264 + g * 64 + 16 * s + 8 * h);
#pragma unroll
    for (int nt = 0; nt < 2; ++nt) {
      const bf16x8 bb = *(const bf16x8*)(WP + (nt * 32 + r) * 64 + 16 * s + 8 * h);
      acc[nt] = MFMA32(a, bb, acc[nt]);
    }
  }
  u16* MIX = (u16*)(p.ws + WS_MIX);
#pragma unroll
  for (int nt = 0; nt < 2; ++nt) {
    const int d = g * 64 + nt * 32 + r;
    const float sc = psc[nt];
#pragma unroll
    for (int i = 0; i < 16; ++i) {
      const size_t row = (size_t)(R0 + mt * 32 + crow(i, h));
      MIX[row * DM + 768 + d] = f2bf(acc[nt][i] * sc * bf2f(pg[nt][i]));
    }
  }
  __syncthreads();
}

__device__ __forceinline__ void phase_mix1(const Params& p, int l, int grp, int* ctr, unsigned char* lds, int tid_) {
  const int nmk = (grp == 0 && l == 0) ? 16 : 0;
  const int nsb = grp ? 32 : 256, npl = grp ? 32 : 256, npa = grp ? 128 : 1024;
  const int ntask = nmk + nsb + npl + npa;
  for (;;) {
    const int task = next_task(ctr, lds, tid_);
    if (task >= ntask) break;
    const int tid = (int)opaque((unsigned)tid_);
    const int w = __builtin_amdgcn_readfirstlane(tid >> 6), lane = tid & 63;
    if (task < nmk) memkv_task(p, task, lds, tid);
    else if (task < nmk + nsb) {
      const int t = task - nmk;
      if (!grp) { const int b = t >> 7, rem = t & 127; sb_wave(p, l, 0, b, rem >> 5, (rem & 31) * 256 + w * 32, lane); }
      else { sb_wave(p, l, 1, t, w >> 1, (w & 1) * 32, lane); }
    } else if (task < nmk + nsb + npl) pool_tile(p, l, ((grp ? 256 : 0) + task - nmk - nsb) * 64, lds, tid);
    else hgrn_passA(p, (grp ? 1024 : 0) + task - nmk - nsb - npl, lds, tid);
  }
}

template <int MT>
__device__ __forceinline__ void chain_tile(const Params& p, int l, int R0, unsigned char* lds, int tid_) {
  const int tid = (int)opaque((unsigned)tid_);
  const int w = __builtin_amdgcn_readfirstlane(tid >> 6), lane = tid & 63, r = lane & 31, h = lane >> 5;
  unsigned char* panel = lds;
  float* red = (float*)(lds + LDS_RED); float* tot = (float*)(lds + LDS_TOT);
  float* rmax = (float*)(lds + LDS_RMAX); float* rsum = (float*)(lds + LDS_RSUM); float* linv = (float*)(lds + LDS_LINV);
  const int grp = R0 >= NPROMPT;
  const int b = grp ? (R0 - NPROMPT) >> 6 : R0 >> 13;
  const u16* WSQ = (const u16*)(p.ws + WS_WSQ) + (size_t)l * 5 * DM * DM;
  float* Y = p.out + O_Y;
  const float* xsrc = (l == 0) ? (grp ? p.x_sample - (size_t)NPROMPT * DM : p.x_prompt) : (const float*)Y;
  const unsigned yo_ = ((unsigned)(R0 + 4 * h) * (unsigned)DM + (unsigned)(w * 128 + r)) * 4u;
  {
    const u16* MIX = (const u16*)(p.ws + WS_MIX) + (size_t)R0 * DM;
#pragma unroll 1
    for (int jb = 0; jb < 8 * MT; jb += 8) {
      const unsigned e0 = (unsigned)(tid + jb * NTHREADS);
#define MIXOFF(j) (unsigned)((((e0 + (j) * NTHREADS) >> 7) * DM + ((e0 + (j) * NTHREADS) & 127) * 8) * 2)
#define PANOFF(j) (((e0 + (j) * NTHREADS) >> 7) * PITCH + ((e0 + (j) * NTHREADS) & 127) * 16)
      const uint4 t0 = *(const uint4*)((const char*)MIX + MIXOFF(0)), t1 = *(const uint4*)((const char*)MIX + MIXOFF(1)), t2 = *(const uint4*)((const char*)MIX + MIXOFF(2)), t3 = *(const uint4*)((const char*)MIX + MIXOFF(3));
      const uint4 t4 = *(const uint4*)((const char*)MIX + MIXOFF(4)), t5 = *(const uint4*)((const char*)MIX + MIXOFF(5)), t6 = *(const uint4*)((const char*)MIX + MIXOFF(6)), t7 = *(const uint4*)((const char*)MIX + MIXOFF(7));
      SBAR();
      *(uint4*)(panel + PANOFF(0)) = t0; *(uint4*)(panel + PANOFF(1)) = t1; *(uint4*)(panel + PANOFF(2)) = t2; *(uint4*)(panel + PANOFF(3)) = t3;
      *(uint4*)(panel + PANOFF(4)) = t4; *(uint4*)(panel + PANOFF(5)) = t5; *(uint4*)(panel + PANOFF(6)) = t6; *(uint4*)(panel + PANOFF(7)) = t7;
    }
  }
  __syncthreads();
  f32x16 acc[MT][4];
#define ZACC() { _Pragma("unroll") for (int a_ = 0; a_ < MT; ++a_) _Pragma("unroll") for (int c_ = 0; c_ < 4; ++c_) acc[a_][c_] = zero16(); }
  ZACC();
  gemm_panel<4, MT>(panel, WSQ + (size_t)0 * DM * DM, w * 128, acc, lane);
  float gnv0[4];
  { const float* gp_ = p.norm_mix_post + l * DM;
  _Pragma("unroll") for (int nt = 0; nt < 4; ++nt) gnv0[nt] = gp_[w * 128 + nt * 32 + r]; }
  row_rstd<MT>(acc, red, tot, w, lane, tid);
  {
    const float* npost = p.norm_mix_post + l * DM;
    const unsigned yo = opaque(yo_);
#pragma unroll
    for (int nt = 0; nt < 4; ++nt) {
      const int col = w * 128 + nt * 32 + r; const float gn = gnv0[nt];
      float xv[MT][16];
#pragma unroll
      for (int mt = 0; mt < MT; ++mt)
#pragma unroll
        for (int i = 0; i < 16; ++i) xv[mt][i] = ld_f32(xsrc, yo + (unsigned)((mt * 32 + (i & 3) + 8 * (i >> 2)) * DM + nt * 32) * 4u);
      SBAR();
#pragma unroll
      for (int mt = 0; mt < MT; ++mt)
#pragma unroll
        for (int i = 0; i < 16; ++i) {
          const unsigned bo = yo + (unsigned)((mt * 32 + (i & 3) + 8 * (i >> 2)) * DM + nt * 32) * 4u;
          const float x1 = xv[mt][i] + acc[mt][nt][i] * tot[4 * h + mt * 32 + (i & 3) + 8 * (i >> 2)] * gn;
          acc[mt][nt][i] = x1; st_f32(Y, bo, x1);
        }
      SBAR();
    }
  }
  float gnv1[4];
  { const float* gp_ = p.norm_x_pre + l * DM;
  _Pragma("unroll") for (int nt = 0; nt < 4; ++nt) gnv1[nt] = gp_[w * 128 + nt * 32 + r]; }
  row_rstd<MT>(acc, red, tot, w, lane, tid);
  {
    const float* g2 = p.norm_x_pre + l * DM;
    const unsigned pwo = opaque((unsigned)(4 * h * PITCH + (w * 128 + r) * 2));
#pragma unroll
    for (int nt = 0; nt < 4; ++nt) {
      const int col = w * 128 + nt * 32 + r; const float gn = gnv1[nt];
#pragma unroll
      for (int mt = 0; mt < MT; ++mt)
#pragma unroll
        for (int i = 0; i < 16; ++i)
          *(u16*)(panel + pwo + (mt * 32 + (i & 3) + 8 * (i >> 2)) * PITCH + nt * 64) = f2bf(acc[mt][nt][i] * tot[4 * h + mt * 32 + (i & 3) + 8 * (i >> 2)] * gn);
    }
  }
  __syncthreads();
  ZACC();
  gemm_panel<4, MT>(panel, WSQ + (size_t)1 * DM * DM, w * 128, acc, lane);
  __syncthreads();
  { const unsigned pwo = opaque((unsigned)(4 * h * PITCH + (w * 128 + r) * 2));
#pragma unroll
  for (int nt = 0; nt < 4; ++nt) {
    const int col = w * 128 + nt * 32 + r; (void)col;
#pragma unroll
    for (int mt = 0; mt < MT; ++mt)
#pragma unroll
      for (int i = 0; i < 16; ++i)
        *(u16*)(panel + pwo + (mt * 32 + (i & 3) + 8 * (i >> 2)) * PITCH + nt * 64) = f2bf(acc[mt][nt][i] * 0.0625f);
  } }
  __syncthreads();
  {
#pragma unroll 1
    for (int hh = 0; hh < 4; ++hh) {
      f32x16 st[MT]; st[0] = zero16(); st[MT - 1] = zero16();
      bf16x8 kfr[16], vfr[16];
      {
        const u16* kfp = (MT == 2 ? (const u16*)(p.ws + WS_KF) + (size_t)((((l * 2 + b) * 4 + hh) * 8 + w) * 16) * 512
                                  : (const u16*)(p.ws + WS_KFS) + (size_t)(((b * 4 + hh) * 8 + w) * 16) * 512) + lane * 8;
        const u16* vfp = (MT == 2 ? (const u16*)(p.ws + WS_VF) + (size_t)((((l * 2 + b) * 4 + hh) * 8 + w) * 16) * 512
                                  : (const u16*)(p.ws + WS_VFS) + (size_t)(((b * 4 + hh) * 8 + w) * 16) * 512) + lane * 8;
#pragma unroll
        for (int ks = 0; ks < 16; ++ks) kfr[ks] = *(const bf16x8*)(kfp + ks * 512);
#pragma unroll
        for (int ks = 0; ks < 16; ++ks) vfr[ks] = *(const bf16x8*)(vfp + ks * 512);
        SBAR();
      }
#pragma unroll
      for (int ks = 0; ks < 16; ++ks) {
#pragma unroll
        for (int nt = 0; nt < MT; ++nt) {
          const bf16x8 bq = *(const bf16x8*)(panel + (nt * 32 + r) * PITCH + (hh * 256 + 16 * ks + 8 * h) * 2);
          st[nt] = MFMA32(kfr[ks], bq, st[nt]);
        }
      }
#pragma unroll
      for (int nt = 0; nt < MT; ++nt) {
        float m = st[nt][0];
#pragma unroll
        for (int i = 1; i < 16; ++i) m = fmaxf(m, st[nt][i]);
        m = fmaxf(m, __shfl_xor(m, 32));
        if (h == 0) rmax[w * 64 + nt * 32 + r] = m;
      }
      __syncthreads();
#pragma unroll
      for (int nt = 0; nt < MT; ++nt) {
        float gm = rmax[nt * 32 + r];
#pragma unroll
        for (int ww = 1; ww < 8; ++ww) gm = fmaxf(gm, rmax[ww * 64 + nt * 32 + r]);
        float sum = 0.f;
#pragma unroll
        for (int i = 0; i < 16; ++i) { const float pv = __expf(st[nt][i] - gm); st[nt][i] = pv; sum += pv; }
        sum += __shfl_xor(sum, 32);
        if (h == 0) rsum[w * 64 + nt * 32 + r] = sum;
#pragma unroll
        for (int g = 0; g < 4; ++g) {
          uint2 o; o.x = pack2(st[nt][4 * g], st[nt][4 * g + 1]); o.y = pack2(st[nt][4 * g + 2], st[nt][4 * g + 3]);
          *(uint2*)(panel + (nt * 32 + r) * PITCH + (hh * 256 + w * 32 + 8 * g + 4 * h) * 2) = o;
        }
      }
      __syncthreads();
      if (tid < 64) { float s = 0.f; for (int ww = 0; ww < 8; ++ww) s += rsum[ww * 64 + tid]; linv[tid] = 1.f / s; }
      f32x16 o2[MT]; o2[0] = zero16(); o2[MT - 1] = zero16();
#pragma unroll
      for (int s = 0; s < 16; ++s) {
#pragma unroll
        for (int mt = 0; mt < MT; ++mt) {
          const bf16x8 a = *(const bf16x8*)(panel + (mt * 32 + r) * PITCH + (hh * 256 + 16 * s + 8 * h) * 2);
          o2[mt] = MFMA32(a, vfr[s], o2[mt]);
        }
      }
      __syncthreads();
#pragma unroll
      for (int mt = 0; mt < MT; ++mt)
#pragma unroll
        for (int i = 0; i < 16; ++i) {
          const int q = mt * 32 + crow(i, h);
          *(u16*)(panel + q * PITCH + (hh * 256 + w * 32 + r) * 2) = f2bf(o2[mt][i] * linv[q]);
        }
    }
  }
  __syncthreads();
  ZACC();
  gemm_panel<4, MT>(panel, WSQ + (size_t)4 * DM * DM, w * 128, acc, lane);
  float gnv2[4];
  { const float* gp_ = p.norm_x_post + l * DM;
  _Pragma("unroll") for (int nt = 0; nt < 4; ++nt) gnv2[nt] = gp_[w * 128 + nt * 32 + r]; }
  row_rstd<MT>(acc, red, tot, w, lane, tid);
  {
    const float* g3 = p.norm_x_post + l * DM;
    const unsigned yo = opaque(yo_);
#pragma unroll
    for (int nt = 0; nt < 4; ++nt) {
      const int col = w * 128 + nt * 32 + r; const float gn = gnv2[nt];
      float xv[MT][16];
#pragma unroll
      for (int mt = 0; mt < MT; ++mt)
#pragma unroll
        for (int i = 0; i < 16; ++i) xv[mt][i] = ld_f32(Y, yo + (unsigned)((mt * 32 + (i & 3) + 8 * (i >> 2)) * DM + nt * 32) * 4u);
      SBAR();
#pragma unroll
      for (int mt = 0; mt < MT; ++mt)
#pragma unroll
        for (int i = 0; i < 16; ++i) {
          const unsigned bo = yo + (unsigned)((mt * 32 + (i & 3) + 8 * (i >> 2)) * DM + nt * 32) * 4u;
          const float x2 = xv[mt][i] + acc[mt][nt][i] * tot[4 * h + mt * 32 + (i & 3) + 8 * (i >> 2)] * gn;
          acc[mt][nt][i] = x2; st_f32(Y, bo, x2);
        }
      SBAR();
    }
  }
  if (l + 1 < DEPTH) {
    float gnv3[4];
    { const float* gp_ = p.norm_mix_pre + (l + 1) * DM;
    _Pragma("unroll") for (int nt = 0; nt < 4; ++nt) gnv3[nt] = gp_[w * 128 + nt * 32 + r]; }
    row_rstd<MT>(acc, red, tot, w, lane, tid);
    const float* g4 = p.norm_mix_pre + (l + 1) * DM;
    const unsigned pwo = opaque((unsigned)(4 * h * PITCH + (w * 128 + r) * 2));
#pragma unroll
    for (int nt = 0; nt < 4; ++nt) {
      const int col = w * 128 + nt * 32 + r; const float gn = gnv3[nt];
#pragma unroll
      for (int mt = 0; mt < MT; ++mt)
#pragma unroll
        for (int i = 0; i < 16; ++i)
          *(u16*)(panel + pwo + (mt * 32 + (i & 3) + 8 * (i >> 2)) * PITCH + nt * 64) = f2bf(acc[mt][nt][i] * tot[4 * h + mt * 32 + (i & 3) + 8 * (i >> 2)] * gn);
    }
    __syncthreads();
    {
      u16* H = (u16*)(p.ws + WS_H) + (size_t)R0 * DM;
#pragma unroll 1
      for (int jb = 0; jb < 8 * MT; jb += 8) {
        const unsigned e0 = (unsigned)(tid + jb * NTHREADS);
        const uint4 t0 = *(const uint4*)(panel + PANOFF(0)), t1 = *(const uint4*)(panel + PANOFF(1)), t2 = *(const uint4*)(panel + PANOFF(2)), t3 = *(const uint4*)(panel + PANOFF(3));
        const uint4 t4 = *(const uint4*)(panel + PANOFF(4)), t5 = *(const uint4*)(panel + PANOFF(5)), t6 = *(const uint4*)(panel + PANOFF(6)), t7 = *(const uint4*)(panel + PANOFF(7));
        *(uint4*)((char*)H + MIXOFF(0)) = t0; *(uint4*)((char*)H + MIXOFF(1)) = t1; *(uint4*)((char*)H + MIXOFF(2)) = t2; *(uint4*)((char*)H + MIXOFF(3)) = t3;
        *(uint4*)((char*)H + MIXOFF(4)) = t4; *(uint4*)((char*)H + MIXOFF(5)) = t5; *(uint4*)((char*)H + MIXOFF(6)) = t6; *(uint4*)((char*)H + MIXOFF(7)) = t7;
      }
    }
  }
  __syncthreads();
#undef ZACC
}

__global__ void __launch_bounds__(NTHREADS) hybrid_fwd(Params p) {
  extern __shared__ __attribute__((aligned(16))) unsigned char lds[];
  cg::grid_group grid = cg::this_grid();
  if (threadIdx.x < 4) ((unsigned*)(lds + LDS_XB))[threadIdx.x] = 0u;
  __syncthreads();
  const XcdBarrier xbar = xcd_barrier_post((unsigned*)(p.ws + WS_XB), (volatile LAS unsigned*)(lds + LDS_XB));
  const int wave_s = __builtin_amdgcn_readfirstlane((int)(threadIdx.x >> 6));
  unsigned tid_c = threadIdx.x;
  grid.sync();
  phase0(p, lds, (int)tid_c);
  xcd_barrier(xbar);
  for (int ph = 1; ph < p.ph_hi; ++ph) {
    {
      const int st_s = ph - 1, st_p = ph - 1 - SAMPLE_LEAD;
      const bool has_s = st_s >= 0 && st_s < 5 * DEPTH, has_p = st_p >= 0 && st_p < 5 * DEPTH;
      const int sub_s = st_s % 5;
      const bool s_first = has_s && (sub_s == 0 || sub_s == 4);
#pragma unroll 1
      for (int pass = 0; pass < 2; ++pass) {
        tid_c = (unsigned)(wave_s * 64) + __builtin_amdgcn_mbcnt_hi(~0u, __builtin_amdgcn_mbcnt_lo(~0u, 0u));
        asm volatile("" : "+v"(tid_c));
        const int tid = (int)tid_c;
        const int grp = (pass == 0) == s_first ? 1 : 0;
        if (grp ? !has_s : !has_p) continue;
        const int st = grp ? st_s : st_p, l = st / 5, sub = st % 5;
        int* ctr = (int*)(p.ws + WS_CTR) + ph * 2 + grp;
        if (sub == 0) {
          const int rbase = grp ? NPROMPT : 0, M = grp ? NROWS - NPROMPT : NPROMPT;
          pg8::Gemm g{(const pg8::bf16_t*)(p.ws + WS_H) + (size_t)rbase * DM, (const pg8::bf16_t*)(p.ws + WS_WIN) + (size_t)l * DIN * DM, M, DIN, DM};
          const bool share = (grp == 0) && has_s && sub_s == 4 && gridDim.x > 128;
          pg8::StaticOrder S;
          if (share) S.init(M, DIN, (int)gridDim.x - 64, (int)blockIdx.x >= 64 ? (int)blockIdx.x - 64 : (1 << 28));
          else S.init(M, DIN, (int)gridDim.x, (int)blockIdx.x);
          pg8::EpiWin E{(pg8::bf16_t*)(p.ws + WS_PROJ), (float*)(p.ws + WS_GF), p.out, (const float*)(p.ws + WS_LB) + l * 1024, l, rbase};
          pg8::gemm_phase<pg8::EpiWin, pg8::StaticOrder, false>((PG8_LAS unsigned char*)lds, g, S, E, nullptr, tid);
        }
        else if (sub == 1) phase_mix1(p, l, grp, ctr, lds, tid);
        else if (sub == 2) { const int u0 = grp ? 128 : 0, nu = grp ? 512 : 128; for (;;) { const int u = next_task(ctr, lds, tid); if (u >= nu) break; hgrn_scan_unit(p, l, u0 + u, lds, tid); } }
        else if (sub == 3) { const int t0 = grp ? 1024 : 0, nt = grp ? 128 : 1024; for (;;) { const int t = next_task(ctr, lds, tid); if (t >= nt) break; hgrn_passC(p, l, t0 + t, lds, tid); } }
        else if (!grp) { for (int t = blockIdx.x; t < 256; t += gridDim.x) chain_tile<2>(p, l, t * 64, lds, tid); }
        else { for (int t = blockIdx.x; t < 64; t += gridDim.x) chain_tile<1>(p, l, NPROMPT + t * 32, lds, tid); }
      }
    }
    if (ph == 1 || ph == 6) {
      int* ctr = (int*)(p.ws + WS_CTR) + 40 + (ph == 6);
      tid_c = (unsigned)(wave_s * 64) + __builtin_amdgcn_mbcnt_hi(~0u, __builtin_amdgcn_mbcnt_lo(~0u, 0u));
      asm volatile("" : "+v"(tid_c));
      const int tid = (int)tid_c;
      for (;;) { const int t = next_task(ctr, lds, tid); if (t >= 16 * DEC_B) break; kvconv_task(p, ph == 6, t, tid); }
    }
    if (ph + 1 < p.ph_hi) xcd_barrier(xbar);
  }
}

extern "C" void kernel_launch(void* const* d_in, const int* in_sizes, int n_in, void* d_out, int out_size, void* d_ws, size_t ws_size, hipStream_t stream) {
  static int grid_blocks = 0;
  if (!grid_blocks) {
    int dev = 0, cus = 0, per_cu = 0;
    hipGetDevice(&dev);
    hipDeviceGetAttribute(&cus, hipDeviceAttributeMultiprocessorCount, dev);
    hipFuncSetAttribute((const void*)hybrid_fwd, hipFuncAttributeMaxDynamicSharedMemorySize, LDS_BYTES);
    hipOccupancyMaxActiveBlocksPerMultiprocessor(&per_cu, (const void*)hybrid_fwd, NTHREADS, LDS_BYTES);
    if (per_cu < 1) { fprintf(stderr, "occupancy query returned %d\n", per_cu); per_cu = 1; }
    grid_blocks = cus * per_cu;
    if (ws_size < WS_END) fprintf(stderr, "workspace too small: %zu < %zu\n", ws_size, (size_t)WS_END);
  }
  Params p{};
  const float* const* in = (const float* const*)d_in;
  p.x_prompt = in[0]; p.x_sample = in[1]; p.mem_prompt = in[2]; p.cache_sb_k = in[3]; p.cache_sb_v = in[4];
  p.state_hgrn = in[5]; p.state_pool = in[6]; p.cache_mem_k = in[7]; p.cache_mem_v = in[8];
  p.norm_mix_pre = in[9]; p.norm_mix_post = in[10]; p.w_in = in[11]; p.lb_logits = in[12]; p.onorm_g = in[13];
  p.w_pool = in[14]; p.pool_scale = in[15]; p.w_out = in[16]; p.norm_x_pre = in[17]; p.norm_x_post = in[18];
  p.norm_mem = in[19]; p.w_xq = in[20]; p.w_xk = in[21]; p.w_xv = in[22]; p.w_xo = in[23];
  p.out = (float*)d_out; p.ws = (unsigned char*)d_ws;
  const int NPH = 1 + 5 * DEPTH + SAMPLE_LEAD;
  p.ph_lo = 0; p.ph_hi = NPH;
  (void)hipMemsetAsync((unsigned char*)d_ws + WS_XB, 0, XCD_BAR_WORDS * 4, stream);
  void* args[] = {&p};
  hipError_t e = hipLaunchCooperativeKernel((const void*)hybrid_fwd, dim3(grid_blocks), dim3(NTHREADS), args, LDS_BYTES, stream);
  if (e != hipSuccess) fprintf(stderr, "cooperative launch failed: %s (grid %d)\n", hipGetErrorString(e), grid_blocks);
}
```

```cpp
#include <hip/hip_runtime.h>
#include <hip/hip_cooperative_groups.h>
#include <cstdio>
namespace cg = cooperative_groups;

typedef unsigned short u16;
typedef __attribute__((ext_vector_type(8))) short bf16x8;
typedef __attribute__((ext_vector_type(16))) float f32x16;
#define DI __device__ __forceinline__
#define MFMA32(a, b, c) __builtin_amdgcn_mfma_f32_32x32x16_bf16((a), (b), (c), 0, 0, 0)
#define SBAR() __builtin_amdgcn_sched_barrier(0)

#ifndef GEMM_PD
#define GEMM_PD 3
#endif
#ifndef SAMPLE_LEAD
#define SAMPLE_LEAD 4
#endif

constexpr int DM = 1024, DIN = 3584, NROWS = 18432, NPROMPT = 16384;
constexpr int SEQ = 8192, DEC_B = 32, DEC_S = 64, PAST = 1024, DEPTH = 2;
constexpr int NTHREADS = 512;
constexpr int PITCH = 2064;
constexpr float EPS = 1e-6f;
constexpr int C_AQ = 0, C_AF = 512, C_AI = 1024, C_AG = 1536, C_BQ = 2048, C_BK = 2304, C_BV = 2560, C_BG = 2816, C_CU = 3072, C_CG = 3328;
constexpr size_t O_Y = 0;
constexpr size_t O_PSBK = (size_t)NROWS * DM;
constexpr size_t O_PSBV = O_PSBK + (size_t)DEPTH * 2 * SEQ * 256;
constexpr size_t O_PHS = O_PSBV + (size_t)DEPTH * 2 * SEQ * 256;
constexpr size_t O_PPOOL = O_PHS + (size_t)DEPTH * 2 * 4 * 16384;
constexpr size_t O_PMK = O_PPOOL + (size_t)DEPTH * 2 * 15 * 256;
constexpr size_t O_PMV = O_PMK + (size_t)DEPTH * 2 * 256 * 1024;
constexpr size_t O_SSBK = O_PMV + (size_t)DEPTH * 2 * 256 * 1024;
constexpr size_t O_SSBV = O_SSBK + (size_t)DEPTH * DEC_B * DEC_S * 256;
constexpr size_t O_SHS = O_SSBV + (size_t)DEPTH * DEC_B * DEC_S * 256;
constexpr size_t O_SPOOL = O_SHS + (size_t)DEPTH * DEC_B * 4 * 16384;
constexpr size_t WS_WIN = 0;
constexpr size_t WS_WSQ = WS_WIN + (size_t)DEPTH * DIN * DM * 2;
constexpr size_t WS_WPT = WS_WSQ + (size_t)DEPTH * 5 * DM * DM * 2;
constexpr size_t WS_LB = WS_WPT + (size_t)DEPTH * 4 * 64 * 64 * 2;
constexpr size_t WS_PROJ = WS_LB + (size_t)DEPTH * 2 * 512 * 4;
constexpr size_t WS_GF = WS_PROJ + (size_t)NROWS * DIN * 2;
constexpr size_t WS_MIX = WS_GF + (size_t)NROWS * 512 * 4;
constexpr size_t WS_DS = WS_MIX + (size_t)NROWS * DM * 2;
constexpr int NCHUNK = 1152;
constexpr size_t WS_DEC = WS_DS + (size_t)NCHUNK * 16384 * 4;
constexpr size_t WS_SPT = WS_DEC + (size_t)NCHUNK * 128 * 4;
constexpr size_t WS_H = WS_MIX;
constexpr size_t WS_CTR = WS_SPT + (size_t)NCHUNK * 16384 * 2;
constexpr size_t WS_XB = WS_CTR + 256;
constexpr size_t WS_KF = WS_XB + 16384;
constexpr size_t WS_VF = WS_KF + (size_t)DEPTH * 2 * 4 * 8 * 16 * 512 * 2;
constexpr size_t WS_KFS = WS_VF + (size_t)DEPTH * 2 * 4 * 8 * 16 * 512 * 2;
constexpr size_t WS_VFS = WS_KFS + (size_t)DEC_B * 4 * 8 * 16 * 512 * 2;
constexpr size_t WS_END = WS_VFS + (size_t)DEC_B * 4 * 8 * 16 * 512 * 2;
constexpr int LDS_PANEL = 64 * PITCH;
constexpr int LDS_RED = LDS_PANEL;
constexpr int LDS_TOT = LDS_RED + 2048;
constexpr int LDS_RMAX = LDS_TOT + 256;
constexpr int LDS_RSUM = LDS_RMAX + 2048;
constexpr int LDS_LINV = LDS_RSUM + 2048;
constexpr int LDS_TASK = LDS_LINV + 256;
constexpr int LDS_XB = LDS_TASK + 16;
constexpr int LDS_BYTES = LDS_XB + 16;

struct Params {
  const float* x_prompt; const float* x_sample; const float* mem_prompt;
  const float* cache_sb_k; const float* cache_sb_v; const float* state_hgrn; const float* state_pool;
  const float* cache_mem_k; const float* cache_mem_v;
  const float* norm_mix_pre; const float* norm_mix_post; const float* w_in; const float* lb_logits;
  const float* onorm_g; const float* w_pool; const float* pool_scale; const float* w_out;
  const float* norm_x_pre; const float* norm_x_post; const float* norm_mem;
  const float* w_xq; const float* w_xk; const float* w_xv; const float* w_xo;
  float* out; unsigned char* ws; int ph_lo, ph_hi;
};

namespace pg8 {
#define PG8_LAS __attribute__((address_space(3)))
typedef unsigned short bf16_t;
typedef short bf16x8 __attribute__((ext_vector_type(8)));
typedef float f32x4 __attribute__((ext_vector_type(4)));
typedef unsigned u32x4 __attribute__((ext_vector_type(4)));
constexpr int BM = 256, BK = 64, HALF = 128, HTB = HALF * BK * 2  , STAGE_BYTES = 8 * HTB, NXCD = 8, WGM = 8;

__host__ __device__ __forceinline__ int lds_byte(int r, int c) { const int st = (r >> 4) * 2 + (c >> 5), rr = r & 15, cc = c & 31, ob = rr * 64 + cc * 2; return st * 1024 + (ob ^ (((ob >> 9) & 1) << 5)); }
__host__ __device__ __forceinline__ void stage_rc(int b, int& R, int& C) { const int st = b / 1024, sb = b % 1024, swz = sb ^ (((sb >> 9) & 1) << 5); R = (st >> 1) * 16 + swz / 64; C = (st & 1) * 32 + (swz % 64) / 2; }
__host__ __device__ __forceinline__ int perm32(int rho) { const int n = rho >> 4, i = rho & 15; return 8 * (i >> 2) + 4 * n + (i & 3); }

struct Unit { int pm, pn; };
struct Gemm { const bf16_t* A; const bf16_t* Bt; int M, N, K; };

struct StaticOrder {
    int nM, nN, nwg, G, c;
    __host__ __device__ void init(int M, int N, int G_, int c_) { nM = M / BM; nN = N / BM; nwg = nM * nN; G = G_; c = c_; }
    __host__ __device__ bool next(int i, Unit& u) const {
        const long L = (long)i * G + c; if (L >= nwg) return false;
        int wgid = (int)L; { const int q = nwg / NXCD, r = nwg % NXCD, xcd = wgid % NXCD, off = wgid / NXCD; wgid = (xcd < r ? xcd * (q + 1) : r * (q + 1) + (xcd - r) * q) + off; }
        const int nig = WGM * nN, gid = wgid / nig, fm = gid * WGM, gsz = (nM - fm) < WGM ? (nM - fm) : WGM;
        u.pm = fm + ((wgid % nig) % gsz); u.pn = (wgid % nig) / gsz; return true;
    }
    __device__ __forceinline__ void a_ready(const Unit&) const {}
    __device__ __forceinline__ void done(const Unit&) const {}
};

__device__ __forceinline__ unsigned cvt_pk_bf16(float lo, float hi) { unsigned r; asm volatile("v_cvt_pk_bf16_f32 %0, %1, %2" : "=v"(r) : "v"(lo), "v"(hi)); return r; }
struct EpiWin {
    static constexpr bool PERM = true, AFTER_DRAIN = false;
    bf16_t* PROJ; float* GF; float* out; const float* LB; int l; int rbase;
    __device__ __forceinline__ void operator()(const f32x4 (&acc)[2][2][4][2], const Unit& u, int wr, int wc, int fr, int fq) const {
        const int region = u.pn;
        const int row0 = rbase + u.pm * BM + wr * 64 + fr, cl0 = wc * 32 + 8 * fq;
        const bool dosilu = region < 2 || region == 6 || region == 7 || region == 11 || region == 13;
        const float sc = region < 2 ? 0.08838834764831845f : (region == 8 ? 0.125f : 1.f);
#pragma unroll
        for (int bj = 0; bj < 2; ++bj) {
            const int cl = cl0 + bj * HALF;
            f32x4 la4[2], l1m4[2];
            if (region == 2 || region == 3) {
                const float* lp = LB + (region - 2) * 256 + cl;
                la4[0] = *(const f32x4*)lp; la4[1] = *(const f32x4*)(lp + 4); l1m4[0] = *(const f32x4*)(lp + 512); l1m4[1] = *(const f32x4*)(lp + 516);
            }
#pragma unroll
            for (int ai = 0; ai < 2; ++ai)
#pragma unroll
                for (int m = 0; m < 4; ++m) {
                    const int row = row0 + ai * HALF + m * 16;
                    float v[8];
#pragma unroll
                    for (int j = 0; j < 4; ++j) { v[j] = acc[ai][bj][m][0][j]; v[4 + j] = acc[ai][bj][m][1][j]; }
                    if (region == 2 || region == 3) {
                        float o[8];
#pragma unroll
                        for (int j = 0; j < 8; ++j) {
                            const float ls = fminf(v[j], 0.f) - __logf(1.f + __expf(-fabsf(v[j])));
                            const float la = la4[j >> 2][j & 3];
                            const float bb = l1m4[j >> 2][j & 3] + ls; const float mx = fmaxf(la, bb);
                            o[j] = mx + __logf(1.f + __expf(-fabsf(la - bb)));
                        }
                        float* gp = GF + (size_t)row * 512 + (region - 2) * 256 + cl;
                        *(f32x4*)gp = (f32x4){o[0], o[1], o[2], o[3]}; *(f32x4*)(gp + 4) = (f32x4){o[4], o[5], o[6], o[7]};
                    } else {
                        float t[8];
#pragma unroll
                        for (int j = 0; j < 8; ++j) t[j] = (dosilu ? v[j] * __builtin_amdgcn_rcpf(1.f + __expf(-v[j])) : v[j]) * sc;
                        u32x4 w; w.x = cvt_pk_bf16(t[0], t[1]); w.y = cvt_pk_bf16(t[2], t[3]); w.z = cvt_pk_bf16(t[4], t[5]); w.w = cvt_pk_bf16(t[6], t[7]);
                        *(u32x4*)(PROJ + (size_t)row * 3584 + region * 256 + cl) = w;
                        if (region == 9 || region == 10 || region == 12) {
                            const bool smp = row >= 16384;
                            const int b = smp ? (row - 16384) >> 6 : row >> 13, tt = smp ? (row - 16384) & 63 : row & 8191;
                            if (region != 12) {
                                const unsigned o = smp ? (unsigned)(region == 9 ? O_SSBK : O_SSBV) + (unsigned)((l * 32 + b) * 64 + tt) * 256u : (unsigned)(region == 9 ? O_PSBK : O_PSBV) + (unsigned)((l * 2 + b) * 8192 + tt) * 256u;
                                float* op = out + (o + (unsigned)cl);
                                *(f32x4*)op = (f32x4){v[0], v[1], v[2], v[3]}; *(f32x4*)(op + 4) = (f32x4){v[4], v[5], v[6], v[7]};
                            } else {
                                const int L = smp ? 64 : 8192;
                                if (tt >= L - 15) {
                                    const unsigned o = (smp ? (unsigned)O_SPOOL + (unsigned)(l * 32 + b) * 3840u : (unsigned)O_PPOOL + (unsigned)(l * 2 + b) * 3840u) + (unsigned)(tt - (L - 15)) * 256u;
                                    float* op = out + (o + (unsigned)cl);
                                    *(f32x4*)op = (f32x4){v[0], v[1], v[2], v[3]}; *(f32x4*)(op + 4) = (f32x4){v[4], v[5], v[6], v[7]};
                                }
                            }
                        }
                    }
                }
        }
    }
};

template <class Epi, class Sched, bool STAMP = false>
__device__ __forceinline__ void gemm_phase(PG8_LAS unsigned char* lds, const Gemm g, const Sched& S, const Epi& E, unsigned long long* stamps, int tid_in) {
    const int tid = tid_in, wid = __builtin_amdgcn_readfirstlane(tid >> 6), lane = tid & 63, wr = wid >> 2, wc = wid & 3, fr = lane & 15, fq = lane >> 4;
    const int K = g.K, nt = K / BK;
    int ts_lo = 0, ts_hi = 0, nts = 0; const unsigned long long rt_entry = STAMP ? (unsigned long long)wall_clock64() : 0ull;
#define PG8_STAMP() do { if (STAMP && wid == 0 && nts < 64) { const unsigned long long _c = (unsigned long long)clock64(); \
        ts_lo = (lane == nts) ? (int)(unsigned)_c : ts_lo; ts_hi = (lane == nts) ? (int)(unsigned)(_c >> 32) : ts_hi; ++nts; } } while (0)
    PG8_STAMP();
    unsigned voffA[2], voffB[2];
#pragma unroll
    for (int i = 0; i < 2; ++i) { int R, C; stage_rc(tid * 16 + i * 8192, R, C); const int Rb = Epi::PERM ? ((R & ~31) + perm32(R & 31)) : R;
        voffA[i] = (unsigned)(R * K + C) * 2u; voffB[i] = (unsigned)(Rb * K + C) * 2u; }
    const size_t kstep = (size_t)(BK * 2);
    const size_t hstep = (size_t)HALF * K * 2;
    const size_t tstep = 2 * hstep;
    const unsigned ldsw = (unsigned)wid * 1024u;
    const int aoff = lds_byte(wr * 64 + fr, fq * 8), boff = lds_byte(wc * 32 + fr, fq * 8);
#define PG8_SA(b, h) (((b) * 2 + (h)) * HTB)
#define PG8_SB(b, h) ((4 + (b) * 2 + (h)) * HTB)
#define PG8_STAGE(bufoff, gbase, voff) do { _Pragma("unroll") for (int _i = 0; _i < 2; ++_i) \
        __builtin_amdgcn_global_load_lds((const unsigned*)((const char*)(gbase) + (voff)[_i]), (PG8_LAS unsigned*)(lds + (bufoff) + ldsw + _i * 8192), 16, 0, 0); } while (0)
#define PG8_LDA(dst, b, h) do { _Pragma("unroll") for (int m = 0; m < 4; ++m) _Pragma("unroll") for (int k = 0; k < 2; ++k) dst[m][k] = *(const PG8_LAS bf16x8*)(lds + PG8_SA(b, h) + aoff + m * 2048 + k * 1024); } while (0)
#define PG8_LDB(dst, b, h) do { _Pragma("unroll") for (int n = 0; n < 2; ++n) _Pragma("unroll") for (int k = 0; k < 2; ++k) dst[n][k] = *(const PG8_LAS bf16x8*)(lds + PG8_SB(b, h) + boff + n * 2048 + k * 1024); } while (0)
#define PG8_MMA(ai, bj, At, Bt) do { __builtin_amdgcn_s_setprio(1); _Pragma("unroll") for (int m = 0; m < 4; ++m) _Pragma("unroll") for (int n = 0; n < 2; ++n) _Pragma("unroll") for (int k = 0; k < 2; ++k) \
        acc[ai][bj][m][n] = __builtin_amdgcn_mfma_f32_16x16x32_bf16(Bt[n][k], At[m][k], acc[ai][bj][m][n], 0, 0, 0); __builtin_amdgcn_s_setprio(0); } while (0)
#define PG8_WAIT_V(n) asm volatile("s_waitcnt vmcnt(" #n ")" ::: "memory")
#define PG8_WAIT_L(n) asm volatile("s_waitcnt lgkmcnt(" #n ")" ::: "memory")
#define PG8_BAR __builtin_amdgcn_s_barrier()
#define PG8_SCHED __builtin_amdgcn_sched_barrier(0)
    Unit cur, nxt; int ui = 0;
    if (!S.next(0, cur)) return;
    f32x4 acc[2][2][4][2];
#pragma unroll
    for (int a = 0; a < 2; ++a)
#pragma unroll
        for (int b = 0; b < 2; ++b)
#pragma unroll
            for (int m = 0; m < 4; ++m)
#pragma unroll
                for (int n = 0; n < 2; ++n) acc[a][b][m][n] = (f32x4){0.f, 0.f, 0.f, 0.f};
    bf16x8 At[4][2], B0[2][2], B1[2][2];
    const char* cA = (const char*)g.A + (size_t)cur.pm * tstep; const char* cB = (const char*)g.Bt + (size_t)cur.pn * tstep;
    S.a_ready(cur);
    PG8_STAGE(PG8_SB(0, 0), cB, voffB); PG8_STAGE(PG8_SA(0, 0), cA, voffA); PG8_STAGE(PG8_SB(0, 1), cB + hstep, voffB); PG8_STAGE(PG8_SA(0, 1), cA + hstep, voffA);
    if (wr == 1) PG8_BAR;
    PG8_WAIT_V(4); PG8_BAR;
    PG8_STAGE(PG8_SB(1, 0), cB + kstep, voffB); PG8_STAGE(PG8_SA(1, 0), cA + kstep, voffA); PG8_STAGE(PG8_SB(1, 1), cB + hstep + kstep, voffB);
    PG8_WAIT_V(6); PG8_BAR;
    PG8_STAMP();
    for (;;) {
        const bool has_next = S.next(ui + 1, nxt);
        const char* nA = has_next ? (const char*)g.A + (size_t)nxt.pm * tstep : cA; const char* nB = has_next ? (const char*)g.Bt + (size_t)nxt.pn * tstep : cB;
        for (int t = 0; t < nt; t += 2) {
            const bool last = (t == nt - 2);
            const char* a1 = cA + (size_t)(t + 1) * kstep;
            const char* a2 = last ? nA : cA + (size_t)(t + 2) * kstep; const char* b2 = last ? nB : cB + (size_t)(t + 2) * kstep;
            const char* a3 = a2 + kstep; const char* b3 = b2 + kstep;
            if (last && has_next) S.a_ready(nxt);
            PG8_LDB(B0, 0, 0); PG8_SCHED; PG8_LDA(At, 0, 0); PG8_STAGE(PG8_SA(1, 1), a1 + hstep, voffA);
            PG8_WAIT_L(8); PG8_BAR; PG8_WAIT_L(0); PG8_MMA(0, 0, At, B0); PG8_BAR; PG8_SCHED;
            PG8_LDB(B1, 0, 1); PG8_STAGE(PG8_SB(0, 0), b2, voffB);
            PG8_BAR; PG8_WAIT_L(0); PG8_MMA(0, 1, At, B1); PG8_BAR;
            PG8_LDA(At, 0, 1); PG8_STAGE(PG8_SA(0, 0), a2, voffA);
            PG8_BAR; PG8_WAIT_L(0); PG8_MMA(1, 0, At, B0); PG8_BAR; PG8_SCHED;
            PG8_STAGE(PG8_SB(0, 1), b2 + hstep, voffB);
            PG8_WAIT_V(6); PG8_BAR; PG8_MMA(1, 1, At, B1); PG8_BAR;
            PG8_LDB(B0, 1, 0); PG8_SCHED; PG8_LDA(At, 1, 0); PG8_STAGE(PG8_SA(0, 1), a2 + hstep, voffA);
            PG8_WAIT_L(8); PG8_BAR; PG8_WAIT_L(0); PG8_MMA(0, 0, At, B0); PG8_BAR; PG8_SCHED;
            PG8_LDB(B1, 1, 1); PG8_STAGE(PG8_SB(1, 0), b3, voffB);
            PG8_BAR; PG8_WAIT_L(0); PG8_MMA(0, 1, At, B1); PG8_BAR;
            PG8_LDA(At, 1, 1); PG8_STAGE(PG8_SA(1, 0), a3, voffA);
            PG8_BAR; PG8_WAIT_L(0); PG8_MMA(1, 0, At, B0); PG8_BAR; PG8_SCHED;
            PG8_STAGE(PG8_SB(1, 1), b3 + hstep, voffB);
            PG8_WAIT_V(6); PG8_BAR; PG8_MMA(1, 1, At, B1); PG8_BAR;
        }
        PG8_STAMP();
        if constexpr (!Epi::AFTER_DRAIN) { E(acc, cur, wr, wc, fr, fq); S.done(cur); }
        PG8_STAMP();
        if (!has_next) break;
#pragma unroll
        for (int a = 0; a < 2; ++a)
#pragma unroll
            for (int b = 0; b < 2; ++b)
#pragma unroll
                for (int m = 0; m < 4; ++m)
#pragma unroll
                    for (int n = 0; n < 2; ++n) acc[a][b][m][n] = (f32x4){0.f, 0.f, 0.f, 0.f};
        cur = nxt; cA = nA; cB = nB; ++ui;
    }
    PG8_WAIT_V(0);
    if (wr == 0) PG8_BAR;
    PG8_BAR;
    if constexpr (Epi::AFTER_DRAIN) { E.fused(acc, cur, wr, wc, fr, fq, lds, wid, lane); S.done(cur); }
    PG8_STAMP();
    if (STAMP && wid == 0) { stamps[lane] = lane < nts ? (((unsigned long long)(unsigned)ts_hi << 32) | (unsigned)ts_lo) : 0ull;
        if (lane == 62) stamps[62] = rt_entry; if (lane == 63) stamps[63] = (unsigned long long)wall_clock64(); }
#undef PG8_STAMP
#undef PG8_SA
#undef PG8_SB
#undef PG8_STAGE
#undef PG8_LDA
#undef PG8_LDB
#undef PG8_MMA
#undef PG8_WAIT_V
#undef PG8_WAIT_L
#undef PG8_BAR
#undef PG8_SCHED
}
}

#define XB_TMO      128
#define XB_XCNT(j)  (256  + 64 * (j))
#define XB_XSUB(j)  (1280 + 64 * (j))
#define XB_XGEN(j)  (2304 + 64 * (j))
#define XB_TOP      3328
#define XB_TOPGEN   3392
#define XCD_BAR_WORDS 3456
#define XB_SPIN_CAP (1u << 18)
#define LAS __attribute__((address_space(3)))

__device__ __forceinline__ unsigned xb_ld(unsigned* p)              { return __hip_atomic_load(p, __ATOMIC_RELAXED, __HIP_MEMORY_SCOPE_AGENT); }
__device__ __forceinline__ unsigned xb_add(unsigned* p, unsigned v) { return __hip_atomic_fetch_add(p, v, __ATOMIC_RELAXED, __HIP_MEMORY_SCOPE_AGENT); }
__device__ __forceinline__ unsigned xb_xcc_id() { return (unsigned)__builtin_amdgcn_s_getreg((3 << 11) | 20) & 0xFu; }
#define XB_SPIN(cond, bar) do { unsigned _sp = 0; while (cond) { __builtin_amdgcn_s_sleep(1); \
    if ((++_sp & 255u) == 0u) { if (xb_ld(&(bar)[XB_TMO])) break; if (_sp > XB_SPIN_CAP) { atomicAdd(&(bar)[XB_TMO], 1u); break; } } } } while (0)

struct XcdBarrier {
    unsigned* bar; unsigned x;
    volatile LAS unsigned* st;
};

__device__ __forceinline__ XcdBarrier xcd_barrier_post(unsigned* bar, volatile LAS unsigned* st) {
    XcdBarrier b; b.bar = bar; b.x = xb_xcc_id(); b.st = st;
    if (threadIdx.x == 0) (void)xb_add(&bar[XB_XCNT(b.x)], 1u);
    return b;
}
__device__ __forceinline__ void xcd_barrier_complete(unsigned* bar, unsigned x, unsigned& nloc, unsigned& nx) {
    const unsigned G = gridDim.x * gridDim.y * gridDim.z;
    unsigned sum, cnt, mine, sp = 0u;
    for (;;) {
        sum = 0u; cnt = 0u; mine = 0u;
#pragma unroll
        for (unsigned j = 0; j < 16; ++j) { const unsigned c = xb_ld(&bar[XB_XCNT(j)]); sum += c; cnt += (c > 0u) ? 1u : 0u; mine = (j == x) ? c : mine; }
        if (sum == G) break;
        __builtin_amdgcn_s_sleep(1);
        if ((++sp & 255u) == 0u) { if (xb_ld(&bar[XB_TMO])) break; if (sp > XB_SPIN_CAP) { atomicAdd(&bar[XB_TMO], 1u); break; } }
    }
    nloc = mine > 0u ? mine : 1u; nx = cnt > 0u ? cnt : 1u;
}

__device__ __forceinline__ void xcd_barrier(const XcdBarrier& b) {
    asm volatile("s_waitcnt vmcnt(0)" ::: "memory");
    __syncthreads();
    if (threadIdx.x == 0) {
        unsigned* bar = b.bar;
        __builtin_amdgcn_s_waitcnt(0);
        unsigned nloc = b.st[0], nx = b.st[1];
        if (nloc == 0u) { xcd_barrier_complete(bar, b.x, nloc, nx); b.st[0] = nloc; b.st[1] = nx; }
        const unsigned old = xb_add(&bar[XB_XSUB(b.x)], 1u);
        const unsigned gen = old / nloc;
        if (old + 1u == (gen + 1u) * nloc) {
            __builtin_amdgcn_fence(__ATOMIC_RELEASE, "agent");
            asm volatile("s_waitcnt vmcnt(0)" ::: "memory");
            const unsigned og = xb_add(&bar[XB_TOP], 1u);
            const unsigned tg = og / nx;
            if (og + 1u == (tg + 1u) * nx) xb_add(&bar[XB_TOPGEN], 1u);
            else XB_SPIN(xb_ld(&bar[XB_TOPGEN]) == tg, bar);
            __builtin_amdgcn_fence(__ATOMIC_ACQUIRE, "agent");
            xb_add(&bar[XB_XGEN(b.x)], 1u);
            asm volatile("s_waitcnt vmcnt(0)" ::: "memory");
        } else {
            XB_SPIN(xb_ld(&bar[XB_XGEN(b.x)]) == gen, bar);
            __builtin_amdgcn_fence(__ATOMIC_ACQUIRE, "agent");
            asm volatile("s_waitcnt vmcnt(0)" ::: "memory");
        }
    }
    __syncthreads();
}


DI u16 f2bf(float x) { unsigned u = __float_as_uint(x); u += 0x7fffu + ((u >> 16) & 1u); return (u16)(u >> 16); }
DI float bf2f(u16 v) { return __uint_as_float(((unsigned)v) << 16); }
DI unsigned pack2(float a, float b) { return (unsigned)f2bf(a) | ((unsigned)f2bf(b) << 16); }
DI int crow(int i, int h) { return (i & 3) + 8 * (i >> 2) + 4 * h; }
DI float silu(float v) { return v / (1.f + __expf(-v)); }
DI float wave_sum(float v) { for (int o = 32; o >= 1; o >>= 1) v += __shfl_xor(v, o); return v; }
DI float half_sum(float v) { for (int o = 16; o >= 1; o >>= 1) v += __shfl_xor(v, o); return v; }
DI bf16x8 cvt8(float4 a, float4 b) {
  union { bf16x8 v; unsigned u[4]; } r;
  r.u[0] = pack2(a.x, a.y); r.u[1] = pack2(a.z, a.w); r.u[2] = pack2(b.x, b.y); r.u[3] = pack2(b.z, b.w);
  return r.v;
}
DI void st_u16(void* base, unsigned boff, u16 v) { *(u16*)((char*)base + boff) = v; }
DI void st_f32(void* base, unsigned boff, float v) { *(float*)((char*)base + boff) = v; }
DI float ld_f32(const void* base, unsigned boff) { return *(const float*)((const char*)base + boff); }
DI u16 ld_u16(const void* base, unsigned boff) { return *(const u16*)((const char*)base + boff); }
DI unsigned opaque(unsigned x) { asm volatile("" : "+v"(x)); return x; }
DI int next_task(int* ctr, unsigned char* lds, int tid) {
  int* slot = (int*)(lds + LDS_TASK);
  __syncthreads();
  if (tid == 0) *slot = atomicAdd(ctr, 1);
  __syncthreads();
  return *slot;
}
DI f32x16 zero16() { f32x16 z; for (int i = 0; i < 16; ++i) z[i] = 0.f; return z; }

template <int NT, int MT>
DI void gemm_panel(const unsigned char* panel, const u16* __restrict__ Wt, int ncol0, f32x16 (&acc)[MT][NT], int lane) {
  const int r = lane & 31, h = lane >> 5;
  const char* bu = (const char*)(Wt + (size_t)(ncol0 >> 5) * 64 * 512);
  const unsigned loff = (unsigned)lane * 16u;
  const unsigned char* ap = panel + r * PITCH + 16 * h;
  constexpr int PD = (NT == 4) ? GEMM_PD : 6;
  bf16x8 B[8][NT];
#define LOADB(t, dst) { _Pragma("unroll") for (int nt = 0; nt < NT; ++nt) dst[nt] = *(const bf16x8*)(bu + (size_t)((nt * 64 + (t)) * 1024) + loff); }
#pragma unroll
  for (int t = 0; t < PD; ++t) LOADB(t, B[t]);
#pragma unroll 1
  for (int kb = 0; kb < 8; ++kb) {
#pragma unroll
    for (int s = 0; s < 8; ++s) {
      const int t2 = (kb * 8 + s + PD) & 63;
      LOADB(t2, B[(s + PD) & 7]);
      SBAR();
      const bf16x8 a0 = *(const bf16x8*)(ap + kb * 256 + s * 32);
      bf16x8 a1 = a0; if (MT == 2) a1 = *(const bf16x8*)(ap + 32 * PITCH + kb * 256 + s * 32);
#pragma unroll
      for (int nt = 0; nt < NT; ++nt) { acc[0][nt] = MFMA32(a0, B[s][nt], acc[0][nt]); if (MT == 2) acc[MT - 1][nt] = MFMA32(a1, B[s][nt], acc[MT - 1][nt]); }
      SBAR();
    }
  }
#undef LOADB
}

template <int MT>
DI void row_rstd(const f32x16 (&acc)[MT][4], float* red, float* tot, int w, int lane, int tid) {
  const int r = lane & 31, h = lane >> 5;
#pragma unroll
  for (int mt = 0; mt < MT; ++mt)
#pragma unroll
    for (int i = 0; i < 16; ++i) {
      float v = 0.f;
#pragma unroll
      for (int nt = 0; nt < 4; ++nt) v += acc[mt][nt][i] * acc[mt][nt][i];
      v = half_sum(v);
      if (r == 0) red[w * 64 + mt * 32 + crow(i, h)] = v;
    }
  __syncthreads();
  if (tid < 64) { float s = 0.f; for (int ww = 0; ww < 8; ++ww) s += red[ww * 64 + tid]; tot[tid] = rsqrtf(s * (1.f / 1024.f) + EPS); }
  __syncthreads();
}

DI void load_norm_panel(const float* __restrict__ src, const float* __restrict__ gain, unsigned char* panel, int w, int lane) {
  float4 g[4];
#pragma unroll
  for (int j = 0; j < 4; ++j) g[j] = ((const float4*)gain)[lane + 64 * j];
#pragma unroll 1
  for (int rb = 0; rb < 2; ++rb) {
    float4 v[4][4];
#pragma unroll
    for (int rr = 0; rr < 4; ++rr)
#pragma unroll
      for (int j = 0; j < 4; ++j) v[rr][j] = ((const float4*)(src + (size_t)(w * 8 + rb * 4 + rr) * 1024))[lane + 64 * j];
    SBAR();
#pragma unroll
    for (int rr = 0; rr < 4; ++rr) {
      const int row = w * 8 + rb * 4 + rr;
      float ss = 0.f;
#pragma unroll
      for (int j = 0; j < 4; ++j) ss += v[rr][j].x * v[rr][j].x + v[rr][j].y * v[rr][j].y + v[rr][j].z * v[rr][j].z + v[rr][j].w * v[rr][j].w;
      ss = wave_sum(ss);
      const float rstd = rsqrtf(ss * (1.f / 1024.f) + EPS);
#pragma unroll
      for (int j = 0; j < 4; ++j) {
        uint2 o; o.x = pack2(v[rr][j].x * rstd * g[j].x, v[rr][j].y * rstd * g[j].y); o.y = pack2(v[rr][j].z * rstd * g[j].z, v[rr][j].w * rstd * g[j].w);
        *(uint2*)(panel + row * PITCH + (lane + 64 * j) * 8) = o;
      }
    }
  }
}

DI void norm_rows_to_global(const float* __restrict__ src, const float* __restrict__ gain, u16* __restrict__ dst, int w, int lane) {
  float4 g[4];
#pragma unroll
  for (int j = 0; j < 4; ++j) g[j] = ((const float4*)gain)[lane + 64 * j];
#pragma unroll 1
  for (int rb = 0; rb < 2; ++rb) {
    float4 v[4][4];
#pragma unroll
    for (int rr = 0; rr < 4; ++rr)
#pragma unroll
      for (int j = 0; j < 4; ++j) v[rr][j] = ((const float4*)(src + (size_t)(w * 8 + rb * 4 + rr) * 1024))[lane + 64 * j];
    SBAR();
#pragma unroll
    for (int rr = 0; rr < 4; ++rr) {
      const int row = w * 8 + rb * 4 + rr;
      float ss = 0.f;
#pragma unroll
      for (int j = 0; j < 4; ++j) ss += v[rr][j].x * v[rr][j].x + v[rr][j].y * v[rr][j].y + v[rr][j].z * v[rr][j].z + v[rr][j].w * v[rr][j].w;
      ss = wave_sum(ss);
      const float rstd = rsqrtf(ss * (1.f / 1024.f) + EPS);
#pragma unroll
      for (int j = 0; j < 4; ++j) {
        uint2 o; o.x = pack2(v[rr][j].x * rstd * g[j].x, v[rr][j].y * rstd * g[j].y); o.y = pack2(v[rr][j].z * rstd * g[j].z, v[rr][j].w * rstd * g[j].w);
        *(uint2*)(dst + (size_t)row * 1024 + (lane + 64 * j) * 4) = o;
      }
    }
  }
}

template <bool FRAG>
DI void convert_tile(const float* __restrict__ src, u16* __restrict__ dst, int K, int N, int k0, int n0, unsigned char* lds, int tid) {
  u16* T = (u16*)lds;
  {
    const int kk = tid >> 3, n8 = (tid & 7) * 8;
    const float4* s = (const float4*)(src + (size_t)(k0 + kk) * N + n0 + n8);
    const float4 a = s[0], bq = s[1];
    T[(n8 + 0) * 72 + kk] = f2bf(a.x); T[(n8 + 1) * 72 + kk] = f2bf(a.y); T[(n8 + 2) * 72 + kk] = f2bf(a.z); T[(n8 + 3) * 72 + kk] = f2bf(a.w);
    T[(n8 + 4) * 72 + kk] = f2bf(bq.x); T[(n8 + 5) * 72 + kk] = f2bf(bq.y); T[(n8 + 6) * 72 + kk] = f2bf(bq.z); T[(n8 + 7) * 72 + kk] = f2bf(bq.w);
  }
  __syncthreads();
  {
    const int n = tid >> 3, k8 = (tid & 7) * 8;
    const uint4 v = *(const uint4*)(T + n * 72 + k8);
    if (FRAG) {
      const int ng = n0 + n, kg = k0 + k8;
      const size_t off = (((size_t)(ng >> 5) * (K >> 4) + (kg >> 4)) * 64 + ((kg >> 3) & 1) * 32 + (ng & 31)) * 8;
      *(uint4*)(dst + off) = v;
    } else *(uint4*)(dst + (size_t)(n0 + n) * K + k0 + k8) = v;
  }
  __syncthreads();
}

template <bool FRAG>
DI void convert_strip(const float* __restrict__ src, u16* __restrict__ dst, int K, int N, int k0, int n0, unsigned char* lds, int tid) {
  const int kk = tid >> 3, n8 = (tid & 7) * 8;
  float4 a[4], bq[4];
#pragma unroll
  for (int q = 0; q < 4; ++q) { const float4* sp = (const float4*)(src + (size_t)(k0 + kk) * N + n0 + q * 64 + n8); a[q] = sp[0]; bq[q] = sp[1]; }
  SBAR();
#pragma unroll
  for (int q = 0; q < 4; ++q) {
    u16* T = (u16*)(lds + q * 9216);
    T[(n8 + 0) * 72 + kk] = f2bf(a[q].x); T[(n8 + 1) * 72 + kk] = f2bf(a[q].y); T[(n8 + 2) * 72 + kk] = f2bf(a[q].z); T[(n8 + 3) * 72 + kk] = f2bf(a[q].w);
    T[(n8 + 4) * 72 + kk] = f2bf(bq[q].x); T[(n8 + 5) * 72 + kk] = f2bf(bq[q].y); T[(n8 + 6) * 72 + kk] = f2bf(bq[q].z); T[(n8 + 7) * 72 + kk] = f2bf(bq[q].w);
  }
  __syncthreads();
  {
    const int n = tid >> 3, k8 = (tid & 7) * 8;
#pragma unroll
    for (int q = 0; q < 4; ++q) {
      const uint4 v = *(const uint4*)((const u16*)(lds + q * 9216) + n * 72 + k8);
      const int ng = n0 + q * 64 + n, kg = k0 + k8;
      if (FRAG) {
        const size_t off = (((size_t)(ng >> 5) * (K >> 4) + (kg >> 4)) * 64 + ((kg >> 3) & 1) * 32 + (ng & 31)) * 8;
        *(uint4*)(dst + off) = v;
      } else *(uint4*)(dst + (size_t)ng * K + kg) = v;
    }
  }
  __syncthreads();
}
__device__ __forceinline__ void phase0(const Params& p, unsigned char* lds, int tid) {
  constexpr int PER_L = 224 + 320;
  const int ntask = DEPTH * PER_L + DEPTH * 4 + 288;
  for (int task = blockIdx.x; task < ntask; task += gridDim.x) {
    if (task >= DEPTH * PER_L + DEPTH * 4) {
      const int R0 = (task - (DEPTH * PER_L + DEPTH * 4)) * 64;
      const float* src = R0 < NPROMPT ? p.x_prompt + (size_t)R0 * DM : p.x_sample + (size_t)(R0 - NPROMPT) * DM;
      norm_rows_to_global(src, p.norm_mix_pre, (u16*)(p.ws + WS_H) + (size_t)R0 * DM, __builtin_amdgcn_readfirstlane(tid >> 6), tid & 63);
    } else if (task < DEPTH * PER_L) {
      const int l = task / PER_L, rr = task % PER_L;
      if (rr < 224) {
        const int kt = rr / 14, nt = rr % 14;
        convert_strip<false>(p.w_in + (size_t)l * DM * DIN, (u16*)(p.ws + WS_WIN) + (size_t)l * DIN * DM, DM, DIN, kt * 64, nt * 256, lds, tid);
      } else {
        const int m = (rr - 224) >> 6, tt = (rr - 224) & 63;
        const float* src = (m == 0 ? p.w_out : m == 1 ? p.w_xq : m == 2 ? p.w_xk : m == 3 ? p.w_xv : p.w_xo) + (size_t)l * DM * DM;
        convert_strip<true>(src, (u16*)(p.ws + WS_WSQ) + (size_t)(l * 5 + m) * DM * DM, DM, DM, (tt >> 2) * 64, (tt & 3) * 256, lds, tid);
      }
    } else {
      const int j = task - DEPTH * PER_L;
      convert_tile<false>(p.w_pool + (size_t)j * 4096, (u16*)(p.ws + WS_WPT) + (size_t)j * 4096, 64, 64, 0, 0, lds, tid);
    }
  }
  if (blockIdx.x == 0) {
    if (tid < 64) ((int*)(p.ws + WS_CTR))[tid] = 0;
    float* LB = (float*)(p.ws + WS_LB);
    for (int c = tid; c < 512; c += NTHREADS) {
      float a[DEPTH], mx = -3.0e38f;
      for (int l = 0; l < DEPTH; ++l) { a[l] = p.lb_logits[l * 512 + c]; mx = fmaxf(mx, a[l]); }
      float s = 0.f; for (int l = 0; l < DEPTH; ++l) { a[l] = expf(a[l] - mx); s += a[l]; }
      float cum = 0.f; const float first = a[0] / s;
      for (int l = 0; l < DEPTH; ++l) { cum += a[l] / s; const float lb = fmaxf(cum - first, 0.f); LB[l * 1024 + c] = lb > 0.f ? logf(lb) : -1e30f; LB[l * 1024 + 512 + c] = log1pf(-lb); }
    }
  }
}

__device__ __forceinline__ void memkv_task(const Params& p, int j, unsigned char* lds, int tid_) {
  const int tid = (int)opaque((unsigned)tid_);
  const int w = __builtin_amdgcn_readfirstlane(tid >> 6), lane = tid & 63, r = lane & 31, h = lane >> 5;
  const int l = j >> 3, mt8 = j & 7;
  load_norm_panel(p.mem_prompt + (size_t)mt8 * 64 * DM, p.norm_mem + l * DM, lds, w, lane);
  __syncthreads();
  for (int kv = 0; kv < 2; ++kv) {
    f32x16 acc[2][4];
    for (int a = 0; a < 2; ++a) for (int c = 0; c < 4; ++c) acc[a][c] = zero16();
    gemm_panel<4, 2>(lds, (const u16*)(p.ws + WS_WSQ) + (size_t)(l * 5 + 2 + kv) * DM * DM, w * 128, acc, lane);
    float* dst = p.out + (kv ? O_PMV : O_PMK) + ((size_t)l * 512 + mt8 * 64) * DM;
    const unsigned so = opaque((unsigned)((4 * h) * DM + w * 128 + r) * 4u);
#pragma unroll
    for (int mt = 0; mt < 2; ++mt)
#pragma unroll
      for (int nt = 0; nt < 4; ++nt)
#pragma unroll
        for (int i = 0; i < 16; ++i) { st_f32(dst, so + (unsigned)((mt * 32 + (i & 3) + 8 * (i >> 2)) * DM + nt * 32) * 4u, acc[mt][nt][i]); if ((i & 7) == 7) SBAR(); }
    {
      const int b = mt8 >> 2, hh = w >> 1;
      const int lq = (int)opaque((unsigned)lane), r = lq & 31, h = lq >> 5;
      u16* fb = (u16*)(p.ws + (kv ? WS_VF : WS_KF)) + (size_t)((l * 2 + b) * 4 + hh) * 8 * 16 * 512;
#pragma unroll
      for (int mt = 0; mt < 2; ++mt)
#pragma unroll
        for (int nt = 0; nt < 4; ++nt)
#pragma unroll
          for (int i = 0; i < 16; ++i) {
            const int m = (mt8 & 3) * 64 + mt * 32 + crow(i, h);
            const int d = (w & 1) * 128 + nt * 32 + r;
            unsigned off;
            if (!kv) off = (unsigned)((((m >> 5) * 16 + (d >> 4)) * 64 + 32 * ((d >> 3) & 1) + (m & 31)) * 8 + (d & 7));
            else off = (unsigned)((((d >> 5) * 16 + (m >> 4)) * 64 + 32 * ((m >> 3) & 1) + (d & 31)) * 8 + (m & 7));
            st_u16(fb, off * 2u, f2bf(acc[mt][nt][i]));
            if ((i & 7) == 7) SBAR();
          }
    }
  }
  __syncthreads();
}

__device__ __forceinline__ void kvconv_task(const Params& p, int l, int task, int tid) {
  const int b = task >> 4, kv = (task >> 3) & 1, sub = task & 7;
  const float* src = (kv ? p.cache_mem_v : p.cache_mem_k) + (size_t)(l * DEC_B + b) * 256 * 1024;
  u16* dst = (u16*)(p.ws + (kv ? WS_VFS : WS_KFS)) + (size_t)b * 4 * 8 * 16 * 512;
  if (!kv) {
#pragma unroll 1
    for (int it = sub * 8; it < sub * 8 + 8; it += 8) {
      float4 a[8], c[8];
#pragma unroll
      for (int q = 0; q < 8; ++q) { const int pc = (it + q) * NTHREADS + tid; const float* sp = src + (size_t)pc * 8; a[q] = *(const float4*)sp; c[q] = *(const float4*)(sp + 4); }
      SBAR();
#pragma unroll
      for (int q = 0; q < 8; ++q) {
        const int pc = (it + q) * NTHREADS + tid;
        const int m = pc >> 7, hh = (pc >> 5) & 3, d8 = pc & 31;
        const unsigned off = (unsigned)((((hh * 8 + (m >> 5)) * 16 + (d8 >> 1)) * 64 + 32 * (d8 & 1) + (m & 31)) * 8);
        uint4 o; o.x = pack2(a[q].x, a[q].y); o.y = pack2(a[q].z, a[q].w); o.z = pack2(c[q].x, c[q].y); o.w = pack2(c[q].z, c[q].w);
        *(uint4*)(dst + off) = o;
      }
    }
  } else {
#pragma unroll 1
    for (int it = sub * 8; it < sub * 8 + 8; it += 2) {
      float v[2][8];
#pragma unroll
      for (int q = 0; q < 2; ++q) {
        const int pc = (it + q) * NTHREADS + tid;
        const int m8 = pc >> 10, cc = pc & 1023;
#pragma unroll
        for (int j = 0; j < 8; ++j) v[q][j] = src[(size_t)(m8 * 8 + j) * 1024 + cc];
      }
      SBAR();
#pragma unroll
      for (int q = 0; q < 2; ++q) {
        const int pc = (it + q) * NTHREADS + tid;
        const int m8 = pc >> 10, hh = (pc >> 8) & 3, d = pc & 255;
        const unsigned off = (unsigned)((((hh * 8 + (d >> 5)) * 16 + (m8 >> 1)) * 64 + 32 * (m8 & 1) + (d & 31)) * 8);
        uint4 o; o.x = pack2(v[q][0], v[q][1]); o.y = pack2(v[q][2], v[q][3]); o.z = pack2(v[q][4], v[q][5]); o.w = pack2(v[q][6], v[q][7]);
        *(uint4*)(dst + off) = o;
      }
    }
  }
}

DI void hgrn_load_G(const float* __restrict__ GF, int R0, int hd, float (&g)[16], float (&G)[16], float& GL, float& Gm, float* qtot, int tid) {
  const int k = tid & 127, q4 = tid >> 7;
  float run = 0.f;
#pragma unroll
  for (int j = 0; j < 16; ++j) g[j] = GF[(size_t)(R0 + q4 * 16 + j) * 512 + hd * 128 + k];
  SBAR();
#pragma unroll
  for (int j = 0; j < 16; ++j) { run += g[j]; G[j] = run; }
  qtot[q4 * 128 + k] = run;
  __syncthreads();
  const float q0 = qtot[k], q1 = qtot[128 + k], q2 = qtot[256 + k], q3 = qtot[384 + k];
  const float off = (q4 > 0 ? q0 : 0.f) + (q4 > 1 ? q1 : 0.f) + (q4 > 2 ? q2 : 0.f);
#pragma unroll
  for (int j = 0; j < 16; ++j) G[j] += off;
  GL = q0 + q1 + q2 + q3; Gm = q0 + q1;
}
DI void chunk_rows(int task, int& R0, int& hd) {
  if (task < 1024) { const int sh = task >> 7, c = task & 127; R0 = (sh >> 2) * SEQ + c * 64; hd = sh & 3; }
  else { const int sh = task - 1024; R0 = NPROMPT + (sh >> 2) * 64; hd = sh & 3; }
}

__device__ __forceinline__ void hgrn_passA(const Params& p, int task, unsigned char* lds, int tid) {
  const int w = __builtin_amdgcn_readfirstlane(tid >> 6), lane = tid & 63, r = lane & 31, h = lane >> 5;
  float* qtot = (float*)lds;
  u16* KT = (u16*)(lds + 2048);
  u16* VT = (u16*)(lds + 2048 + 128 * 144);
  const u16* PROJ = (const u16*)(p.ws + WS_PROJ);
  int R0, hd; chunk_rows(task, R0, hd);
  const int k = tid & 127, q4 = tid >> 7;
  u16 vraw[16];
#pragma unroll
  for (int j = 0; j < 16; ++j) vraw[j] = PROJ[(size_t)(R0 + q4 * 16 + j) * DIN + C_AI + hd * 128 + k];
  float g[16], G[16], GL, Gm;
  hgrn_load_G((const float*)(p.ws + WS_GF), R0, hd, g, G, GL, Gm, qtot, tid);
#pragma unroll
  for (int j = 0; j < 16; ++j) {
    const int s = q4 * 16 + j;
    KT[k * 72 + s] = f2bf((1.f - __expf(g[j])) * __expf(GL - G[j]));
    VT[k * 72 + s] = vraw[j];
  }
  if (q4 == 0) ((float*)(p.ws + WS_DEC))[(size_t)task * 128 + k] = __expf(GL);
  __syncthreads();
  const int vt = w >> 1, kt0 = (w & 1) * 2;
  f32x16 acc[2]; acc[0] = zero16(); acc[1] = zero16();
#pragma unroll
  for (int ss = 0; ss < 4; ++ss) {
    const bf16x8 a = *(const bf16x8*)(VT + (vt * 32 + r) * 72 + 16 * ss + 8 * h);
#pragma unroll
    for (int q = 0; q < 2; ++q) {
      const bf16x8 bb = *(const bf16x8*)(KT + ((kt0 + q) * 32 + r) * 72 + 16 * ss + 8 * h);
      acc[q] = MFMA32(a, bb, acc[q]);
    }
  }
  float* DS = (float*)(p.ws + WS_DS) + (size_t)task * 16384;
#pragma unroll
  for (int q = 0; q < 2; ++q)
#pragma unroll
    for (int i = 0; i < 16; ++i) DS[(vt * 32 + crow(i, h)) * 128 + (kt0 + q) * 32 + r] = acc[q][i];
  __syncthreads();
}

__device__ __forceinline__ void hgrn_scan_unit(const Params& p, int l, int unit, unsigned char* lds, int tid) {
  float* tmp = (float*)lds;
  const float* DS = (const float*)(p.ws + WS_DS);
  const float* DEC = (const float*)(p.ws + WS_DEC);
  u16* SPT = (u16*)(p.ws + WS_SPT);
  if (unit < 128) {
    const int sh = unit >> 4, v0 = (unit & 15) * 8;
    const int v = tid >> 6, k2 = (tid & 63) * 2;
    const int ka = tid >> 2, va = (tid & 3) * 2;
    float s0 = 0.f, s1 = 0.f;
    const unsigned eoff = (unsigned)((v0 + v) * 128 + k2);
    const float* dsb = DS + (size_t)(sh * 128) * 16384;
    const float* dcb = DEC + (size_t)(sh * 128) * 128;
    u16* spb = SPT + (size_t)(sh * 128) * 16384;
#pragma unroll 1
    for (int c0 = 0; c0 < 128; c0 += 16) {
      float2 d[16], dc[16];
#pragma unroll
      for (int j = 0; j < 16; ++j) { d[j] = *(const float2*)(dsb + (size_t)(c0 + j) * 16384 + eoff); dc[j] = *(const float2*)(dcb + (c0 + j) * 128 + k2); }
      SBAR();
#pragma unroll
      for (int j = 0; j < 16; ++j) {
        *(unsigned*)(spb + (size_t)(c0 + j) * 16384 + eoff) = pack2(s0, s1);
        s0 = dc[j].x * s0 + d[j].x; s1 = dc[j].y * s1 + d[j].y;
      }
    }
    tmp[v * 130 + k2] = s0; tmp[v * 130 + k2 + 1] = s1;
    __syncthreads();
    float2 o; o.x = tmp[va * 130 + ka]; o.y = tmp[(va + 1) * 130 + ka];
    *(float2*)(p.out + O_PHS + ((size_t)l * 8 + sh) * 16384 + (size_t)ka * 128 + v0 + va) = o;
    __syncthreads();
  } else {
    const int u = unit - 128, ss = u >> 2, v0 = (u & 3) * 32;
    const int task = 1024 + ss;
    const int ka = tid >> 2, va = (tid & 3) * 8;
    const int v = tid >> 4, k8 = (tid & 15) * 8;
    const float* st = p.state_hgrn + ((size_t)l * 128 + ss) * 16384 + (size_t)ka * 128 + v0 + va;
    const float4 x0 = *(const float4*)st, x1 = *(const float4*)(st + 4);
    const float* dp = DS + (size_t)task * 16384 + (size_t)(v0 + v) * 128 + k8;
    const float4 d0 = *(const float4*)dp, d1 = *(const float4*)(dp + 4);
    const float* cp = DEC + (size_t)task * 128 + k8;
    const float4 c0 = *(const float4*)cp, c1 = *(const float4*)(cp + 4);
    SBAR();
    tmp[(va + 0) * 129 + ka] = x0.x; tmp[(va + 1) * 129 + ka] = x0.y; tmp[(va + 2) * 129 + ka] = x0.z; tmp[(va + 3) * 129 + ka] = x0.w;
    tmp[(va + 4) * 129 + ka] = x1.x; tmp[(va + 5) * 129 + ka] = x1.y; tmp[(va + 6) * 129 + ka] = x1.z; tmp[(va + 7) * 129 + ka] = x1.w;
    __syncthreads();
    float sv[8];
#pragma unroll
    for (int j = 0; j < 8; ++j) sv[j] = tmp[v * 129 + k8 + j];
    uint4 pk; pk.x = pack2(sv[0], sv[1]); pk.y = pack2(sv[2], sv[3]); pk.z = pack2(sv[4], sv[5]); pk.w = pack2(sv[6], sv[7]);
    *(uint4*)(SPT + (size_t)task * 16384 + (size_t)(v0 + v) * 128 + k8) = pk;
    __syncthreads();
    tmp[v * 129 + k8 + 0] = c0.x * sv[0] + d0.x; tmp[v * 129 + k8 + 1] = c0.y * sv[1] + d0.y; tmp[v * 129 + k8 + 2] = c0.z * sv[2] + d0.z; tmp[v * 129 + k8 + 3] = c0.w * sv[3] + d0.w;
    tmp[v * 129 + k8 + 4] = c1.x * sv[4] + d1.x; tmp[v * 129 + k8 + 5] = c1.y * sv[5] + d1.y; tmp[v * 129 + k8 + 6] = c1.z * sv[6] + d1.z; tmp[v * 129 + k8 + 7] = c1.w * sv[7] + d1.w;
    __syncthreads();
    float4 o0, o1;
    o0.x = tmp[(va + 0) * 129 + ka]; o0.y = tmp[(va + 1) * 129 + ka]; o0.z = tmp[(va + 2) * 129 + ka]; o0.w = tmp[(va + 3) * 129 + ka];
    o1.x = tmp[(va + 4) * 129 + ka]; o1.y = tmp[(va + 5) * 129 + ka]; o1.z = tmp[(va + 6) * 129 + ka]; o1.w = tmp[(va + 7) * 129 + ka];
    float* fp = p.out + O_SHS + ((size_t)l * 128 + ss) * 16384 + (size_t)ka * 128 + v0 + va;
    *(float4*)fp = o0; *(float4*)(fp + 4) = o1;
    __syncthreads();
  }
}

__device__ __forceinline__ void hgrn_passC(const Params& p, int l, int task, unsigned char* lds, int tid) {
  const int w = __builtin_amdgcn_readfirstlane(tid >> 6), lane = tid & 63, r = lane & 31, h = lane >> 5;
  float* qtot = (float*)lds;
  u16* Qm = (u16*)(lds + 2048);
  u16* Km = (u16*)(lds + 2048 + 17408);
  u16* QS = (u16*)(lds + 2048 + 2 * 17408);
  u16* VT = (u16*)(lds + 2048 + 3 * 17408);
  u16* ATT = (u16*)(lds + 2048 + 3 * 17408 + 18432);
  float* psum = (float*)(lds + 2048 + 3 * 17408 + 18432 + 9216);
  const u16* PROJ = (const u16*)(p.ws + WS_PROJ);
  int R0, hd; chunk_rows(task, R0, hd);
  bf16x8 spf[8];
  {
    const u16* SPp = (const u16*)(p.ws + WS_SPT) + (size_t)task * 16384 + (size_t)((w & 3) * 32 + r) * 128 + 8 * h;
#pragma unroll
    for (int sk = 0; sk < 8; ++sk) spf[sk] = *(const bf16x8*)(SPp + 16 * sk);
  }
  const float og = p.onorm_g[l * 512 + hd * 128 + (w & 3) * 32 + r];
  u16 graw[16];
#pragma unroll
  for (int i = 0; i < 16; ++i) graw[i] = PROJ[(size_t)(R0 + (w >> 2) * 32 + crow(i, h)) * DIN + C_AG + hd * 128 + (w & 3) * 32 + r];
  u16 qraw[16], vraw[16];
  {
    const int k = tid & 127, q4 = tid >> 7;
#pragma unroll
    for (int j = 0; j < 16; ++j) { qraw[j] = PROJ[(size_t)(R0 + q4 * 16 + j) * DIN + C_AQ + hd * 128 + k]; vraw[j] = PROJ[(size_t)(R0 + q4 * 16 + j) * DIN + C_AI + hd * 128 + k]; }
  }
  float g[16], G[16], GL, Gm;
  hgrn_load_G((const float*)(p.ws + WS_GF), R0, hd, g, G, GL, Gm, qtot, tid);
  {
    const int k = tid & 127, q4 = tid >> 7;
#pragma unroll
    for (int j = 0; j < 16; ++j) {
      const int s = q4 * 16 + j;
      const float q = bf2f(qraw[j]);
      const float d1 = fminf(fmaxf(G[j] - Gm, -80.f), 80.f);
      Qm[s * 136 + k] = f2bf(q * __expf(d1));
      Km[s * 136 + k] = f2bf((1.f - __expf(g[j])) * __expf(-d1));
      QS[s * 136 + k] = f2bf(q * __expf(G[j]));
      VT[k * 72 + s] = vraw[j];
    }
  }
  __syncthreads();
  if (w < 4) {
    const int tt = w >> 1, st = w & 1;
    f32x16 a = zero16();
    if (st <= tt) {
#pragma unroll
      for (int sk = 0; sk < 8; ++sk) {
        const bf16x8 fa = *(const bf16x8*)(Qm + (tt * 32 + r) * 136 + 16 * sk + 8 * h);
        const bf16x8 fb = *(const bf16x8*)(Km + (st * 32 + r) * 136 + 16 * sk + 8 * h);
        a = MFMA32(fa, fb, a);
      }
    }
    const int s = st * 32 + r;
#pragma unroll
    for (int i = 0; i < 16; ++i) {
      const int t = tt * 32 + crow(i, h);
      ATT[t * 72 + s] = (st <= tt && s <= t) ? f2bf(a[i]) : (u16)0;
    }
  }
  __syncthreads();
  const int tt = w >> 2, vt = w & 3;
  f32x16 o = zero16();
#pragma unroll
  for (int ss = 0; ss < 4; ++ss) {
    const bf16x8 fa = *(const bf16x8*)(ATT + (tt * 32 + r) * 72 + 16 * ss + 8 * h);
    const bf16x8 fb = *(const bf16x8*)(VT + (vt * 32 + r) * 72 + 16 * ss + 8 * h);
    o = MFMA32(fa, fb, o);
  }
#pragma unroll
  for (int sk = 0; sk < 8; ++sk) {
    const bf16x8 fa = *(const bf16x8*)(QS + (tt * 32 + r) * 136 + 16 * sk + 8 * h);
    o = MFMA32(fa, spf[sk], o);
  }
#pragma unroll
  for (int i = 0; i < 16; ++i) {
    const float v = half_sum(o[i] * o[i]);
    if (r == 0) psum[vt * 64 + tt * 32 + crow(i, h)] = v;
  }
  __syncthreads();
  const int v = vt * 32 + r;
  u16* MIX = (u16*)(p.ws + WS_MIX);
#pragma unroll
  for (int i = 0; i < 16; ++i) {
    const int t = tt * 32 + crow(i, h);
    const float ssq = psum[t] + psum[64 + t] + psum[128 + t] + psum[192 + t];
    const float rstd = rsqrtf(ssq * (1.f / 128.f) + EPS);
    const size_t row = (size_t)(R0 + t);
    MIX[row * DM + hd * 128 + v] = f2bf(o[i] * rstd * og * bf2f(graw[i]));
  }
  __syncthreads();
}

__device__ __forceinline__ void sb_wave(const Params& p, int l, int grp, int b, int head, int q0, int lane) {
  const int r = lane & 31, h = lane >> 5;
  const u16* PROJ = (const u16*)(p.ws + WS_PROJ);
  const int Rbase = grp ? NPROMPT + b * 64 : b * SEQ;
  const int past = grp ? PAST : 0;
  const float* ck = p.cache_sb_k + (size_t)(l * DEC_B + b) * PAST * 256;
  const float* cv = p.cache_sb_v + (size_t)(l * DEC_B + b) * PAST * 256;
  bf16x8 qf[4];
#pragma unroll
  for (int s = 0; s < 4; ++s) qf[s] = *(const bf16x8*)(PROJ + (size_t)(Rbase + q0 + r) * DIN + C_BQ + head * 64 + 16 * s + 8 * h);
  const int qpos = past + q0 + r;
  float carry = 0.f;
  f32x16 O[2]; O[0] = zero16(); O[1] = zero16();
  const int T0 = (past + q0) >> 5;
  unsigned raw[64];
#define SB_ISSUE(T_) do { const int Tn_ = (T_); \
    if (Tn_ * 32 >= past) { \
      const u16* kp_ = PROJ + (size_t)(Rbase + Tn_ * 32 - past + r) * DIN + C_BK + head * 64 + 8 * h; \
      _Pragma("unroll") for (int s_ = 0; s_ < 4; ++s_) { const uint4 t_ = *(const uint4*)(kp_ + 16 * s_); raw[4 * s_] = t_.x; raw[4 * s_ + 1] = t_.y; raw[4 * s_ + 2] = t_.z; raw[4 * s_ + 3] = t_.w; } \
      const u16* vp_ = PROJ + (size_t)(Rbase + Tn_ * 32 - past + 4 * h) * DIN + C_BV + head * 64 + r; \
      _Pragma("unroll") for (int e_ = 0; e_ < 32; ++e_) raw[16 + e_] = vp_[(size_t)(16 * (e_ >> 4) + 8 * ((e_ >> 2) & 1) + (e_ & 3)) * DIN + ((e_ >> 3) & 1) * 32]; \
    } else { \
      const float* kp_ = ck + (size_t)(Tn_ * 32 + r) * 256 + head * 64 + 8 * h; \
      _Pragma("unroll") for (int s_ = 0; s_ < 8; ++s_) { const uint4 t_ = *(const uint4*)(kp_ + 16 * (s_ >> 1) + 4 * (s_ & 1)); raw[4 * s_] = t_.x; raw[4 * s_ + 1] = t_.y; raw[4 * s_ + 2] = t_.z; raw[4 * s_ + 3] = t_.w; } \
      const float* vp_ = cv + (size_t)(Tn_ * 32 + 4 * h) * 256 + head * 64 + r; \
      _Pragma("unroll") for (int e_ = 0; e_ < 32; ++e_) raw[32 + e_] = __float_as_uint(vp_[(size_t)(16 * (e_ >> 4) + 8 * ((e_ >> 2) & 1) + (e_ & 3)) * 256 + ((e_ >> 3) & 1) * 32]); \
    } } while (0)
  SB_ISSUE(T0);
  for (int T = T0; T >= 0; --T) {
    const bool isnew = T * 32 >= past;
    union { bf16x8 v; unsigned u[4]; } kf[4], vf[2][2];
    if (isnew) {
#pragma unroll
      for (int s = 0; s < 4; ++s)
#pragma unroll
        for (int j = 0; j < 4; ++j) kf[s].u[j] = raw[4 * s + j];
#pragma unroll
      for (int s = 0; s < 2; ++s)
#pragma unroll
        for (int dt = 0; dt < 2; ++dt)
#pragma unroll
          for (int j = 0; j < 4; ++j) vf[s][dt].u[j] = (raw[16 + s * 16 + dt * 8 + 2 * j] & 0xffffu) | (raw[16 + s * 16 + dt * 8 + 2 * j + 1] << 16);
    } else {
#pragma unroll
      for (int s = 0; s < 4; ++s)
#pragma unroll
        for (int j = 0; j < 4; ++j) kf[s].u[j] = pack2(__uint_as_float(raw[8 * s + 2 * j]), __uint_as_float(raw[8 * s + 2 * j + 1]));
#pragma unroll
      for (int s = 0; s < 2; ++s)
#pragma unroll
        for (int dt = 0; dt < 2; ++dt)
#pragma unroll
          for (int j = 0; j < 4; ++j) vf[s][dt].u[j] = pack2(__uint_as_float(raw[32 + s * 16 + dt * 8 + 2 * j]), __uint_as_float(raw[32 + s * 16 + dt * 8 + 2 * j + 1]));
    }
    if (T > 0) SB_ISSUE(T - 1);
    SBAR();
    f32x16 z = zero16();
#pragma unroll
    for (int s = 0; s < 4; ++s) z = MFMA32(kf[s].v, qf[s], z);
    float lsm[16]; bool msk[16];
#pragma unroll
    for (int i = 0; i < 16; ++i) {
      msk[i] = (T * 32 + crow(i, h)) < qpos;
      const float sp = fmaxf(z[i], 0.f) + __logf(1.f + __expf(-fabsf(z[i])));
      lsm[i] = msk[i] ? -sp : 0.f;
    }
    float town[4], toth[4];
#pragma unroll
    for (int g = 0; g < 4; ++g) {
      lsm[4 * g + 2] += lsm[4 * g + 3]; lsm[4 * g + 1] += lsm[4 * g + 2]; lsm[4 * g + 0] += lsm[4 * g + 1];
      town[g] = lsm[4 * g];
    }
#pragma unroll
    for (int g = 0; g < 4; ++g) toth[g] = __shfl_xor(town[g], 32);
    float spair = 0.f;
    float ag[4];
#pragma unroll
    for (int g = 3; g >= 0; --g) { ag[g] = spair + (h == 0 ? toth[g] : 0.f); spair += town[g] + toth[g]; }
    union { bf16x8 v; unsigned u[4]; } pf[2];
#pragma unroll
    for (int i = 0; i < 16; i += 2) {
      const float w0 = msk[i] ? __expf(z[i] + lsm[i] + ag[i >> 2] + carry) : 0.f;
      const float w1 = msk[i + 1] ? __expf(z[i + 1] + lsm[i + 1] + ag[i >> 2] + carry) : 0.f;
      pf[i >> 3].u[(i & 7) >> 1] = pack2(w0, w1);
    }
    carry += spair;
#pragma unroll
    for (int s = 0; s < 2; ++s)
#pragma unroll
      for (int dt = 0; dt < 2; ++dt) O[dt] = MFMA32(pf[s].v, vf[s][dt].v, O[dt]);
    if (__all(carry < -110.f)) break;
  }
#undef SB_ISSUE
  u16* MIX = (u16*)(p.ws + WS_MIX);
#pragma unroll
  for (int dt = 0; dt < 2; ++dt)
#pragma unroll
    for (int i = 0; i < 16; ++i) {
      const size_t row = (size_t)(Rbase + q0 + crow(i, h));
      const int d = head * 64 + dt * 32 + r;
      const float gate = bf2f(PROJ[row * DIN + C_BG + d]);
      MIX[row * DM + 512 + d] = f2bf(O[dt][i] * gate);
    }
}

__device__ __forceinline__ void pool_tile(const Params& p, int l, int R0, unsigned char* lds, int tid) {
  const int w = __builtin_amdgcn_readfirstlane(tid >> 6), lane = tid & 63, r = lane & 31, h = lane >> 5;
  float* E = (float*)lds;
  const int g = w >> 1, mt = w & 1;
  float psc[2];
#pragma unroll
  for (int nt = 0; nt < 2; ++nt) psc[nt] = p.pool_scale[l * 256 + g * 64 + nt * 32 + r];
  u16 pg[2][16];
#pragma unroll
  for (int nt = 0; nt < 2; ++nt)
#pragma unroll
    for (int i = 0; i < 16; ++i) pg[nt][i] = ((const u16*)(p.ws + WS_PROJ))[(size_t)(R0 + mt * 32 + crow(i, h)) * DIN + C_CG + g * 64 + nt * 32 + r];
  u16* D = (u16*)(lds + 79 * 1024);
  const u16* PROJ = (const u16*)(p.ws + WS_PROJ);
  const int grp = R0 >= NPROMPT;
  const int b = grp ? (R0 - NPROMPT) >> 6 : R0 >> 13;
  const int t0 = grp ? 0 : (R0 & (SEQ - 1));
  const int past = grp ? PAST : 0;
  {
    const int c4 = (tid & 63) * 4, rg = tid >> 6;
    uint2 raw[10];
#pragma unroll
    for (int q = 0; q < 10; ++q) {
      const int j = rg + 8 * q, t = t0 - 15 + j;
      raw[q] = make_uint2(0u, 0u);
      if (j < 79 && t >= 0) raw[q] = *(const uint2*)(PROJ + (size_t)(R0 - t0 + t) * DIN + C_CU + c4);
    }
    SBAR();
#pragma unroll
    for (int q = 0; q < 10; ++q) {
      const int j = rg + 8 * q, t = t0 - 15 + j;
      if (j < 79) {
        float4 v;
        if (t >= 0) { v.x = bf2f((u16)(raw[q].x & 0xffff)); v.y = bf2f((u16)(raw[q].x >> 16)); v.z = bf2f((u16)(raw[q].y & 0xffff)); v.w = bf2f((u16)(raw[q].y >> 16)); }
        else if (grp) v = *(const float4*)(p.state_pool + ((size_t)(l * DEC_B + b) * 15 + (15 + t)) * 256 + c4);
        else v = make_float4(0.f, 0.f, 0.f, 0.f);
        *(float4*)(E + j * 256 + c4) = v;
      }
    }
  }
  __syncthreads();
  for (int e = tid; e < 64 * 256; e += NTHREADS) {
    const int t = e >> 8, c = e & 255;
    const int wdw = 2 << (c >> 6);
    float s = 0.f;
    for (int j = 0; j < wdw; ++j) s += E[(15 + t - j) * 256 + c];
    const int pos = past + t0 + t;
    const float cnt = (float)min(pos + 1, wdw);
    D[t * 264 + c] = f2bf(s / cnt - E[(15 + t) * 256 + c]);
  }
  __syncthreads();
  const u16* WP = (const u16*)(p.ws + WS_WPT) + (size_t)(l * 4 + g) * 4096;
  f32x16 acc[2]; acc[0] = zero16(); acc[1] = zero16();
#pragma unroll
  for (int s = 0; s < 4; ++s) {
    const bf16x8 a = *(const bf16x8*)(D + (mt * 32 + r) * 264 + g * 64 + 16 * s + 8 * h);
#pragma unroll
    for (int nt = 0; nt < 2; ++nt) {
      const bf16x8 bb = *(const bf16x8*)(WP + (nt * 32 + r) * 64 + 16 * s + 8 * h);
      acc[nt] = MFMA32(a, bb, acc[nt]);
    }
  }
  u16* MIX = (u16*)(p.ws + WS_MIX);
#pragma unroll
  for (int nt = 0; nt < 2; ++nt) {
    const int d = g * 64 + nt * 32 + r;
    const float sc = psc[nt];
#pragma unroll
    for (int i = 0; i < 16; ++i) {
      const size_t row = (size_t)(R0 + mt * 32 + crow(i, h));
      MIX[row * DM + 768 + d] = f2bf(acc[nt][i] * sc * bf2f(pg[nt][i]));
    }
  }
  __syncthreads();
}

__device__ __forceinline__ void phase_mix1(const Params& p, int l, int grp, int* ctr, unsigned char* lds, int tid_) {
  const int nmk = (grp == 0 && l == 0) ? 16 : 0;
  const int nsb = grp ? 32 : 256, npl = grp ? 32 : 256, npa = grp ? 128 : 1024;
  const int ntask = nmk + nsb + npl + npa;
  for (;;) {
    const int task = next_task(ctr, lds, tid_);
    if (task >= ntask) break;
    const int tid = (int)opaque((unsigned)tid_);
    const int w = __builtin_amdgcn_readfirstlane(tid >> 6), lane = tid & 63;
    if (task < nmk) memkv_task(p, task, lds, tid);
    else if (task < nmk + nsb) {
      const int t = task - nmk;
      if (!grp) { const int b = t >> 7, rem = t & 127; sb_wave(p, l, 0, b, rem >> 5, (rem & 31) * 256 + w * 32, lane); }
      else { sb_wave(p, l, 1, t, w >> 1, (w & 1) * 32, lane); }
    } else if (task < nmk + nsb + npl) pool_tile(p, l, ((grp ? 256 : 0) + task - nmk - nsb) * 64, lds, tid);
    else hgrn_passA(p, (grp ? 1024 : 0) + task - nmk - nsb - npl, lds, tid);
  }
}

template <int MT>
__device__ __forceinline__ void chain_tile(const Params& p, int l, int R0, unsigned char* lds, int tid_) {
  const int tid = (int)opaque((unsigned)tid_);
  const int w = __builtin_amdgcn_readfirstlane(tid >> 6), lane = tid & 63, r = lane & 31, h = lane >> 5;
  unsigned char* panel = lds;
  float* red = (float*)(lds + LDS_RED); float* tot = (float*)(lds + LDS_TOT);
  float* rmax = (float*)(lds + LDS_RMAX); float* rsum = (float*)(lds + LDS_RSUM); float* linv = (float*)(lds + LDS_LINV);
  const int grp = R0 >= NPROMPT;
  const int b = grp ? (R0 - NPROMPT) >> 6 : R0 >> 13;
  const u16* WSQ = (const u16*)(p.ws + WS_WSQ) + (size_t)l * 5 * DM * DM;
  float* Y = p.out + O_Y;
  const float* xsrc = (l == 0) ? (grp ? p.x_sample - (size_t)NPROMPT * DM : p.x_prompt) : (const float*)Y;
  const unsigned yo_ = ((unsigned)(R0 + 4 * h) * (unsigned)DM + (unsigned)(w * 128 + r)) * 4u;
  {
    const u16* MIX = (const u16*)(p.ws + WS_MIX) + (size_t)R0 * DM;
#pragma unroll 1
    for (int jb = 0; jb < 8 * MT; jb += 8) {
      const unsigned e0 = (unsigned)(tid + jb * NTHREADS);
#define MIXOFF(j) (unsigned)((((e0 + (j) * NTHREADS) >> 7) * DM + ((e0 + (j) * NTHREADS) & 127) * 8) * 2)
#define PANOFF(j) (((e0 + (j) * NTHREADS) >> 7) * PITCH + ((e0 + (j) * NTHREADS) & 127) * 16)
      const uint4 t0 = *(const uint4*)((const char*)MIX + MIXOFF(0)), t1 = *(const uint4*)((const char*)MIX + MIXOFF(1)), t2 = *(const uint4*)((const char*)MIX + MIXOFF(2)), t3 = *(const uint4*)((const char*)MIX + MIXOFF(3));
      const uint4 t4 = *(const uint4*)((const char*)MIX + MIXOFF(4)), t5 = *(const uint4*)((const char*)MIX + MIXOFF(5)), t6 = *(const uint4*)((const char*)MIX + MIXOFF(6)), t7 = *(const uint4*)((const char*)MIX + MIXOFF(7));
      SBAR();
      *(uint4*)(panel + PANOFF(0)) = t0; *(uint4*)(panel + PANOFF(1)) = t1; *(uint4*)(panel + PANOFF(2)) = t2; *(uint4*)(panel + PANOFF(3)) = t3;
      *(uint4*)(panel + PANOFF(4)) = t4; *(uint4*)(panel + PANOFF(5)) = t5; *(uint4*)(panel + PANOFF(6)) = t6; *(uint4*)(panel + PANOFF(7)) = t7;
    }
  }
  __syncthreads();
  f32x16 acc[MT][4];
#define ZACC() { _Pragma("unroll") for (int a_ = 0; a_ < MT; ++a_) _Pragma("unroll") for (int c_ = 0; c_ < 4; ++c_) acc[a_][c_] = zero16(); }
  ZACC();
  gemm_panel<4, MT>(panel, WSQ + (size_t)0 * DM * DM, w * 128, acc, lane);
  row_rstd<MT>(acc, red, tot, w, lane, tid);
  {
    const float* npost = p.norm_mix_post + l * DM;
    const unsigned yo = opaque(yo_);
#pragma unroll
    for (int nt = 0; nt < 4; ++nt) {
      const int col = w * 128 + nt * 32 + r; const float gn = npost[col];
      float xv[MT][16];
#pragma unroll
      for (int mt = 0; mt < MT; ++mt)
#pragma unroll
        for (int i = 0; i < 16; ++i) xv[mt][i] = ld_f32(xsrc, yo + (unsigned)((mt * 32 + (i & 3) + 8 * (i >> 2)) * DM + nt * 32) * 4u);
      SBAR();
#pragma unroll
      for (int mt = 0; mt < MT; ++mt)
#pragma unroll
        for (int i = 0; i < 16; ++i) {
          const unsigned bo = yo + (unsigned)((mt * 32 + (i & 3) + 8 * (i >> 2)) * DM + nt * 32) * 4u;
          const float x1 = xv[mt][i] + acc[mt][nt][i] * tot[4 * h + mt * 32 + (i & 3) + 8 * (i >> 2)] * gn;
          acc[mt][nt][i] = x1; st_f32(Y, bo, x1);
        }
      SBAR();
    }
  }
  row_rstd<MT>(acc, red, tot, w, lane, tid);
  {
    const float* g2 = p.norm_x_pre + l * DM;
    const unsigned pwo = opaque((unsigned)(4 * h * PITCH + (w * 128 + r) * 2));
#pragma unroll
    for (int nt = 0; nt < 4; ++nt) {
      const int col = w * 128 + nt * 32 + r; const float gn = g2[col];
#pragma unroll
      for (int mt = 0; mt < MT; ++mt)
#pragma unroll
        for (int i = 0; i < 16; ++i)
          *(u16*)(panel + pwo + (mt * 32 + (i & 3) + 8 * (i >> 2)) * PITCH + nt * 64) = f2bf(acc[mt][nt][i] * tot[4 * h + mt * 32 + (i & 3) + 8 * (i >> 2)] * gn);
    }
  }
  __syncthreads();
  ZACC();
  gemm_panel<4, MT>(panel, WSQ + (size_t)1 * DM * DM, w * 128, acc, lane);
  __syncthreads();
  { const unsigned pwo = opaque((unsigned)(4 * h * PITCH + (w * 128 + r) * 2));
#pragma unroll
  for (int nt = 0; nt < 4; ++nt) {
    const int col = w * 128 + nt * 32 + r; (void)col;
#pragma unroll
    for (int mt = 0; mt < MT; ++mt)
#pragma unroll
      for (int i = 0; i < 16; ++i)
        *(u16*)(panel + pwo + (mt * 32 + (i & 3) + 8 * (i >> 2)) * PITCH + nt * 64) = f2bf(acc[mt][nt][i] * 0.0625f);
  } }
  __syncthreads();
  {
#pragma unroll 1
    for (int hh = 0; hh < 4; ++hh) {
      f32x16 st[MT]; st[0] = zero16(); st[MT - 1] = zero16();
      bf16x8 kfr[16], vfr[16];
      {
        const u16* kfp = (MT == 2 ? (const u16*)(p.ws + WS_KF) + (size_t)((((l * 2 + b) * 4 + hh) * 8 + w) * 16) * 512
                                  : (const u16*)(p.ws + WS_KFS) + (size_t)(((b * 4 + hh) * 8 + w) * 16) * 512) + lane * 8;
        const u16* vfp = (MT == 2 ? (const u16*)(p.ws + WS_VF) + (size_t)((((l * 2 + b) * 4 + hh) * 8 + w) * 16) * 512
                                  : (const u16*)(p.ws + WS_VFS) + (size_t)(((b * 4 + hh) * 8 + w) * 16) * 512) + lane * 8;
#pragma unroll
        for (int ks = 0; ks < 16; ++ks) kfr[ks] = *(const bf16x8*)(kfp + ks * 512);
#pragma unroll
        for (int ks = 0; ks < 16; ++ks) vfr[ks] = *(const bf16x8*)(vfp + ks * 512);
        SBAR();
      }
#pragma unroll
      for (int ks = 0; ks < 16; ++ks) {
#pragma unroll
        for (int nt = 0; nt < MT; ++nt) {
          const bf16x8 bq = *(const bf16x8*)(panel + (nt * 32 + r) * PITCH + (hh * 256 + 16 * ks + 8 * h) * 2);
          st[nt] = MFMA32(kfr[ks], bq, st[nt]);
        }
      }
#pragma unroll
      for (int nt = 0; nt < MT; ++nt) {
        float m = st[nt][0];
#pragma unroll
        for (int i = 1; i < 16; ++i) m = fmaxf(m, st[nt][i]);
        m = fmaxf(m, __shfl_xor(m, 32));
        if (h == 0) rmax[w * 64 + nt * 32 + r] = m;
      }
      __syncthreads();
#pragma unroll
      for (int nt = 0; nt < MT; ++nt) {
        float gm = rmax[nt * 32 + r];
#pragma unroll
        for (int ww = 1; ww < 8; ++ww) gm = fmaxf(gm, rmax[ww * 64 + nt * 32 + r]);
        float sum = 0.f;
#pragma unroll
        for (int i = 0; i < 16; ++i) { const float pv = __expf(st[nt][i] - gm); st[nt][i] = pv; sum += pv; }
        sum += __shfl_xor(sum, 32);
        if (h == 0) rsum[w * 64 + nt * 32 + r] = sum;
#pragma unroll
        for (int g = 0; g < 4; ++g) {
          uint2 o; o.x = pack2(st[nt][4 * g], st[nt][4 * g + 1]); o.y = pack2(st[nt][4 * g + 2], st[nt][4 * g + 3]);
          *(uint2*)(panel + (nt * 32 + r) * PITCH + (hh * 256 + w * 32 + 8 * g + 4 * h) * 2) = o;
        }
      }
      __syncthreads();
      if (tid < 64) { float s = 0.f; for (int ww = 0; ww < 8; ++ww) s += rsum[ww * 64 + tid]; linv[tid] = 1.f / s; }
      f32x16 o2[MT]; o2[0] = zero16(); o2[MT - 1] = zero16();
#pragma unroll
      for (int s = 0; s < 16; ++s) {
#pragma unroll
        for (int mt = 0; mt < MT; ++mt) {
          const bf16x8 a = *(const bf16x8*)(panel + (mt * 32 + r) * PITCH + (hh * 256 + 16 * s + 8 * h) * 2);
          o2[mt] = MFMA32(a, vfr[s], o2[mt]);
        }
      }
      __syncthreads();
#pragma unroll
      for (int mt = 0; mt < MT; ++mt)
#pragma unroll
        for (int i = 0; i < 16; ++i) {
          const int q = mt * 32 + crow(i, h);
          *(u16*)(panel + q * PITCH + (hh * 256 + w * 32 + r) * 2) = f2bf(o2[mt][i] * linv[q]);
        }
    }
  }
  __syncthreads();
  ZACC();
  gemm_panel<4, MT>(panel, WSQ + (size_t)4 * DM * DM, w * 128, acc, lane);
  row_rstd<MT>(acc, red, tot, w, lane, tid);
  {
    const float* g3 = p.norm_x_post + l * DM;
    const unsigned yo = opaque(yo_);
#pragma unroll
    for (int nt = 0; nt < 4; ++nt) {
      const int col = w * 128 + nt * 32 + r; const float gn = g3[col];
      float xv[MT][16];
#pragma unroll
      for (int mt = 0; mt < MT; ++mt)
#pragma unroll
        for (int i = 0; i < 16; ++i) xv[mt][i] = ld_f32(Y, yo + (unsigned)((mt * 32 + (i & 3) + 8 * (i >> 2)) * DM + nt * 32) * 4u);
      SBAR();
#pragma unroll
      for (int mt = 0; mt < MT; ++mt)
#pragma unroll
        for (int i = 0; i < 16; ++i) {
          const unsigned bo = yo + (unsigned)((mt * 32 + (i & 3) + 8 * (i >> 2)) * DM + nt * 32) * 4u;
          const float x2 = xv[mt][i] + acc[mt][nt][i] * tot[4 * h + mt * 32 + (i & 3) + 8 * (i >> 2)] * gn;
          acc[mt][nt][i] = x2; st_f32(Y, bo, x2);
        }
      SBAR();
    }
  }
  if (l + 1 < DEPTH) {
    row_rstd<MT>(acc, red, tot, w, lane, tid);
    const float* g4 = p.norm_mix_pre + (l + 1) * DM;
    const unsigned pwo = opaque((unsigned)(4 * h * PITCH + (w * 128 + r) * 2));
#pragma unroll
    for (int nt = 0; nt < 4; ++nt) {
      const int col = w * 128 + nt * 32 + r; const float gn = g4[col];
#pragma unroll
      for (int mt = 0; mt < MT; ++mt)
#pragma unroll
        for (int i = 0; i < 16; ++i)
          *(u16*)(panel + pwo + (mt * 32 + (i & 3) + 8 * (i >> 2)) * PITCH + nt * 64) = f2bf(acc[mt][nt][i] * tot[4 * h + mt * 32 + (i & 3) + 8 * (i >> 2)] * gn);
    }
    __syncthreads();
    {
      u16* H = (u16*)(p.ws + WS_H) + (size_t)R0 * DM;
#pragma unroll 1
      for (int jb = 0; jb < 8 * MT; jb += 8) {
        const unsigned e0 = (unsigned)(tid + jb * NTHREADS);
        const uint4 t0 = *(const uint4*)(panel + PANOFF(0)), t1 = *(const uint4*)(panel + PANOFF(1)), t2 = *(const uint4*)(panel + PANOFF(2)), t3 = *(const uint4*)(panel + PANOFF(3));
        const uint4 t4 = *(const uint4*)(panel + PANOFF(4)), t5 = *(const uint4*)(panel + PANOFF(5)), t6 = *(const uint4*)(panel + PANOFF(6)), t7 = *(const uint4*)(panel + PANOFF(7));
        *(uint4*)((char*)H + MIXOFF(0)) = t0; *(uint4*)((char*)H + MIXOFF(1)) = t1; *(uint4*)((char*)H + MIXOFF(2)) = t2; *(uint4*)((char*)H + MIXOFF(3)) = t3;
        *(uint4*)((char*)H + MIXOFF(4)) = t4; *(uint4*)((char*)H + MIXOFF(5)) = t5; *(uint4*)((char*)H + MIXOFF(6)) = t6; *(uint4*)((char*)H + MIXOFF(7)) = t7;
      }
    }
  }
  __syncthreads();
#undef ZACC
}

__global__ void __launch_bounds__(NTHREADS) hybrid_fwd(Params p) {
  extern __shared__ __attribute__((aligned(16))) unsigned char lds[];
  cg::grid_group grid = cg::this_grid();
  if (threadIdx.x < 4) ((unsigned*)(lds + LDS_XB))[threadIdx.x] = 0u;
  __syncthreads();
  const XcdBarrier xbar = xcd_barrier_post((unsigned*)(p.ws + WS_XB), (volatile LAS unsigned*)(lds + LDS_XB));
  const int wave_s = __builtin_amdgcn_readfirstlane((int)(threadIdx.x >> 6));
  unsigned tid_c = threadIdx.x;
  grid.sync();
  phase0(p, lds, (int)tid_c);
  xcd_barrier(xbar);
  for (int ph = 1; ph < p.ph_hi; ++ph) {
    {
      const int st_s = ph - 1, st_p = ph - 1 - SAMPLE_LEAD;
      const bool has_s = st_s >= 0 && st_s < 5 * DEPTH, has_p = st_p >= 0 && st_p < 5 * DEPTH;
      const int sub_s = st_s % 5;
      const bool s_first = has_s && (sub_s == 0 || sub_s == 4);
#pragma unroll 1
      for (int pass = 0; pass < 2; ++pass) {
        tid_c = (unsigned)(wave_s * 64) + __builtin_amdgcn_mbcnt_hi(~0u, __builtin_amdgcn_mbcnt_lo(~0u, 0u));
        asm volatile("" : "+v"(tid_c));
        const int tid = (int)tid_c;
        const int grp = (pass == 0) == s_first ? 1 : 0;
        if (grp ? !has_s : !has_p) continue;
        const int st = grp ? st_s : st_p, l = st / 5, sub = st % 5;
        int* ctr = (int*)(p.ws + WS_CTR) + ph * 2 + grp;
        if (sub == 0) {
          const int rbase = grp ? NPROMPT : 0, M = grp ? NROWS - NPROMPT : NPROMPT;
          pg8::Gemm g{(const pg8::bf16_t*)(p.ws + WS_H) + (size_t)rbase * DM, (const pg8::bf16_t*)(p.ws + WS_WIN) + (size_t)l * DIN * DM, M, DIN, DM};
          const bool share = (grp == 0) && has_s && sub_s == 4 && gridDim.x > 128;
          pg8::StaticOrder S;
          if (share) S.init(M, DIN, (int)gridDim.x - 64, (int)blockIdx.x >= 64 ? (int)blockIdx.x - 64 : (1 << 28));
          else S.init(M, DIN, (int)gridDim.x, (int)blockIdx.x);
          pg8::EpiWin E{(pg8::bf16_t*)(p.ws + WS_PROJ), (float*)(p.ws + WS_GF), p.out, (const float*)(p.ws + WS_LB) + l * 1024, l, rbase};
          pg8::gemm_phase<pg8::EpiWin, pg8::StaticOrder, false>((PG8_LAS unsigned char*)lds, g, S, E, nullptr, tid);
        }
        else if (sub == 1) phase_mix1(p, l, grp, ctr, lds, tid);
        else if (sub == 2) { const int u0 = grp ? 128 : 0, nu = grp ? 512 : 128; for (;;) { const int u = next_task(ctr, lds, tid); if (u >= nu) break; hgrn_scan_unit(p, l, u0 + u, lds, tid); } }
        else if (sub == 3) { const int t0 = grp ? 1024 : 0, nt = grp ? 128 : 1024; for (;;) { const int t = next_task(ctr, lds, tid); if (t >= nt) break; hgrn_passC(p, l, t0 + t, lds, tid); } }
        else if (!grp) {
          for (int t = blockIdx.x; t < 256; t += gridDim.x) {
            const int tile = (gridDim.x == 256) ? ((t & 7) >> 2) * 128 + (t & 3) * 32 + (t >> 3) : t;
            chain_tile<2>(p, l, tile * 64, lds, tid);
          }
        }
        else { for (int t = blockIdx.x; t < 64; t += gridDim.x) chain_tile<1>(p, l, NPROMPT + t * 32, lds, tid); }
      }
    }
    if (ph == 1 || ph == 6) {
      int* ctr = (int*)(p.ws + WS_CTR) + 40 + (ph == 6);
      tid_c = (unsigned)(wave_s * 64) + __builtin_amdgcn_mbcnt_hi(~0u, __builtin_amdgcn_mbcnt_lo(~0u, 0u));
      asm volatile("" : "+v"(tid_c));
      const int tid = (int)tid_c;
      for (;;) { const int t = next_task(ctr, lds, tid); if (t >= 16 * DEC_B) break; kvconv_task(p, ph == 6, t, tid); }
    }
    if (ph + 1 < p.ph_hi) xcd_barrier(xbar);
  }
}

extern "C" void kernel_launch(void* const* d_in, const int* in_sizes, int n_in, void* d_out, int out_size, void* d_ws, size_t ws_size, hipStream_t stream) {
  static int grid_blocks = 0;
  if (!grid_blocks) {
    int dev = 0, cus = 0, per_cu = 0;
    hipGetDevice(&dev);
    hipDeviceGetAttribute(&cus, hipDeviceAttributeMultiprocessorCount, dev);
    hipFuncSetAttribute((const void*)hybrid_fwd, hipFuncAttributeMaxDynamicSharedMemorySize, LDS_BYTES);
    hipOccupancyMaxActiveBlocksPerMultiprocessor(&per_cu, (const void*)hybrid_fwd, NTHREADS, LDS_BYTES);
    if (per_cu < 1) { fprintf(stderr, "occupancy query returned %d\n", per_cu); per_cu = 1; }
    grid_blocks = cus * per_cu;
    if (ws_size < WS_END) fprintf(stderr, "workspace too small: %zu < %zu\n", ws_size, (size_t)WS_END);
  }
  Params p{};
  const float* const* in = (const float* const*)d_in;
  p.x_prompt = in[0]; p.x_sample = in[1]; p.mem_prompt = in[2]; p.cache_sb_k = in[3]; p.cache_sb_v = in[4];
  p.state_hgrn = in[5]; p.state_pool = in[6]; p.cache_mem_k = in[7]; p.cache_mem_v = in[8];
  p.norm_mix_pre = in[9]; p.norm_mix_post = in[10]; p.w_in = in[11]; p.lb_logits = in[12]; p.onorm_g = in[13];
  p.w_pool = in[14]; p.pool_scale = in[15]; p.w_out = in[16]; p.norm_x_pre = in[17]; p.norm_x_post = in[18];
  p.norm_mem = in[19]; p.w_xq = in[20]; p.w_xk = in[21]; p.w_xv = in[22]; p.w_xo = in[23];
  p.out = (float*)d_out; p.ws = (unsigned char*)d_ws;
  const int NPH = 1 + 5 * DEPTH + SAMPLE_LEAD;
  p.ph_lo = 0; p.ph_hi = NPH;
  (void)hipMemsetAsync((unsigned char*)d_ws + WS_XB, 0, XCD_BAR_WORDS * 4, stream);
  void* args[] = {&p};
  hipError_t e = hipLaunchCooperativeKernel((const void*)hybrid_fwd, dim3(grid_blocks), dim3(NTHREADS), args, LDS_BYTES, stream);
  if (e != hipSuccess) fprintf(stderr, "cooperative launch failed: %s (grid %d)\n", hipGetErrorString(e), grid_blocks);
}
```

```cpp
#include <hip/hip_runtime.h>
#include <hip/hip_cooperative_groups.h>
#include <cstdio>
namespace cg = cooperative_groups;

typedef unsigned short u16;
typedef __attribute__((ext_vector_type(8))) short bf16x8;
typedef __attribute__((ext_vector_type(16))) float f32x16;
#define DI __device__ __forceinline__
#define MFMA32(a, b, c) __builtin_amdgcn_mfma_f32_32x32x16_bf16((a), (b), (c), 0, 0, 0)
#define SBAR() __builtin_amdgcn_sched_barrier(0)

#ifndef GEMM_PD
#define GEMM_PD 3
#endif
#ifndef SAMPLE_LEAD
#define SAMPLE_LEAD 4
#endif

constexpr int DM = 1024, DIN = 3584, NROWS = 18432, NPROMPT = 16384;
constexpr int SEQ = 8192, DEC_B = 32, DEC_S = 64, PAST = 1024, DEPTH = 2;
constexpr int NTHREADS = 512;
constexpr int PITCH = 2064;
constexpr float EPS = 1e-6f;
constexpr int C_AQ = 0, C_AF = 512, C_AI = 1024, C_AG = 1536, C_BQ = 2048, C_BK = 2304, C_BV = 2560, C_BG = 2816, C_CU = 3072, C_CG = 3328;
constexpr size_t O_Y = 0;
constexpr size_t O_PSBK = (size_t)NROWS * DM;
constexpr size_t O_PSBV = O_PSBK + (size_t)DEPTH * 2 * SEQ * 256;
constexpr size_t O_PHS = O_PSBV + (size_t)DEPTH * 2 * SEQ * 256;
constexpr size_t O_PPOOL = O_PHS + (size_t)DEPTH * 2 * 4 * 16384;
constexpr size_t O_PMK = O_PPOOL + (size_t)DEPTH * 2 * 15 * 256;
constexpr size_t O_PMV = O_PMK + (size_t)DEPTH * 2 * 256 * 1024;
constexpr size_t O_SSBK = O_PMV + (size_t)DEPTH * 2 * 256 * 1024;
constexpr size_t O_SSBV = O_SSBK + (size_t)DEPTH * DEC_B * DEC_S * 256;
constexpr size_t O_SHS = O_SSBV + (size_t)DEPTH * DEC_B * DEC_S * 256;
constexpr size_t O_SPOOL = O_SHS + (size_t)DEPTH * DEC_B * 4 * 16384;
constexpr size_t WS_WIN = 0;
constexpr size_t WS_WSQ = WS_WIN + (size_t)DEPTH * DIN * DM * 2;
constexpr size_t WS_WPT = WS_WSQ + (size_t)DEPTH * 5 * DM * DM * 2;
constexpr size_t WS_LB = WS_WPT + (size_t)DEPTH * 4 * 64 * 64 * 2;
constexpr size_t WS_PROJ = WS_LB + (size_t)DEPTH * 2 * 512 * 4;
constexpr size_t WS_GF = WS_PROJ + (size_t)NROWS * DIN * 2;
constexpr size_t WS_MIX = WS_GF + (size_t)NROWS * 512 * 4;
constexpr size_t WS_DS = WS_MIX + (size_t)NROWS * DM * 2;
constexpr int NCHUNK = 1152;
constexpr size_t WS_DEC = WS_DS + (size_t)NCHUNK * 16384 * 4;
constexpr size_t WS_SPT = WS_DEC + (size_t)NCHUNK * 128 * 4;
constexpr size_t WS_H = WS_MIX;
constexpr size_t WS_CTR = WS_SPT + (size_t)NCHUNK * 16384 * 2;
constexpr size_t WS_XB = WS_CTR + 256;
constexpr size_t WS_KF = WS_XB + 16384;
constexpr size_t WS_VF = WS_KF + (size_t)DEPTH * 2 * 4 * 8 * 16 * 512 * 2;
constexpr size_t WS_KFS = WS_VF + (size_t)DEPTH * 2 * 4 * 8 * 16 * 512 * 2;
constexpr size_t WS_VFS = WS_KFS + (size_t)DEC_B * 4 * 8 * 16 * 512 * 2;
constexpr size_t WS_END = WS_VFS + (size_t)DEC_B * 4 * 8 * 16 * 512 * 2;
constexpr int LDS_PANEL = 64 * PITCH;
constexpr int LDS_RED = LDS_PANEL;
constexpr int LDS_TOT = LDS_RED + 2048;
constexpr int LDS_RMAX = LDS_TOT + 256;
constexpr int LDS_RSUM = LDS_RMAX + 2048;
constexpr int LDS_LINV = LDS_RSUM + 2048;
constexpr int LDS_TASK = LDS_LINV + 256;
constexpr int LDS_XB = LDS_TASK + 16;
constexpr int LDS_BYTES = LDS_XB + 16;

struct Params {
  const float* x_prompt; const float* x_sample; const float* mem_prompt;
  const float* cache_sb_k; const float* cache_sb_v; const float* state_hgrn; const float* state_pool;
  const float* cache_mem_k; const float* cache_mem_v;
  const float* norm_mix_pre; const float* norm_mix_post; const float* w_in; const float* lb_logits;
  const float* onorm_g; const float* w_pool; const float* pool_scale; const float* w_out;
  const float* norm_x_pre; const float* norm_x_post; const float* norm_mem;
  const float* w_xq; const float* w_xk; const float* w_xv; const float* w_xo;
  float* out; unsigned char* ws; int ph_lo, ph_hi;
};

namespace pg8 {
#define PG8_LAS __attribute__((address_space(3)))
typedef unsigned short bf16_t;
typedef short bf16x8 __attribute__((ext_vector_type(8)));
typedef float f32x4 __attribute__((ext_vector_type(4)));
typedef unsigned u32x4 __attribute__((ext_vector_type(4)));
constexpr int BM = 256, BK = 64, HALF = 128, HTB = HALF * BK * 2  , STAGE_BYTES = 8 * HTB, NXCD = 8, WGM = 8;

__host__ __device__ __forceinline__ int lds_byte(int r, int c) { const int st = (r >> 4) * 2 + (c >> 5), rr = r & 15, cc = c & 31, ob = rr * 64 + cc * 2; return st * 1024 + (ob ^ (((ob >> 9) & 1) << 5)); }
__host__ __device__ __forceinline__ void stage_rc(int b, int& R, int& C) { const int st = b / 1024, sb = b % 1024, swz = sb ^ (((sb >> 9) & 1) << 5); R = (st >> 1) * 16 + swz / 64; C = (st & 1) * 32 + (swz % 64) / 2; }
__host__ __device__ __forceinline__ int perm32(int rho) { const int n = rho >> 4, i = rho & 15; return 8 * (i >> 2) + 4 * n + (i & 3); }

struct Unit { int pm, pn; };
struct Gemm { const bf16_t* A; const bf16_t* Bt; int M, N, K; };

struct StaticOrder {
    int nM, nN, nwg, G, c;
    __host__ __device__ void init(int M, int N, int G_, int c_) { nM = M / BM; nN = N / BM; nwg = nM * nN; G = G_; c = c_; }
    __host__ __device__ bool next(int i, Unit& u) const {
        const long L = (long)i * G + c; if (L >= nwg) return false;
        int wgid = (int)L; { const int q = nwg / NXCD, r = nwg % NXCD, xcd = wgid % NXCD, off = wgid / NXCD; wgid = (xcd < r ? xcd * (q + 1) : r * (q + 1) + (xcd - r) * q) + off; }
        const int nig = WGM * nN, gid = wgid / nig, fm = gid * WGM, gsz = (nM - fm) < WGM ? (nM - fm) : WGM;
        u.pm = fm + ((wgid % nig) % gsz); u.pn = (wgid % nig) / gsz; return true;
    }
    __device__ __forceinline__ void a_ready(const Unit&) const {}
    __device__ __forceinline__ void done(const Unit&) const {}
};

__device__ __forceinline__ unsigned cvt_pk_bf16(float lo, float hi) { unsigned r; asm volatile("v_cvt_pk_bf16_f32 %0, %1, %2" : "=v"(r) : "v"(lo), "v"(hi)); return r; }
struct EpiWin {
    static constexpr bool PERM = true, AFTER_DRAIN = false;
    bf16_t* PROJ; float* GF; float* out; const float* LB; int l; int rbase;
    __device__ __forceinline__ void operator()(const f32x4 (&acc)[2][2][4][2], const Unit& u, int wr, int wc, int fr, int fq) const {
        const int region = u.pn;
        const int row0 = rbase + u.pm * BM + wr * 64 + fr, cl0 = wc * 32 + 8 * fq;
        const bool dosilu = region < 2 || region == 6 || region == 7 || region == 11 || region == 13;
        const float sc = region < 2 ? 0.08838834764831845f : (region == 8 ? 0.125f : 1.f);
#pragma unroll
        for (int bj = 0; bj < 2; ++bj) {
            const int cl = cl0 + bj * HALF;
            f32x4 la4[2], l1m4[2];
            if (region == 2 || region == 3) {
                const float* lp = LB + (region - 2) * 256 + cl;
                la4[0] = *(const f32x4*)lp; la4[1] = *(const f32x4*)(lp + 4); l1m4[0] = *(const f32x4*)(lp + 512); l1m4[1] = *(const f32x4*)(lp + 516);
            }
#pragma unroll
            for (int ai = 0; ai < 2; ++ai)
#pragma unroll
                for (int m = 0; m < 4; ++m) {
                    const int row = row0 + ai * HALF + m * 16;
                    float v[8];
#pragma unroll
                    for (int j = 0; j < 4; ++j) { v[j] = acc[ai][bj][m][0][j]; v[4 + j] = acc[ai][bj][m][1][j]; }
                    if (region == 2 || region == 3) {
                        float o[8];
#pragma unroll
                        for (int j = 0; j < 8; ++j) {
                            const float ls = fminf(v[j], 0.f) - __logf(1.f + __expf(-fabsf(v[j])));
                            const float la = la4[j >> 2][j & 3];
                            const float bb = l1m4[j >> 2][j & 3] + ls; const float mx = fmaxf(la, bb);
                            o[j] = mx + __logf(1.f + __expf(-fabsf(la - bb)));
                        }
                        float* gp = GF + (size_t)row * 512 + (region - 2) * 256 + cl;
                        *(f32x4*)gp = (f32x4){o[0], o[1], o[2], o[3]}; *(f32x4*)(gp + 4) = (f32x4){o[4], o[5], o[6], o[7]};
                    } else {
                        float t[8];
#pragma unroll
                        for (int j = 0; j < 8; ++j) t[j] = (dosilu ? v[j] * __builtin_amdgcn_rcpf(1.f + __expf(-v[j])) : v[j]) * sc;
                        u32x4 w; w.x = cvt_pk_bf16(t[0], t[1]); w.y = cvt_pk_bf16(t[2], t[3]); w.z = cvt_pk_bf16(t[4], t[5]); w.w = cvt_pk_bf16(t[6], t[7]);
                        *(u32x4*)(PROJ + (size_t)row * 3584 + region * 256 + cl) = w;
                        if (region == 9 || region == 10 || region == 12) {
                            const bool smp = row >= 16384;
                            const int b = smp ? (row - 16384) >> 6 : row >> 13, tt = smp ? (row - 16384) & 63 : row & 8191;
                            if (region != 12) {
                                const unsigned o = smp ? (unsigned)(region == 9 ? O_SSBK : O_SSBV) + (unsigned)((l * 32 + b) * 64 + tt) * 256u : (unsigned)(region == 9 ? O_PSBK : O_PSBV) + (unsigned)((l * 2 + b) * 8192 + tt) * 256u;
                                float* op = out + (o + (unsigned)cl);
                                *(f32x4*)op = (f32x4){v[0], v[1], v[2], v[3]}; *(f32x4*)(op + 4) = (f32x4){v[4], v[5], v[6], v[7]};
                            } else {
                                const int L = smp ? 64 : 8192;
                                if (tt >= L - 15) {
                                    const unsigned o = (smp ? (unsigned)O_SPOOL + (unsigned)(l * 32 + b) * 3840u : (unsigned)O_PPOOL + (unsigned)(l * 2 + b) * 3840u) + (unsigned)(tt - (L - 15)) * 256u;
                                    float* op = out + (o + (unsigned)cl);
                                    *(f32x4*)op = (f32x4){v[0], v[1], v[2], v[3]}; *(f32x4*)(op + 4) = (f32x4){v[4], v[5], v[6], v[7]};
                                }
                            }
                        }
                    }
                }
        }
    }
};

template <class Epi, class Sched, bool STAMP = false>
__device__ __forceinline__ void gemm_phase(PG8_LAS unsigned char* lds, const Gemm g, const Sched& S, const Epi& E, unsigned long long* stamps, int tid_in) {
    const int tid = tid_in, wid = __builtin_amdgcn_readfirstlane(tid >> 6), lane = tid & 63, wr = wid >> 2, wc = wid & 3, fr = lane & 15, fq = lane >> 4;
    const int K = g.K, nt = K / BK;
    int ts_lo = 0, ts_hi = 0, nts = 0; const unsigned long long rt_entry = STAMP ? (unsigned long long)wall_clock64() : 0ull;
#define PG8_STAMP() do { if (STAMP && wid == 0 && nts < 64) { const unsigned long long _c = (unsigned long long)clock64(); \
        ts_lo = (lane == nts) ? (int)(unsigned)_c : ts_lo; ts_hi = (lane == nts) ? (int)(unsigned)(_c >> 32) : ts_hi; ++nts; } } while (0)
    PG8_STAMP();
    unsigned voffA[2], voffB[2];
#pragma unroll
    for (int i = 0; i < 2; ++i) { int R, C; stage_rc(tid * 16 + i * 8192, R, C); const int Rb = Epi::PERM ? ((R & ~31) + perm32(R & 31)) : R;
        voffA[i] = (unsigned)(R * K + C) * 2u; voffB[i] = (unsigned)(Rb * K + C) * 2u; }
    const size_t kstep = (size_t)(BK * 2);
    const size_t hstep = (size_t)HALF * K * 2;
    const size_t tstep = 2 * hstep;
    const unsigned ldsw = (unsigned)wid * 1024u;
    const int aoff = lds_byte(wr * 64 + fr, fq * 8), boff = lds_byte(wc * 32 + fr, fq * 8);
#define PG8_SA(b, h) (((b) * 2 + (h)) * HTB)
#define PG8_SB(b, h) ((4 + (b) * 2 + (h)) * HTB)
#define PG8_STAGE(bufoff, gbase, voff) do { _Pragma("unroll") for (int _i = 0; _i < 2; ++_i) \
        __builtin_amdgcn_global_load_lds((const unsigned*)((const char*)(gbase) + (voff)[_i]), (PG8_LAS unsigned*)(lds + (bufoff) + ldsw + _i * 8192), 16, 0, 0); } while (0)
#define PG8_LDA(dst, b, h) do { _Pragma("unroll") for (int m = 0; m < 4; ++m) _Pragma("unroll") for (int k = 0; k < 2; ++k) dst[m][k] = *(const PG8_LAS bf16x8*)(lds + PG8_SA(b, h) + aoff + m * 2048 + k * 1024); } while (0)
#define PG8_LDB(dst, b, h) do { _Pragma("unroll") for (int n = 0; n < 2; ++n) _Pragma("unroll") for (int k = 0; k < 2; ++k) dst[n][k] = *(const PG8_LAS bf16x8*)(lds + PG8_SB(b, h) + boff + n * 2048 + k * 1024); } while (0)
#define PG8_MMA(ai, bj, At, Bt) do { __builtin_amdgcn_s_setprio(1); _Pragma("unroll") for (int m = 0; m < 4; ++m) _Pragma("unroll") for (int n = 0; n < 2; ++n) _Pragma("unroll") for (int k = 0; k < 2; ++k) \
        acc[ai][bj][m][n] = __builtin_amdgcn_mfma_f32_16x16x32_bf16(Bt[n][k], At[m][k], acc[ai][bj][m][n], 0, 0, 0); __builtin_amdgcn_s_setprio(0); } while (0)
#define PG8_WAIT_V(n) asm volatile("s_waitcnt vmcnt(" #n ")" ::: "memory")
#define PG8_WAIT_L(n) asm volatile("s_waitcnt lgkmcnt(" #n ")" ::: "memory")
#define PG8_BAR __builtin_amdgcn_s_barrier()
#define PG8_SCHED __builtin_amdgcn_sched_barrier(0)
    Unit cur, nxt; int ui = 0;
    if (!S.next(0, cur)) return;
    f32x4 acc[2][2][4][2];
#pragma unroll
    for (int a = 0; a < 2; ++a)
#pragma unroll
        for (int b = 0; b < 2; ++b)
#pragma unroll
            for (int m = 0; m < 4; ++m)
#pragma unroll
                for (int n = 0; n < 2; ++n) acc[a][b][m][n] = (f32x4){0.f, 0.f, 0.f, 0.f};
    bf16x8 At[4][2], B0[2][2], B1[2][2];
    const char* cA = (const char*)g.A + (size_t)cur.pm * tstep; const char* cB = (const char*)g.Bt + (size_t)cur.pn * tstep;
    S.a_ready(cur);
    PG8_STAGE(PG8_SB(0, 0), cB, voffB); PG8_STAGE(PG8_SA(0, 0), cA, voffA); PG8_STAGE(PG8_SB(0, 1), cB + hstep, voffB); PG8_STAGE(PG8_SA(0, 1), cA + hstep, voffA);
    if (wr == 1) PG8_BAR;
    PG8_WAIT_V(4); PG8_BAR;
    PG8_STAGE(PG8_SB(1, 0), cB + kstep, voffB); PG8_STAGE(PG8_SA(1, 0), cA + kstep, voffA); PG8_STAGE(PG8_SB(1, 1), cB + hstep + kstep, voffB);
    PG8_WAIT_V(6); PG8_BAR;
    PG8_STAMP();
    for (;;) {
        const bool has_next = S.next(ui + 1, nxt);
        const char* nA = has_next ? (const char*)g.A + (size_t)nxt.pm * tstep : cA; const char* nB = has_next ? (const char*)g.Bt + (size_t)nxt.pn * tstep : cB;
        for (int t = 0; t < nt; t += 2) {
            const bool last = (t == nt - 2);
            const char* a1 = cA + (size_t)(t + 1) * kstep;
            const char* a2 = last ? nA : cA + (size_t)(t + 2) * kstep; const char* b2 = last ? nB : cB + (size_t)(t + 2) * kstep;
            const char* a3 = a2 + kstep; const char* b3 = b2 + kstep;
            if (last && has_next) S.a_ready(nxt);
            PG8_LDB(B0, 0, 0); PG8_SCHED; PG8_LDA(At, 0, 0); PG8_STAGE(PG8_SA(1, 1), a1 + hstep, voffA);
            PG8_WAIT_L(8); PG8_BAR; PG8_WAIT_L(0); PG8_MMA(0, 0, At, B0); PG8_BAR; PG8_SCHED;
            PG8_LDB(B1, 0, 1); PG8_STAGE(PG8_SB(0, 0), b2, voffB);
            PG8_BAR; PG8_WAIT_L(0); PG8_MMA(0, 1, At, B1); PG8_BAR;
            PG8_LDA(At, 0, 1); PG8_STAGE(PG8_SA(0, 0), a2, voffA);
            PG8_BAR; PG8_WAIT_L(0); PG8_MMA(1, 0, At, B0); PG8_BAR; PG8_SCHED;
            PG8_STAGE(PG8_SB(0, 1), b2 + hstep, voffB);
            PG8_WAIT_V(6); PG8_BAR; PG8_MMA(1, 1, At, B1); PG8_BAR;
            PG8_LDB(B0, 1, 0); PG8_SCHED; PG8_LDA(At, 1, 0); PG8_STAGE(PG8_SA(0, 1), a2 + hstep, voffA);
            PG8_WAIT_L(8); PG8_BAR; PG8_WAIT_L(0); PG8_MMA(0, 0, At, B0); PG8_BAR; PG8_SCHED;
            PG8_LDB(B1, 1, 1); PG8_STAGE(PG8_SB(1, 0), b3, voffB);
            PG8_BAR; PG8_WAIT_L(0); PG8_MMA(0, 1, At, B1); PG8_BAR;
            PG8_LDA(At, 1, 1); PG8_STAGE(PG8_SA(1, 0), a3, voffA);
            PG8_BAR; PG8_WAIT_L(0); PG8_MMA(1, 0, At, B0); PG8_BAR; PG8_SCHED;
            PG8_STAGE(PG8_SB(1, 1), b3 + hstep, voffB);
            PG8_WAIT_V(6); PG8_BAR; PG8_MMA(1, 1, At, B1); PG8_BAR;
        }
        PG8_STAMP();
        if constexpr (!Epi::AFTER_DRAIN) { E(acc, cur, wr, wc, fr, fq); S.done(cur); }
        PG8_STAMP();
        if (!has_next) break;
#pragma unroll
        for (int a = 0; a < 2; ++a)
#pragma unroll
            for (int b = 0; b < 2; ++b)
#pragma unroll
                for (int m = 0; m < 4; ++m)
#pragma unroll
                    for (int n = 0; n < 2; ++n) acc[a][b][m][n] = (f32x4){0.f, 0.f, 0.f, 0.f};
        cur = nxt; cA = nA; cB = nB; ++ui;
    }
    PG8_WAIT_V(0);
    if (wr == 0) PG8_BAR;
    PG8_BAR;
    if constexpr (Epi::AFTER_DRAIN) { E.fused(acc, cur, wr, wc, fr, fq, lds, wid, lane); S.done(cur); }
    PG8_STAMP();
    if (STAMP && wid == 0) { stamps[lane] = lane < nts ? (((unsigned long long)(unsigned)ts_hi << 32) | (unsigned)ts_lo) : 0ull;
        if (lane == 62) stamps[62] = rt_entry; if (lane == 63) stamps[63] = (unsigned long long)wall_clock64(); }
#undef PG8_STAMP
#undef PG8_SA
#undef PG8_SB
#undef PG8_STAGE
#undef PG8_LDA
#undef PG8_LDB
#undef PG8_MMA
#undef PG8_WAIT_V
#undef PG8_WAIT_L
#undef PG8_BAR
#undef PG8_SCHED
}
}

#define XB_TMO      128
#define XB_XCNT(j)  (256  + 64 * (j))
#define XB_XSUB(j)  (1280 + 64 * (j))
#define XB_XGEN(j)  (2304 + 64 * (j))
#define XB_TOP      3328
#define XB_TOPGEN   3392
#define XCD_BAR_WORDS 3456
#define XB_SPIN_CAP (1u << 18)
#define LAS __attribute__((address_space(3)))

__device__ __forceinline__ unsigned xb_ld(unsigned* p)              { return __hip_atomic_load(p, __ATOMIC_RELAXED, __HIP_MEMORY_SCOPE_AGENT); }
__device__ __forceinline__ unsigned xb_add(unsigned* p, unsigned v) { return __hip_atomic_fetch_add(p, v, __ATOMIC_RELAXED, __HIP_MEMORY_SCOPE_AGENT); }
__device__ __forceinline__ unsigned xb_xcc_id() { return (unsigned)__builtin_amdgcn_s_getreg((3 << 11) | 20) & 0xFu; }
#define XB_SPIN(cond, bar) do { unsigned _sp = 0; while (cond) { __builtin_amdgcn_s_sleep(1); \
    if ((++_sp & 255u) == 0u) { if (xb_ld(&(bar)[XB_TMO])) break; if (_sp > XB_SPIN_CAP) { atomicAdd(&(bar)[XB_TMO], 1u); break; } } } } while (0)

struct XcdBarrier {
    unsigned* bar; unsigned x;
    volatile LAS unsigned* st;
};

__device__ __forceinline__ XcdBarrier xcd_barrier_post(unsigned* bar, volatile LAS unsigned* st) {
    XcdBarrier b; b.bar = bar; b.x = xb_xcc_id(); b.st = st;
    if (threadIdx.x == 0) (void)xb_add(&bar[XB_XCNT(b.x)], 1u);
    return b;
}
__device__ __forceinline__ void xcd_barrier_complete(unsigned* bar, unsigned x, unsigned& nloc, unsigned& nx) {
    const unsigned G = gridDim.x * gridDim.y * gridDim.z;
    unsigned sum, cnt, mine, sp = 0u;
    for (;;) {
        sum = 0u; cnt = 0u; mine = 0u;
#pragma unroll
        for (unsigned j = 0; j < 16; ++j) { const unsigned c = xb_ld(&bar[XB_XCNT(j)]); sum += c; cnt += (c > 0u) ? 1u : 0u; mine = (j == x) ? c : mine; }
        if (sum == G) break;
        __builtin_amdgcn_s_sleep(1);
        if ((++sp & 255u) == 0u) { if (xb_ld(&bar[XB_TMO])) break; if (sp > XB_SPIN_CAP) { atomicAdd(&bar[XB_TMO], 1u); break; } }
    }
    nloc = mine > 0u ? mine : 1u; nx = cnt > 0u ? cnt : 1u;
}

__device__ __forceinline__ void xcd_barrier(const XcdBarrier& b) {
    asm volatile("s_waitcnt vmcnt(0)" ::: "memory");
    __syncthreads();
    if (threadIdx.x == 0) {
        unsigned* bar = b.bar;
        __builtin_amdgcn_s_waitcnt(0);
        unsigned nloc = b.st[0], nx = b.st[1];
        if (nloc == 0u) { xcd_barrier_complete(bar, b.x, nloc, nx); b.st[0] = nloc; b.st[1] = nx; }
        const unsigned old = xb_add(&bar[XB_XSUB(b.x)], 1u);
        const unsigned gen = old / nloc;
        if (old + 1u == (gen + 1u) * nloc) {
            __builtin_amdgcn_fence(__ATOMIC_RELEASE, "agent");
            asm volatile("s_waitcnt vmcnt(0)" ::: "memory");
            const unsigned og = xb_add(&bar[XB_TOP], 1u);
            const unsigned tg = og / nx;
            if (og + 1u == (tg + 1u) * nx) xb_add(&bar[XB_TOPGEN], 1u);
            else XB_SPIN(xb_ld(&bar[XB_TOPGEN]) == tg, bar);
            __builtin_amdgcn_fence(__ATOMIC_ACQUIRE, "agent");
            xb_add(&bar[XB_XGEN(b.x)], 1u);
            asm volatile("s_waitcnt vmcnt(0)" ::: "memory");
        } else {
            XB_SPIN(xb_ld(&bar[XB_XGEN(b.x)]) == gen, bar);
            __builtin_amdgcn_fence(__ATOMIC_ACQUIRE, "agent");
            asm volatile("s_waitcnt vmcnt(0)" ::: "memory");
        }
    }
    __syncthreads();
}


DI u16 f2bf(float x) { unsigned u = __float_as_uint(x); u += 0x7fffu + ((u >> 16) & 1u); return (u16)(u >> 16); }
DI float bf2f(u16 v) { return __uint_as_float(((unsigned)v) << 16); }
DI unsigned pack2(float a, float b) { return (unsigned)f2bf(a) | ((unsigned)f2bf(b) << 16); }
DI int crow(int i, int h) { return (i & 3) + 8 * (i >> 2) + 4 * h; }
DI float silu(float v) { return v / (1.f + __expf(-v)); }
DI float wave_sum(float v) { for (int o = 32; o >= 1; o >>= 1) v += __shfl_xor(v, o); return v; }
DI float half_sum(float v) { for (int o = 16; o >= 1; o >>= 1) v += __shfl_xor(v, o); return v; }
DI bf16x8 cvt8(float4 a, float4 b) {
  union { bf16x8 v; unsigned u[4]; } r;
  r.u[0] = pack2(a.x, a.y); r.u[1] = pack2(a.z, a.w); r.u[2] = pack2(b.x, b.y); r.u[3] = pack2(b.z, b.w);
  return r.v;
}
DI void st_u16(void* base, unsigned boff, u16 v) { *(u16*)((char*)base + boff) = v; }
DI void st_f32(void* base, unsigned boff, float v) { *(float*)((char*)base + boff) = v; }
DI float ld_f32(const void* base, unsigned boff) { return *(const float*)((const char*)base + boff); }
DI u16 ld_u16(const void* base, unsigned boff) { return *(const u16*)((const char*)base + boff); }
DI unsigned opaque(unsigned x) { asm volatile("" : "+v"(x)); return x; }
DI int next_task(int* ctr, unsigned char* lds, int tid) {
  int* slot = (int*)(lds + LDS_TASK);
  __syncthreads();
  if (tid == 0) *slot = atomicAdd(ctr, 1);
  __syncthreads();
  return *slot;
}
DI f32x16 zero16() { f32x16 z; for (int i = 0; i < 16; ++i) z[i] = 0.f; return z; }

template <int NT, int MT>
DI void gemm_panel(const unsigned char* panel, const u16* __restrict__ Wt, int ncol0, f32x16 (&acc)[MT][NT], int lane) {
  const int r = lane & 31, h = lane >> 5;
  const char* bu = (const char*)(Wt + (size_t)(ncol0 >> 5) * 64 * 512);
  const unsigned loff = (unsigned)lane * 16u;
  const unsigned char* ap = panel + r * PITCH + 16 * h;
  constexpr int PD = (NT == 4) ? GEMM_PD : 6;
  bf16x8 B[8][NT];
#define LOADB(t, dst) { _Pragma("unroll") for (int nt = 0; nt < NT; ++nt) dst[nt] = *(const bf16x8*)(bu + (size_t)((nt * 64 + (t)) * 1024) + loff); }
#pragma unroll
  for (int t = 0; t < PD; ++t) LOADB(t, B[t]);
#pragma unroll 1
  for (int kb = 0; kb < 8; ++kb) {
#pragma unroll
    for (int s = 0; s < 8; ++s) {
      const int t2 = (kb * 8 + s + PD) & 63;
      LOADB(t2, B[(s + PD) & 7]);
      SBAR();
      const bf16x8 a0 = *(const bf16x8*)(ap + kb * 256 + s * 32);
      bf16x8 a1 = a0; if (MT == 2) a1 = *(const bf16x8*)(ap + 32 * PITCH + kb * 256 + s * 32);
#pragma unroll
      for (int nt = 0; nt < NT; ++nt) { acc[0][nt] = MFMA32(a0, B[s][nt], acc[0][nt]); if (MT == 2) acc[MT - 1][nt] = MFMA32(a1, B[s][nt], acc[MT - 1][nt]); }
      SBAR();
    }
  }
#undef LOADB
}

DI float half_reduce_scatter16(const float (&v)[16], int r) {
  const bool b4 = (r & 16) != 0, b3 = (r & 8) != 0, b2 = (r & 4) != 0, b1 = (r & 2) != 0;
  float a8[8], a4[4], a2[2];
#pragma unroll
  for (int j = 0; j < 8; ++j) { const float mine = b4 ? v[j + 8] : v[j], th = b4 ? v[j] : v[j + 8]; a8[j] = mine + __shfl_xor(th, 16); }
#pragma unroll
  for (int j = 0; j < 4; ++j) { const float mine = b3 ? a8[j + 4] : a8[j], th = b3 ? a8[j] : a8[j + 4]; a4[j] = mine + __shfl_xor(th, 8); }
#pragma unroll
  for (int j = 0; j < 2; ++j) { const float mine = b2 ? a4[j + 2] : a4[j], th = b2 ? a4[j] : a4[j + 2]; a2[j] = mine + __shfl_xor(th, 4); }
  const float mine = b1 ? a2[1] : a2[0], th = b1 ? a2[0] : a2[1];
  float a1 = mine + __shfl_xor(th, 2);
  a1 += __shfl_xor(a1, 1);
  return a1;
}
template <int MT>
DI void row_rstd(const f32x16 (&acc)[MT][4], float* red, float* tot, int w, int lane, int tid) {
  const int r = lane & 31, h = lane >> 5;
#pragma unroll
  for (int mt = 0; mt < MT; ++mt) {
    float v[16];
#pragma unroll
    for (int i = 0; i < 16; ++i) {
      float t = 0.f;
#pragma unroll
      for (int nt = 0; nt < 4; ++nt) t += acc[mt][nt][i] * acc[mt][nt][i];
      v[i] = t;
    }
    const float tsum = half_reduce_scatter16(v, r);
    if ((r & 1) == 0) red[w * 64 + mt * 32 + crow(r >> 1, h)] = tsum;
  }
  __syncthreads();
  if (tid < 64) { float s = 0.f; for (int ww = 0; ww < 8; ++ww) s += red[ww * 64 + tid]; tot[tid] = rsqrtf(s * (1.f / 1024.f) + EPS); }
  __syncthreads();
}

DI void load_norm_panel(const float* __restrict__ src, const float* __restrict__ gain, unsigned char* panel, int w, int lane) {
  float4 g[4];
#pragma unroll
  for (int j = 0; j < 4; ++j) g[j] = ((const float4*)gain)[lane + 64 * j];
#pragma unroll 1
  for (int rb = 0; rb < 2; ++rb) {
    float4 v[4][4];
#pragma unroll
    for (int rr = 0; rr < 4; ++rr)
#pragma unroll
      for (int j = 0; j < 4; ++j) v[rr][j] = ((const float4*)(src + (size_t)(w * 8 + rb * 4 + rr) * 1024))[lane + 64 * j];
    SBAR();
#pragma unroll
    for (int rr = 0; rr < 4; ++rr) {
      const int row = w * 8 + rb * 4 + rr;
      float ss = 0.f;
#pragma unroll
      for (int j = 0; j < 4; ++j) ss += v[rr][j].x * v[rr][j].x + v[rr][j].y * v[rr][j].y + v[rr][j].z * v[rr][j].z + v[rr][j].w * v[rr][j].w;
      ss = wave_sum(ss);
      const float rstd = rsqrtf(ss * (1.f / 1024.f) + EPS);
#pragma unroll
      for (int j = 0; j < 4; ++j) {
        uint2 o; o.x = pack2(v[rr][j].x * rstd * g[j].x, v[rr][j].y * rstd * g[j].y); o.y = pack2(v[rr][j].z * rstd * g[j].z, v[rr][j].w * rstd * g[j].w);
        *(uint2*)(panel + row * PITCH + (lane + 64 * j) * 8) = o;
      }
    }
  }
}

DI void norm_rows_to_global(const float* __restrict__ src, const float* __restrict__ gain, u16* __restrict__ dst, int w, int lane) {
  float4 g[4];
#pragma unroll
  for (int j = 0; j < 4; ++j) g[j] = ((const float4*)gain)[lane + 64 * j];
#pragma unroll 1
  for (int rb = 0; rb < 2; ++rb) {
    float4 v[4][4];
#pragma unroll
    for (int rr = 0; rr < 4; ++rr)
#pragma unroll
      for (int j = 0; j < 4; ++j) v[rr][j] = ((const float4*)(src + (size_t)(w * 8 + rb * 4 + rr) * 1024))[lane + 64 * j];
    SBAR();
#pragma unroll
    for (int rr = 0; rr < 4; ++rr) {
      const int row = w * 8 + rb * 4 + rr;
      float ss = 0.f;
#pragma unroll
      for (int j = 0; j < 4; ++j) ss += v[rr][j].x * v[rr][j].x + v[rr][j].y * v[rr][j].y + v[rr][j].z * v[rr][j].z + v[rr][j].w * v[rr][j].w;
      ss = wave_sum(ss);
      const float rstd = rsqrtf(ss * (1.f / 1024.f) + EPS);
#pragma unroll
      for (int j = 0; j < 4; ++j) {
        uint2 o; o.x = pack2(v[rr][j].x * rstd * g[j].x, v[rr][j].y * rstd * g[j].y); o.y = pack2(v[rr][j].z * rstd * g[j].z, v[rr][j].w * rstd * g[j].w);
        *(uint2*)(dst + (size_t)row * 1024 + (lane + 64 * j) * 4) = o;
      }
    }
  }
}

template <bool FRAG>
DI void convert_tile(const float* __restrict__ src, u16* __restrict__ dst, int K, int N, int k0, int n0, unsigned char* lds, int tid) {
  u16* T = (u16*)lds;
  {
    const int kk = tid >> 3, n8 = (tid & 7) * 8;
    const float4* s = (const float4*)(src + (size_t)(k0 + kk) * N + n0 + n8);
    const float4 a = s[0], bq = s[1];
    T[(n8 + 0) * 72 + kk] = f2bf(a.x); T[(n8 + 1) * 72 + kk] = f2bf(a.y); T[(n8 + 2) * 72 + kk] = f2bf(a.z); T[(n8 + 3) * 72 + kk] = f2bf(a.w);
    T[(n8 + 4) * 72 + kk] = f2bf(bq.x); T[(n8 + 5) * 72 + kk] = f2bf(bq.y); T[(n8 + 6) * 72 + kk] = f2bf(bq.z); T[(n8 + 7) * 72 + kk] = f2bf(bq.w);
  }
  __syncthreads();
  {
    const int n = tid >> 3, k8 = (tid & 7) * 8;
    const uint4 v = *(const uint4*)(T + n * 72 + k8);
    if (FRAG) {
      const int ng = n0 + n, kg = k0 + k8;
      const size_t off = (((size_t)(ng >> 5) * (K >> 4) + (kg >> 4)) * 64 + ((kg >> 3) & 1) * 32 + (ng & 31)) * 8;
      *(uint4*)(dst + off) = v;
    } else *(uint4*)(dst + (size_t)(n0 + n) * K + k0 + k8) = v;
  }
  __syncthreads();
}

template <bool FRAG>
DI void convert_strip(const float* __restrict__ src, u16* __restrict__ dst, int K, int N, int k0, int n0, unsigned char* lds, int tid) {
  const int kk = tid >> 3, n8 = (tid & 7) * 8;
  float4 a[4], bq[4];
#pragma unroll
  for (int q = 0; q < 4; ++q) { const float4* sp = (const float4*)(src + (size_t)(k0 + kk) * N + n0 + q * 64 + n8); a[q] = sp[0]; bq[q] = sp[1]; }
  SBAR();
#pragma unroll
  for (int q = 0; q < 4; ++q) {
    u16* T = (u16*)(lds + q * 9216);
    T[(n8 + 0) * 72 + kk] = f2bf(a[q].x); T[(n8 + 1) * 72 + kk] = f2bf(a[q].y); T[(n8 + 2) * 72 + kk] = f2bf(a[q].z); T[(n8 + 3) * 72 + kk] = f2bf(a[q].w);
    T[(n8 + 4) * 72 + kk] = f2bf(bq[q].x); T[(n8 + 5) * 72 + kk] = f2bf(bq[q].y); T[(n8 + 6) * 72 + kk] = f2bf(bq[q].z); T[(n8 + 7) * 72 + kk] = f2bf(bq[q].w);
  }
  __syncthreads();
  {
    const int n = tid >> 3, k8 = (tid & 7) * 8;
#pragma unroll
    for (int q = 0; q < 4; ++q) {
      const uint4 v = *(const uint4*)((const u16*)(lds + q * 9216) + n * 72 + k8);
      const int ng = n0 + q * 64 + n, kg = k0 + k8;
      if (FRAG) {
        const size_t off = (((size_t)(ng >> 5) * (K >> 4) + (kg >> 4)) * 64 + ((kg >> 3) & 1) * 32 + (ng & 31)) * 8;
        *(uint4*)(dst + off) = v;
      } else *(uint4*)(dst + (size_t)ng * K + kg) = v;
    }
  }
  __syncthreads();
}
__device__ __forceinline__ void phase0(const Params& p, unsigned char* lds, int tid) {
  constexpr int PER_L = 224 + 320;
  const int ntask = DEPTH * PER_L + DEPTH * 4 + 288;
  for (int task = blockIdx.x; task < ntask; task += gridDim.x) {
    if (task >= DEPTH * PER_L + DEPTH * 4) {
      const int R0 = (task - (DEPTH * PER_L + DEPTH * 4)) * 64;
      const float* src = R0 < NPROMPT ? p.x_prompt + (size_t)R0 * DM : p.x_sample + (size_t)(R0 - NPROMPT) * DM;
      norm_rows_to_global(src, p.norm_mix_pre, (u16*)(p.ws + WS_H) + (size_t)R0 * DM, __builtin_amdgcn_readfirstlane(tid >> 6), tid & 63);
    } else if (task < DEPTH * PER_L) {
      const int l = task / PER_L, rr = task % PER_L;
      if (rr < 224) {
        const int kt = rr / 14, nt = rr % 14;
        convert_strip<false>(p.w_in + (size_t)l * DM * DIN, (u16*)(p.ws + WS_WIN) + (size_t)l * DIN * DM, DM, DIN, kt * 64, nt * 256, lds, tid);
      } else {
        const int m = (rr - 224) >> 6, tt = (rr - 224) & 63;
        const float* src = (m == 0 ? p.w_out : m == 1 ? p.w_xq : m == 2 ? p.w_xk : m == 3 ? p.w_xv : p.w_xo) + (size_t)l * DM * DM;
        convert_strip<true>(src, (u16*)(p.ws + WS_WSQ) + (size_t)(l * 5 + m) * DM * DM, DM, DM, (tt >> 2) * 64, (tt & 3) * 256, lds, tid);
      }
    } else {
      const int j = task - DEPTH * PER_L;
      convert_tile<false>(p.w_pool + (size_t)j * 4096, (u16*)(p.ws + WS_WPT) + (size_t)j * 4096, 64, 64, 0, 0, lds, tid);
    }
  }
  if (blockIdx.x == 0) {
    if (tid < 64) ((int*)(p.ws + WS_CTR))[tid] = 0;
    float* LB = (float*)(p.ws + WS_LB);
    for (int c = tid; c < 512; c += NTHREADS) {
      float a[DEPTH], mx = -3.0e38f;
      for (int l = 0; l < DEPTH; ++l) { a[l] = p.lb_logits[l * 512 + c]; mx = fmaxf(mx, a[l]); }
      float s = 0.f; for (int l = 0; l < DEPTH; ++l) { a[l] = expf(a[l] - mx); s += a[l]; }
      float cum = 0.f; const float first = a[0] / s;
      for (int l = 0; l < DEPTH; ++l) { cum += a[l] / s; const float lb = fmaxf(cum - first, 0.f); LB[l * 1024 + c] = lb > 0.f ? logf(lb) : -1e30f; LB[l * 1024 + 512 + c] = log1pf(-lb); }
    }
  }
}

__device__ __forceinline__ void memkv_task(const Params& p, int j, unsigned char* lds, int tid_) {
  const int tid = (int)opaque((unsigned)tid_);
  const int w = __builtin_amdgcn_readfirstlane(tid >> 6), lane = tid & 63, r = lane & 31, h = lane >> 5;
  const int l = j >> 3, mt8 = j & 7;
  load_norm_panel(p.mem_prompt + (size_t)mt8 * 64 * DM, p.norm_mem + l * DM, lds, w, lane);
  __syncthreads();
  for (int kv = 0; kv < 2; ++kv) {
    f32x16 acc[2][4];
    for (int a = 0; a < 2; ++a) for (int c = 0; c < 4; ++c) acc[a][c] = zero16();
    gemm_panel<4, 2>(lds, (const u16*)(p.ws + WS_WSQ) + (size_t)(l * 5 + 2 + kv) * DM * DM, w * 128, acc, lane);
    float* dst = p.out + (kv ? O_PMV : O_PMK) + ((size_t)l * 512 + mt8 * 64) * DM;
    const unsigned so = opaque((unsigned)((4 * h) * DM + w * 128 + r) * 4u);
#pragma unroll
    for (int mt = 0; mt < 2; ++mt)
#pragma unroll
      for (int nt = 0; nt < 4; ++nt)
#pragma unroll
        for (int i = 0; i < 16; ++i) { st_f32(dst, so + (unsigned)((mt * 32 + (i & 3) + 8 * (i >> 2)) * DM + nt * 32) * 4u, acc[mt][nt][i]); if ((i & 7) == 7) SBAR(); }
    {
      const int b = mt8 >> 2, hh = w >> 1;
      const int lq = (int)opaque((unsigned)lane), r = lq & 31, h = lq >> 5;
      u16* fb = (u16*)(p.ws + (kv ? WS_VF : WS_KF)) + (size_t)((l * 2 + b) * 4 + hh) * 8 * 16 * 512;
#pragma unroll
      for (int mt = 0; mt < 2; ++mt)
#pragma unroll
        for (int nt = 0; nt < 4; ++nt)
#pragma unroll
          for (int i = 0; i < 16; ++i) {
            const int m = (mt8 & 3) * 64 + mt * 32 + crow(i, h);
            const int d = (w & 1) * 128 + nt * 32 + r;
            unsigned off;
            if (!kv) off = (unsigned)((((m >> 5) * 16 + (d >> 4)) * 64 + 32 * ((d >> 3) & 1) + (m & 31)) * 8 + (d & 7));
            else off = (unsigned)((((d >> 5) * 16 + (m >> 4)) * 64 + 32 * ((m >> 3) & 1) + (d & 31)) * 8 + (m & 7));
            st_u16(fb, off * 2u, f2bf(acc[mt][nt][i]));
            if ((i & 7) == 7) SBAR();
          }
    }
  }
  __syncthreads();
}

__device__ __forceinline__ void kvconv_task(const Params& p, int l, int task, int tid) {
  const int b = task >> 4, kv = (task >> 3) & 1, sub = task & 7;
  const float* src = (kv ? p.cache_mem_v : p.cache_mem_k) + (size_t)(l * DEC_B + b) * 256 * 1024;
  u16* dst = (u16*)(p.ws + (kv ? WS_VFS : WS_KFS)) + (size_t)b * 4 * 8 * 16 * 512;
  if (!kv) {
#pragma unroll 1
    for (int it = sub * 8; it < sub * 8 + 8; it += 8) {
      float4 a[8], c[8];
#pragma unroll
      for (int q = 0; q < 8; ++q) { const int pc = (it + q) * NTHREADS + tid; const float* sp = src + (size_t)pc * 8; a[q] = *(const float4*)sp; c[q] = *(const float4*)(sp + 4); }
      SBAR();
#pragma unroll
      for (int q = 0; q < 8; ++q) {
        const int pc = (it + q) * NTHREADS + tid;
        const int m = pc >> 7, hh = (pc >> 5) & 3, d8 = pc & 31;
        const unsigned off = (unsigned)((((hh * 8 + (m >> 5)) * 16 + (d8 >> 1)) * 64 + 32 * (d8 & 1) + (m & 31)) * 8);
        uint4 o; o.x = pack2(a[q].x, a[q].y); o.y = pack2(a[q].z, a[q].w); o.z = pack2(c[q].x, c[q].y); o.w = pack2(c[q].z, c[q].w);
        *(uint4*)(dst + off) = o;
      }
    }
  } else {
#pragma unroll 1
    for (int it = sub * 8; it < sub * 8 + 8; it += 2) {
      float v[2][8];
#pragma unroll
      for (int q = 0; q < 2; ++q) {
        const int pc = (it + q) * NTHREADS + tid;
        const int m8 = pc >> 10, cc = pc & 1023;
#pragma unroll
        for (int j = 0; j < 8; ++j) v[q][j] = src[(size_t)(m8 * 8 + j) * 1024 + cc];
      }
      SBAR();
#pragma unroll
      for (int q = 0; q < 2; ++q) {
        const int pc = (it + q) * NTHREADS + tid;
        const int m8 = pc >> 10, hh = (pc >> 8) & 3, d = pc & 255;
        const unsigned off = (unsigned)((((hh * 8 + (d >> 5)) * 16 + (m8 >> 1)) * 64 + 32 * (m8 & 1) + (d & 31)) * 8);
        uint4 o; o.x = pack2(v[q][0], v[q][1]); o.y = pack2(v[q][2], v[q][3]); o.z = pack2(v[q][4], v[q][5]); o.w = pack2(v[q][6], v[q][7]);
        *(uint4*)(dst + off) = o;
      }
    }
  }
}

DI void hgrn_load_G(const float* __restrict__ GF, int R0, int hd, float (&g)[16], float (&G)[16], float& GL, float& Gm, float* qtot, int tid) {
  const int k = tid & 127, q4 = tid >> 7;
  float run = 0.f;
#pragma unroll
  for (int j = 0; j < 16; ++j) g[j] = GF[(size_t)(R0 + q4 * 16 + j) * 512 + hd * 128 + k];
  SBAR();
#pragma unroll
  for (int j = 0; j < 16; ++j) { run += g[j]; G[j] = run; }
  qtot[q4 * 128 + k] = run;
  __syncthreads();
  const float q0 = qtot[k], q1 = qtot[128 + k], q2 = qtot[256 + k], q3 = qtot[384 + k];
  const float off = (q4 > 0 ? q0 : 0.f) + (q4 > 1 ? q1 : 0.f) + (q4 > 2 ? q2 : 0.f);
#pragma unroll
  for (int j = 0; j < 16; ++j) G[j] += off;
  GL = q0 + q1 + q2 + q3; Gm = q0 + q1;
}
DI void chunk_rows(int task, int& R0, int& hd) {
  if (task < 1024) { const int sh = task >> 7, c = task & 127; R0 = (sh >> 2) * SEQ + c * 64; hd = sh & 3; }
  else { const int sh = task - 1024; R0 = NPROMPT + (sh >> 2) * 64; hd = sh & 3; }
}

__device__ __forceinline__ void hgrn_passA(const Params& p, int task, unsigned char* lds, int tid) {
  const int w = __builtin_amdgcn_readfirstlane(tid >> 6), lane = tid & 63, r = lane & 31, h = lane >> 5;
  float* qtot = (float*)lds;
  u16* KT = (u16*)(lds + 2048);
  u16* VT = (u16*)(lds + 2048 + 128 * 144);
  const u16* PROJ = (const u16*)(p.ws + WS_PROJ);
  int R0, hd; chunk_rows(task, R0, hd);
  const int k = tid & 127, q4 = tid >> 7;
  u16 vraw[16];
#pragma unroll
  for (int j = 0; j < 16; ++j) vraw[j] = PROJ[(size_t)(R0 + q4 * 16 + j) * DIN + C_AI + hd * 128 + k];
  float g[16], G[16], GL, Gm;
  hgrn_load_G((const float*)(p.ws + WS_GF), R0, hd, g, G, GL, Gm, qtot, tid);
#pragma unroll
  for (int j = 0; j < 16; ++j) {
    const int s = q4 * 16 + j;
    KT[k * 72 + s] = f2bf((1.f - __expf(g[j])) * __expf(GL - G[j]));
    VT[k * 72 + s] = vraw[j];
  }
  if (q4 == 0) ((float*)(p.ws + WS_DEC))[(size_t)task * 128 + k] = __expf(GL);
  __syncthreads();
  const int vt = w >> 1, kt0 = (w & 1) * 2;
  f32x16 acc[2]; acc[0] = zero16(); acc[1] = zero16();
#pragma unroll
  for (int ss = 0; ss < 4; ++ss) {
    const bf16x8 a = *(const bf16x8*)(VT + (vt * 32 + r) * 72 + 16 * ss + 8 * h);
#pragma unroll
    for (int q = 0; q < 2; ++q) {
      const bf16x8 bb = *(const bf16x8*)(KT + ((kt0 + q) * 32 + r) * 72 + 16 * ss + 8 * h);
      acc[q] = MFMA32(a, bb, acc[q]);
    }
  }
  float* DS = (float*)(p.ws + WS_DS) + (size_t)task * 16384;
#pragma unroll
  for (int q = 0; q < 2; ++q)
#pragma unroll
    for (int i = 0; i < 16; ++i) DS[(vt * 32 + crow(i, h)) * 128 + (kt0 + q) * 32 + r] = acc[q][i];
  __syncthreads();
}

__device__ __forceinline__ void hgrn_scan_unit(const Params& p, int l, int unit, unsigned char* lds, int tid) {
  float* tmp = (float*)lds;
  const float* DS = (const float*)(p.ws + WS_DS);
  const float* DEC = (const float*)(p.ws + WS_DEC);
  u16* SPT = (u16*)(p.ws + WS_SPT);
  if (unit < 128) {
    const int sh = unit >> 4, v0 = (unit & 15) * 8;
    const int v = tid >> 6, k2 = (tid & 63) * 2;
    const int ka = tid >> 2, va = (tid & 3) * 2;
    float s0 = 0.f, s1 = 0.f;
    const unsigned eoff = (unsigned)((v0 + v) * 128 + k2);
    const float* dsb = DS + (size_t)(sh * 128) * 16384;
    const float* dcb = DEC + (size_t)(sh * 128) * 128;
    u16* spb = SPT + (size_t)(sh * 128) * 16384;
#pragma unroll 1
    for (int c0 = 0; c0 < 128; c0 += 16) {
      float2 d[16], dc[16];
#pragma unroll
      for (int j = 0; j < 16; ++j) { d[j] = *(const float2*)(dsb + (size_t)(c0 + j) * 16384 + eoff); dc[j] = *(const float2*)(dcb + (c0 + j) * 128 + k2); }
      SBAR();
#pragma unroll
      for (int j = 0; j < 16; ++j) {
        *(unsigned*)(spb + (size_t)(c0 + j) * 16384 + eoff) = pack2(s0, s1);
        s0 = dc[j].x * s0 + d[j].x; s1 = dc[j].y * s1 + d[j].y;
      }
    }
    tmp[v * 130 + k2] = s0; tmp[v * 130 + k2 + 1] = s1;
    __syncthreads();
    float2 o; o.x = tmp[va * 130 + ka]; o.y = tmp[(va + 1) * 130 + ka];
    *(float2*)(p.out + O_PHS + ((size_t)l * 8 + sh) * 16384 + (size_t)ka * 128 + v0 + va) = o;
    __syncthreads();
  } else {
    const int u = unit - 128, ss = u >> 2, v0 = (u & 3) * 32;
    const int task = 1024 + ss;
    const int ka = tid >> 2, va = (tid & 3) * 8;
    const int v = tid >> 4, k8 = (tid & 15) * 8;
    const float* st = p.state_hgrn + ((size_t)l * 128 + ss) * 16384 + (size_t)ka * 128 + v0 + va;
    const float4 x0 = *(const float4*)st, x1 = *(const float4*)(st + 4);
    const float* dp = DS + (size_t)task * 16384 + (size_t)(v0 + v) * 128 + k8;
    const float4 d0 = *(const float4*)dp, d1 = *(const float4*)(dp + 4);
    const float* cp = DEC + (size_t)task * 128 + k8;
    const float4 c0 = *(const float4*)cp, c1 = *(const float4*)(cp + 4);
    SBAR();
    tmp[(va + 0) * 129 + ka] = x0.x; tmp[(va + 1) * 129 + ka] = x0.y; tmp[(va + 2) * 129 + ka] = x0.z; tmp[(va + 3) * 129 + ka] = x0.w;
    tmp[(va + 4) * 129 + ka] = x1.x; tmp[(va + 5) * 129 + ka] = x1.y; tmp[(va + 6) * 129 + ka] = x1.z; tmp[(va + 7) * 129 + ka] = x1.w;
    __syncthreads();
    float sv[8];
#pragma unroll
    for (int j = 0; j < 8; ++j) sv[j] = tmp[v * 129 + k8 + j];
    uint4 pk; pk.x = pack2(sv[0], sv[1]); pk.y = pack2(sv[2], sv[3]); pk.z = pack2(sv[4], sv[5]); pk.w = pack2(sv[6], sv[7]);
    *(uint4*)(SPT + (size_t)task * 16384 + (size_t)(v0 + v) * 128 + k8) = pk;
    __syncthreads();
    tmp[v * 129 + k8 + 0] = c0.x * sv[0] + d0.x; tmp[v * 129 + k8 + 1] = c0.y * sv[1] + d0.y; tmp[v * 129 + k8 + 2] = c0.z * sv[2] + d0.z; tmp[v * 129 + k8 + 3] = c0.w * sv[3] + d0.w;
    tmp[v * 129 + k8 + 4] = c1.x * sv[4] + d1.x; tmp[v * 129 + k8 + 5] = c1.y * sv[5] + d1.y; tmp[v * 129 + k8 + 6] = c1.z * sv[6] + d1.z; tmp[v * 129 + k8 + 7] = c1.w * sv[7] + d1.w;
    __syncthreads();
    float4 o0, o1;
    o0.x = tmp[(va + 0) * 129 + ka]; o0.y = tmp[(va + 1) * 129 + ka]; o0.z = tmp[(va + 2) * 129 + ka]; o0.w = tmp[(va + 3) * 129 + ka];
    o1.x = tmp[(va + 4) * 129 + ka]; o1.y = tmp[(va + 5) * 129 + ka]; o1.z = tmp[(va + 6) * 129 + ka]; o1.w = tmp[(va + 7) * 129 + ka];
    float* fp = p.out + O_SHS + ((size_t)l * 128 + ss) * 16384 + (size_t)ka * 128 + v0 + va;
    *(float4*)fp = o0; *(float4*)(fp + 4) = o1;
    __syncthreads();
  }
}

__device__ __forceinline__ void hgrn_passC(const Params& p, int l, int task, unsigned char* lds, int tid) {
  const int w = __builtin_amdgcn_readfirstlane(tid >> 6), lane = tid & 63, r = lane & 31, h = lane >> 5;
  float* qtot = (float*)lds;
  u16* Qm = (u16*)(lds + 2048);
  u16* Km = (u16*)(lds + 2048 + 17408);
  u16* QS = (u16*)(lds + 2048 + 2 * 17408);
  u16* VT = (u16*)(lds + 2048 + 3 * 17408);
  u16* ATT = (u16*)(lds + 2048 + 3 * 17408 + 18432);
  float* psum = (float*)(lds + 2048 + 3 * 17408 + 18432 + 9216);
  const u16* PROJ = (const u16*)(p.ws + WS_PROJ);
  int R0, hd; chunk_rows(task, R0, hd);
  bf16x8 spf[8];
  {
    const u16* SPp = (const u16*)(p.ws + WS_SPT) + (size_t)task * 16384 + (size_t)((w & 3) * 32 + r) * 128 + 8 * h;
#pragma unroll
    for (int sk = 0; sk < 8; ++sk) spf[sk] = *(const bf16x8*)(SPp + 16 * sk);
  }
  const float og = p.onorm_g[l * 512 + hd * 128 + (w & 3) * 32 + r];
  u16 graw[16];
#pragma unroll
  for (int i = 0; i < 16; ++i) graw[i] = PROJ[(size_t)(R0 + (w >> 2) * 32 + crow(i, h)) * DIN + C_AG + hd * 128 + (w & 3) * 32 + r];
  u16 qraw[16], vraw[16];
  {
    const int k = tid & 127, q4 = tid >> 7;
#pragma unroll
    for (int j = 0; j < 16; ++j) { qraw[j] = PROJ[(size_t)(R0 + q4 * 16 + j) * DIN + C_AQ + hd * 128 + k]; vraw[j] = PROJ[(size_t)(R0 + q4 * 16 + j) * DIN + C_AI + hd * 128 + k]; }
  }
  float g[16], G[16], GL, Gm;
  hgrn_load_G((const float*)(p.ws + WS_GF), R0, hd, g, G, GL, Gm, qtot, tid);
  {
    const int k = tid & 127, q4 = tid >> 7;
#pragma unroll
    for (int j = 0; j < 16; ++j) {
      const int s = q4 * 16 + j;
      const float q = bf2f(qraw[j]);
      const float d1 = fminf(fmaxf(G[j] - Gm, -80.f), 80.f);
      Qm[s * 136 + k] = f2bf(q * __expf(d1));
      Km[s * 136 + k] = f2bf((1.f - __expf(g[j])) * __expf(-d1));
      QS[s * 136 + k] = f2bf(q * __expf(G[j]));
      VT[k * 72 + s] = vraw[j];
    }
  }
  __syncthreads();
  if (w < 4) {
    const int tt = w >> 1, st = w & 1;
    f32x16 a = zero16();
    if (st <= tt) {
#pragma unroll
      for (int sk = 0; sk < 8; ++sk) {
        const bf16x8 fa = *(const bf16x8*)(Qm + (tt * 32 + r) * 136 + 16 * sk + 8 * h);
        const bf16x8 fb = *(const bf16x8*)(Km + (st * 32 + r) * 136 + 16 * sk + 8 * h);
        a = MFMA32(fa, fb, a);
      }
    }
    const int s = st * 32 + r;
#pragma unroll
    for (int i = 0; i < 16; ++i) {
      const int t = tt * 32 + crow(i, h);
      ATT[t * 72 + s] = (st <= tt && s <= t) ? f2bf(a[i]) : (u16)0;
    }
  }
  __syncthreads();
  const int tt = w >> 2, vt = w & 3;
  f32x16 o = zero16();
#pragma unroll
  for (int ss = 0; ss < 4; ++ss) {
    const bf16x8 fa = *(const bf16x8*)(ATT + (tt * 32 + r) * 72 + 16 * ss + 8 * h);
    const bf16x8 fb = *(const bf16x8*)(VT + (vt * 32 + r) * 72 + 16 * ss + 8 * h);
    o = MFMA32(fa, fb, o);
  }
#pragma unroll
  for (int sk = 0; sk < 8; ++sk) {
    const bf16x8 fa = *(const bf16x8*)(QS + (tt * 32 + r) * 136 + 16 * sk + 8 * h);
    o = MFMA32(fa, spf[sk], o);
  }
  {
    float v2[16];
#pragma unroll
    for (int i = 0; i < 16; ++i) v2[i] = o[i] * o[i];
    const float tsum = half_reduce_scatter16(v2, r);
    if ((r & 1) == 0) psum[vt * 64 + tt * 32 + crow(r >> 1, h)] = tsum;
  }
  __syncthreads();
  const int v = vt * 32 + r;
  u16* MIX = (u16*)(p.ws + WS_MIX);
#pragma unroll
  for (int i = 0; i < 16; ++i) {
    const int t = tt * 32 + crow(i, h);
    const float ssq = psum[t] + psum[64 + t] + psum[128 + t] + psum[192 + t];
    const float rstd = rsqrtf(ssq * (1.f / 128.f) + EPS);
    const size_t row = (size_t)(R0 + t);
    MIX[row * DM + hd * 128 + v] = f2bf(o[i] * rstd * og * bf2f(graw[i]));
  }
  __syncthreads();
}

__device__ __forceinline__ void sb_wave(const Params& p, int l, int grp, int b, int head, int q0, int lane) {
  const int r = lane & 31, h = lane >> 5;
  const u16* PROJ = (const u16*)(p.ws + WS_PROJ);
  const int Rbase = grp ? NPROMPT + b * 64 : b * SEQ;
  const int past = grp ? PAST : 0;
  const float* ck = p.cache_sb_k + (size_t)(l * DEC_B + b) * PAST * 256;
  const float* cv = p.cache_sb_v + (size_t)(l * DEC_B + b) * PAST * 256;
  bf16x8 qf[4];
#pragma unroll
  for (int s = 0; s < 4; ++s) qf[s] = *(const bf16x8*)(PROJ + (size_t)(Rbase + q0 + r) * DIN + C_BQ + head * 64 + 16 * s + 8 * h);
  const int qpos = past + q0 + r;
  float carry = 0.f;
  f32x16 O[2]; O[0] = zero16(); O[1] = zero16();
  const int T0 = (past + q0) >> 5;
  unsigned raw[64];
#define SB_ISSUE(T_) do { const int Tn_ = (T_); \
    if (Tn_ * 32 >= past) { \
      const u16* kp_ = PROJ + (size_t)(Rbase + Tn_ * 32 - past + r) * DIN + C_BK + head * 64 + 8 * h; \
      _Pragma("unroll") for (int s_ = 0; s_ < 4; ++s_) { const uint4 t_ = *(const uint4*)(kp_ + 16 * s_); raw[4 * s_] = t_.x; raw[4 * s_ + 1] = t_.y; raw[4 * s_ + 2] = t_.z; raw[4 * s_ + 3] = t_.w; } \
      const u16* vp_ = PROJ + (size_t)(Rbase + Tn_ * 32 - past + 4 * h) * DIN + C_BV + head * 64 + r; \
      _Pragma("unroll") for (int e_ = 0; e_ < 32; ++e_) raw[16 + e_] = vp_[(size_t)(16 * (e_ >> 4) + 8 * ((e_ >> 2) & 1) + (e_ & 3)) * DIN + ((e_ >> 3) & 1) * 32]; \
    } else { \
      const float* kp_ = ck + (size_t)(Tn_ * 32 + r) * 256 + head * 64 + 8 * h; \
      _Pragma("unroll") for (int s_ = 0; s_ < 8; ++s_) { const uint4 t_ = *(const uint4*)(kp_ + 16 * (s_ >> 1) + 4 * (s_ & 1)); raw[4 * s_] = t_.x; raw[4 * s_ + 1] = t_.y; raw[4 * s_ + 2] = t_.z; raw[4 * s_ + 3] = t_.w; } \
      const float* vp_ = cv + (size_t)(Tn_ * 32 + 4 * h) * 256 + head * 64 + r; \
      _Pragma("unroll") for (int e_ = 0; e_ < 32; ++e_) raw[32 + e_] = __float_as_uint(vp_[(size_t)(16 * (e_ >> 4) + 8 * ((e_ >> 2) & 1) + (e_ & 3)) * 256 + ((e_ >> 3) & 1) * 32]); \
    } } while (0)
  SB_ISSUE(T0);
  for (int T = T0; T >= 0; --T) {
    const bool isnew = T * 32 >= past;
    union { bf16x8 v; unsigned u[4]; } kf[4], vf[2][2];
    if (isnew) {
#pragma unroll
      for (int s = 0; s < 4; ++s)
#pragma unroll
        for (int j = 0; j < 4; ++j) kf[s].u[j] = raw[4 * s + j];
#pragma unroll
      for (int s = 0; s < 2; ++s)
#pragma unroll
        for (int dt = 0; dt < 2; ++dt)
#pragma unroll
          for (int j = 0; j < 4; ++j) vf[s][dt].u[j] = (raw[16 + s * 16 + dt * 8 + 2 * j] & 0xffffu) | (raw[16 + s * 16 + dt * 8 + 2 * j + 1] << 16);
    } else {
#pragma unroll
      for (int s = 0; s < 4; ++s)
#pragma unroll
        for (int j = 0; j < 4; ++j) kf[s].u[j] = pack2(__uint_as_float(raw[8 * s + 2 * j]), __uint_as_float(raw[8 * s + 2 * j + 1]));
#pragma unroll
      for (int s = 0; s < 2; ++s)
#pragma unroll
        for (int dt = 0; dt < 2; ++dt)
#pragma unroll
          for (int j = 0; j < 4; ++j) vf[s][dt].u[j] = pack2(__uint_as_float(raw[32 + s * 16 + dt * 8 + 2 * j]), __uint_as_float(raw[32 + s * 16 + dt * 8 + 2 * j + 1]));
    }
    if (T > 0) SB_ISSUE(T - 1);
    SBAR();
    f32x16 z = zero16();
#pragma unroll
    for (int s = 0; s < 4; ++s) z = MFMA32(kf[s].v, qf[s], z);
    float lsm[16]; bool msk[16];
#pragma unroll
    for (int i = 0; i < 16; ++i) {
      msk[i] = (T * 32 + crow(i, h)) < qpos;
      const float sp = fmaxf(z[i], 0.f) + __logf(1.f + __expf(-fabsf(z[i])));
      lsm[i] = msk[i] ? -sp : 0.f;
    }
    float town[4], toth[4];
#pragma unroll
    for (int g = 0; g < 4; ++g) {
      lsm[4 * g + 2] += lsm[4 * g + 3]; lsm[4 * g + 1] += lsm[4 * g + 2]; lsm[4 * g + 0] += lsm[4 * g + 1];
      town[g] = lsm[4 * g];
    }
#pragma unroll
    for (int g = 0; g < 4; ++g) toth[g] = __shfl_xor(town[g], 32);
    float spair = 0.f;
    float ag[4];
#pragma unroll
    for (int g = 3; g >= 0; --g) { ag[g] = spair + (h == 0 ? toth[g] : 0.f); spair += town[g] + toth[g]; }
    union { bf16x8 v; unsigned u[4]; } pf[2];
#pragma unroll
    for (int i = 0; i < 16; i += 2) {
      const float w0 = msk[i] ? __expf(z[i] + lsm[i] + ag[i >> 2] + carry) : 0.f;
      const float w1 = msk[i + 1] ? __expf(z[i + 1] + lsm[i + 1] + ag[i >> 2] + carry) : 0.f;
      pf[i >> 3].u[(i & 7) >> 1] = pack2(w0, w1);
    }
    carry += spair;
#pragma unroll
    for (int s = 0; s < 2; ++s)
#pragma unroll
      for (int dt = 0; dt < 2; ++dt) O[dt] = MFMA32(pf[s].v, vf[s][dt].v, O[dt]);
    if (__all(carry < -110.f)) break;
  }
#undef SB_ISSUE
  u16* MIX = (u16*)(p.ws + WS_MIX);
#pragma unroll
  for (int dt = 0; dt < 2; ++dt)
#pragma unroll
    for (int i = 0; i < 16; ++i) {
      const size_t row = (size_t)(Rbase + q0 + crow(i, h));
      const int d = head * 64 + dt * 32 + r;
      const float gate = bf2f(PROJ[row * DIN + C_BG + d]);
      MIX[row * DM + 512 + d] = f2bf(O[dt][i] * gate);
    }
}

__device__ __forceinline__ void pool_tile(const Params& p, int l, int R0, unsigned char* lds, int tid) {
  const int w = __builtin_amdgcn_readfirstlane(tid >> 6), lane = tid & 63, r = lane & 31, h = lane >> 5;
  float* E = (float*)lds;
  const int g = w >> 1, mt = w & 1;
  float psc[2];
#pragma unroll
  for (int nt = 0; nt < 2; ++nt) psc[nt] = p.pool_scale[l * 256 + g * 64 + nt * 32 + r];
  u16 pg[2][16];
#pragma unroll
  for (int nt = 0; nt < 2; ++nt)
#pragma unroll
    for (int i = 0; i < 16; ++i) pg[nt][i] = ((const u16*)(p.ws + WS_PROJ))[(size_t)(R0 + mt * 32 + crow(i, h)) * DIN + C_CG + g * 64 + nt * 32 + r];
  u16* D = (u16*)(lds + 79 * 1024);
  const u16* PROJ = (const u16*)(p.ws + WS_PROJ);
  const int grp = R0 >= NPROMPT;
  const int b = grp ? (R0 - NPROMPT) >> 6 : R0 >> 13;
  const int t0 = grp ? 0 : (R0 & (SEQ - 1));
  const int past = grp ? PAST : 0;
  {
    const int c4 = (tid & 63) * 4, rg = tid >> 6;
    uint2 raw[10];
#pragma unroll
    for (int q = 0; q < 10; ++q) {
      const int j = rg + 8 * q, t = t0 - 15 + j;
      raw[q] = make_uint2(0u, 0u);
      if (j < 79 && t >= 0) raw[q] = *(const uint2*)(PROJ + (size_t)(R0 - t0 + t) * DIN + C_CU + c4);
    }
    SBAR();
#pragma unroll
    for (int q = 0; q < 10; ++q) {
      const int j = rg + 8 * q, t = t0 - 15 + j;
      if (j < 79) {
        float4 v;
        if (t >= 0) { v.x = bf2f((u16)(raw[q].x & 0xffff)); v.y = bf2f((u16)(raw[q].x >> 16)); v.z = bf2f((u16)(raw[q].y & 0xffff)); v.w = bf2f((u16)(raw[q].y >> 16)); }
        else if (grp) v = *(const float4*)(p.state_pool + ((size_t)(l * DEC_B + b) * 15 + (15 + t)) * 256 + c4);
        else v = make_float4(0.f, 0.f, 0.f, 0.f);
        *(float4*)(E + j * 256 + c4) = v;
      }
    }
  }
  __syncthreads();
  for (int e = tid; e < 64 * 256; e += NTHREADS) {
    const int t = e >> 8, c = e & 255;
    const int wdw = 2 << (c >> 6);
    float s = 0.f;
    for (int j = 0; j < wdw; ++j) s += E[(15 + t - j) * 256 + c];
    const int pos = past + t0 + t;
    const float cnt = (float)min(pos + 1, wdw);
    D[t * 264 + c] = f2bf(s / cnt - E[(15 + t) * 256 + c]);
  }
  __syncthreads();
  const u16* WP = (const u16*)(p.ws + WS_WPT) + (size_t)(l * 4 + g) * 4096;
  f32x16 acc[2]; acc[0] = zero16(); acc[1] = zero16();
#pragma unroll
  for (int s = 0; s < 4; ++s) {
    const bf16x8 a = *(const bf16x8*)(D + (mt * 32 + r) * 264 + g * 64 + 16 * s + 8 * h);
#pragma unroll
    for (int nt = 0; nt < 2; ++nt) {
      const bf16x8 bb = *(const bf16x8*)(WP + (nt * 32 + r) * 64 + 16 * s + 8 * h);
      acc[nt] = MFMA32(a, bb, acc[nt]);
    }
  }
  u16* MIX = (u16*)(p.ws + WS_MIX);
#pragma unroll
  for (int nt = 0; nt < 2; ++nt) {
    const int d = g * 64 + nt * 32 + r;
    const float sc = psc[nt];
#pragma unroll
    for (int i = 0; i < 16; ++i) {
      const size_t row = (size_t)(R0 + mt * 32 + crow(i, h));
      MIX[row * DM + 768 + d] = f2bf(acc[nt][i] * sc * bf2f(pg[nt][i]));
    }
  }
  __syncthreads();
}

__device__ __forceinline__ void phase_mix1(const Params& p, int l, int grp, int* ctr, unsigned char* lds, int tid_) {
  const int nmk = (grp == 0 && l == 0) ? 16 : 0;
  const int nsb = grp ? 32 : 256, npl = grp ? 32 : 256, npa = grp ? 128 : 1024;
  const int ntask = nmk + nsb + npl + npa;
  for (;;) {
    const int task = next_task(ctr, lds, tid_);
    if (task >= ntask) break;
    const int tid = (int)opaque((unsigned)tid_);
    const int w = __builtin_amdgcn_readfirstlane(tid >> 6), lane = tid & 63;
    if (task < nmk) memkv_task(p, task, lds, tid);
    else if (task < nmk + nsb) {
      const int t = task - nmk;
      if (!grp) { const int b = t >> 7, rem = t & 127; sb_wave(p, l, 0, b, rem >> 5, (rem & 31) * 256 + w * 32, lane); }
      else { sb_wave(p, l, 1, t, w >> 1, (w & 1) * 32, lane); }
    } else if (task < nmk + nsb + npl) pool_tile(p, l, ((grp ? 256 : 0) + task - nmk - nsb) * 64, lds, tid);
    else hgrn_passA(p, (grp ? 1024 : 0) + task - nmk - nsb - npl, lds, tid);
  }
}

template <int MT>
__device__ __forceinline__ void chain_tile(const Params& p, int l, int R0, unsigned char* lds, int tid_) {
  const int tid = (int)opaque((unsigned)tid_);
  const int w = __builtin_amdgcn_readfirstlane(tid >> 6), lane = tid & 63, r = lane & 31, h = lane >> 5;
  unsigned char* panel = lds;
  float* red = (float*)(lds + LDS_RED); float* tot = (float*)(lds + LDS_TOT);
  float* rmax = (float*)(lds + LDS_RMAX); float* rsum = (float*)(lds + LDS_RSUM); float* linv = (float*)(lds + LDS_LINV);
  const int grp = R0 >= NPROMPT;
  const int b = grp ? (R0 - NPROMPT) >> 6 : R0 >> 13;
  const u16* WSQ = (const u16*)(p.ws + WS_WSQ) + (size_t)l * 5 * DM * DM;
  float* Y = p.out + O_Y;
  const float* xsrc = (l == 0) ? (grp ? p.x_sample - (size_t)NPROMPT * DM : p.x_prompt) : (const float*)Y;
  const unsigned yo_ = ((unsigned)(R0 + 4 * h) * (unsigned)DM + (unsigned)(w * 128 + r)) * 4u;
  {
    const u16* MIX = (const u16*)(p.ws + WS_MIX) + (size_t)R0 * DM;
#pragma unroll 1
    for (int jb = 0; jb < 8 * MT; jb += 8) {
      const unsigned e0 = (unsigned)(tid + jb * NTHREADS);
#define MIXOFF(j) (unsigned)((((e0 + (j) * NTHREADS) >> 7) * DM + ((e0 + (j) * NTHREADS) & 127) * 8) * 2)
#define PANOFF(j) (((e0 + (j) * NTHREADS) >> 7) * PITCH + ((e0 + (j) * NTHREADS) & 127) * 16)
      const uint4 t0 = *(const uint4*)((const char*)MIX + MIXOFF(0)), t1 = *(const uint4*)((const char*)MIX + MIXOFF(1)), t2 = *(const uint4*)((const char*)MIX + MIXOFF(2)), t3 = *(const uint4*)((const char*)MIX + MIXOFF(3));
      const uint4 t4 = *(const uint4*)((const char*)MIX + MIXOFF(4)), t5 = *(const uint4*)((const char*)MIX + MIXOFF(5)), t6 = *(const uint4*)((const char*)MIX + MIXOFF(6)), t7 = *(const uint4*)((const char*)MIX + MIXOFF(7));
      SBAR();
      *(uint4*)(panel + PANOFF(0)) = t0; *(uint4*)(panel + PANOFF(1)) = t1; *(uint4*)(panel + PANOFF(2)) = t2; *(uint4*)(panel + PANOFF(3)) = t3;
      *(uint4*)(panel + PANOFF(4)) = t4; *(uint4*)(panel + PANOFF(5)) = t5; *(uint4*)(panel + PANOFF(6)) = t6; *(uint4*)(panel + PANOFF(7)) = t7;
    }
  }
  __syncthreads();
  f32x16 acc[MT][4];
#define ZACC() { _Pragma("unroll") for (int a_ = 0; a_ < MT; ++a_) _Pragma("unroll") for (int c_ = 0; c_ < 4; ++c_) acc[a_][c_] = zero16(); }
  ZACC();
  gemm_panel<4, MT>(panel, WSQ + (size_t)0 * DM * DM, w * 128, acc, lane);
  row_rstd<MT>(acc, red, tot, w, lane, tid);
  {
    const float* npost = p.norm_mix_post + l * DM;
    const unsigned yo = opaque(yo_);
#pragma unroll
    for (int nt = 0; nt < 4; ++nt) {
      const int col = w * 128 + nt * 32 + r; const float gn = npost[col];
      float xv[MT][16];
#pragma unroll
      for (int mt = 0; mt < MT; ++mt)
#pragma unroll
        for (int i = 0; i < 16; ++i) xv[mt][i] = ld_f32(xsrc, yo + (unsigned)((mt * 32 + (i & 3) + 8 * (i >> 2)) * DM + nt * 32) * 4u);
      SBAR();
#pragma unroll
      for (int mt = 0; mt < MT; ++mt)
#pragma unroll
        for (int i = 0; i < 16; ++i) {
          const unsigned bo = yo + (unsigned)((mt * 32 + (i & 3) + 8 * (i >> 2)) * DM + nt * 32) * 4u;
          const float x1 = xv[mt][i] + acc[mt][nt][i] * tot[4 * h + mt * 32 + (i & 3) + 8 * (i >> 2)] * gn;
          acc[mt][nt][i] = x1; st_f32(Y, bo, x1);
        }
      SBAR();
    }
  }
  row_rstd<MT>(acc, red, tot, w, lane, tid);
  {
    const float* g2 = p.norm_x_pre + l * DM;
    const unsigned pwo = opaque((unsigned)(4 * h * PITCH + (w * 128 + r) * 2));
#pragma unroll
    for (int nt = 0; nt < 4; ++nt) {
      const int col = w * 128 + nt * 32 + r; const float gn = g2[col];
#pragma unroll
      for (int mt = 0; mt < MT; ++mt)
#pragma unroll
        for (int i = 0; i < 16; ++i)
          *(u16*)(panel + pwo + (mt * 32 + (i & 3) + 8 * (i >> 2)) * PITCH + nt * 64) = f2bf(acc[mt][nt][i] * tot[4 * h + mt * 32 + (i & 3) + 8 * (i >> 2)] * gn);
    }
  }
  __syncthreads();
  ZACC();
  gemm_panel<4, MT>(panel, WSQ + (size_t)1 * DM * DM, w * 128, acc, lane);
  __syncthreads();
  { const unsigned pwo = opaque((unsigned)(4 * h * PITCH + (w * 128 + r) * 2));
#pragma unroll
  for (int nt = 0; nt < 4; ++nt) {
    const int col = w * 128 + nt * 32 + r; (void)col;
#pragma unroll
    for (int mt = 0; mt < MT; ++mt)
#pragma unroll
      for (int i = 0; i < 16; ++i)
        *(u16*)(panel + pwo + (mt * 32 + (i & 3) + 8 * (i >> 2)) * PITCH + nt * 64) = f2bf(acc[mt][nt][i] * 0.0625f);
  } }
  __syncthreads();
  {
#pragma unroll 1
    for (int hh = 0; hh < 4; ++hh) {
      f32x16 st[MT]; st[0] = zero16(); st[MT - 1] = zero16();
      bf16x8 kfr[16], vfr[16];
      {
        const u16* kfp = (MT == 2 ? (const u16*)(p.ws + WS_KF) + (size_t)((((l * 2 + b) * 4 + hh) * 8 + w) * 16) * 512
                                  : (const u16*)(p.ws + WS_KFS) + (size_t)(((b * 4 + hh) * 8 + w) * 16) * 512) + lane * 8;
        const u16* vfp = (MT == 2 ? (const u16*)(p.ws + WS_VF) + (size_t)((((l * 2 + b) * 4 + hh) * 8 + w) * 16) * 512
                                  : (const u16*)(p.ws + WS_VFS) + (size_t)(((b * 4 + hh) * 8 + w) * 16) * 512) + lane * 8;
#pragma unroll
        for (int ks = 0; ks < 16; ++ks) kfr[ks] = *(const bf16x8*)(kfp + ks * 512);
#pragma unroll
        for (int ks = 0; ks < 16; ++ks) vfr[ks] = *(const bf16x8*)(vfp + ks * 512);
        SBAR();
      }
#pragma unroll
      for (int ks = 0; ks < 16; ++ks) {
#pragma unroll
        for (int nt = 0; nt < MT; ++nt) {
          const bf16x8 bq = *(const bf16x8*)(panel + (nt * 32 + r) * PITCH + (hh * 256 + 16 * ks + 8 * h) * 2);
          st[nt] = MFMA32(kfr[ks], bq, st[nt]);
        }
      }
#pragma unroll
      for (int nt = 0; nt < MT; ++nt) {
        float m = st[nt][0];
#pragma unroll
        for (int i = 1; i < 16; ++i) m = fmaxf(m, st[nt][i]);
        m = fmaxf(m, __shfl_xor(m, 32));
        if (h == 0) rmax[w * 64 + nt * 32 + r] = m;
      }
      __syncthreads();
#pragma unroll
      for (int nt = 0; nt < MT; ++nt) {
        float gm = rmax[nt * 32 + r];
#pragma unroll
        for (int ww = 1; ww < 8; ++ww) gm = fmaxf(gm, rmax[ww * 64 + nt * 32 + r]);
        float sum = 0.f;
#pragma unroll
        for (int i = 0; i < 16; ++i) { const float pv = __expf(st[nt][i] - gm); st[nt][i] = pv; sum += pv; }
        sum += __shfl_xor(sum, 32);
        if (h == 0) rsum[w * 64 + nt * 32 + r] = sum;
#pragma unroll
        for (int g = 0; g < 4; ++g) {
          uint2 o; o.x = pack2(st[nt][4 * g], st[nt][4 * g + 1]); o.y = pack2(st[nt][4 * g + 2], st[nt][4 * g + 3]);
          *(uint2*)(panel + (nt * 32 + r) * PITCH + (hh * 256 + w * 32 + 8 * g + 4 * h) * 2) = o;
        }
      }
      __syncthreads();
      if (tid < 64) { float s = 0.f; for (int ww = 0; ww < 8; ++ww) s += rsum[ww * 64 + tid]; linv[tid] = 1.f / s; }
      f32x16 o2[MT]; o2[0] = zero16(); o2[MT - 1] = zero16();
#pragma unroll
      for (int s = 0; s < 16; ++s) {
#pragma unroll
        for (int mt = 0; mt < MT; ++mt) {
          const bf16x8 a = *(const bf16x8*)(panel + (mt * 32 + r) * PITCH + (hh * 256 + 16 * s + 8 * h) * 2);
          o2[mt] = MFMA32(a, vfr[s], o2[mt]);
        }
      }
      __syncthreads();
#pragma unroll
      for (int mt = 0; mt < MT; ++mt)
#pragma unroll
        for (int i = 0; i < 16; ++i) {
          const int q = mt * 32 + crow(i, h);
          *(u16*)(panel + q * PITCH + (hh * 256 + w * 32 + r) * 2) = f2bf(o2[mt][i] * linv[q]);
        }
    }
  }
  __syncthreads();
  ZACC();
  gemm_panel<4, MT>(panel, WSQ + (size_t)4 * DM * DM, w * 128, acc, lane);
  row_rstd<MT>(acc, red, tot, w, lane, tid);
  {
    const float* g3 = p.norm_x_post + l * DM;
    const unsigned yo = opaque(yo_);
#pragma unroll
    for (int nt = 0; nt < 4; ++nt) {
      const int col = w * 128 + nt * 32 + r; const float gn = g3[col];
      float xv[MT][16];
#pragma unroll
      for (int mt = 0; mt < MT; ++mt)
#pragma unroll
        for (int i = 0; i < 16; ++i) xv[mt][i] = ld_f32(Y, yo + (unsigned)((mt * 32 + (i & 3) + 8 * (i >> 2)) * DM + nt * 32) * 4u);
      SBAR();
#pragma unroll
      for (int mt = 0; mt < MT; ++mt)
#pragma unroll
        for (int i = 0; i < 16; ++i) {
          const unsigned bo = yo + (unsigned)((mt * 32 + (i & 3) + 8 * (i >> 2)) * DM + nt * 32) * 4u;
          const float x2 = xv[mt][i] + acc[mt][nt][i] * tot[4 * h + mt * 32 + (i & 3) + 8 * (i >> 2)] * gn;
          acc[mt][nt][i] = x2; st_f32(Y, bo, x2);
        }
      SBAR();
    }
  }
  if (l + 1 < DEPTH) {
    row_rstd<MT>(acc, red, tot, w, lane, tid);
    const float* g4 = p.norm_mix_pre + (l + 1) * DM;
    const unsigned pwo = opaque((unsigned)(4 * h * PITCH + (w * 128 + r) * 2));
#pragma unroll
    for (int nt = 0; nt < 4; ++nt) {
      const int col = w * 128 + nt * 32 + r; const float gn = g4[col];
#pragma unroll
      for (int mt = 0; mt < MT; ++mt)
#pragma unroll
        for (int i = 0; i < 16; ++i)
          *(u16*)(panel + pwo + (mt * 32 + (i & 3) + 8 * (i >> 2)) * PITCH + nt * 64) = f2bf(acc[mt][nt][i] * tot[4 * h + mt * 32 + (i & 3) + 8 * (i >> 2)] * gn);
    }
    __syncthreads();
    {
      u16* H = (u16*)(p.ws + WS_H) + (size_t)R0 * DM;
#pragma unroll 1
      for (int jb = 0; jb < 8 * MT; jb += 8) {
        const unsigned e0 = (unsigned)(tid + jb * NTHREADS);
        const uint4 t0 = *(const uint4*)(panel + PANOFF(0)), t1 = *(const uint4*)(panel + PANOFF(1)), t2 = *(const uint4*)(panel + PANOFF(2)), t3 = *(const uint4*)(panel + PANOFF(3));
        const uint4 t4 = *(const uint4*)(panel + PANOFF(4)), t5 = *(const uint4*)(panel + PANOFF(5)), t6 = *(const uint4*)(panel + PANOFF(6)), t7 = *(const uint4*)(panel + PANOFF(7));
        *(uint4*)((char*)H + MIXOFF(0)) = t0; *(uint4*)((char*)H + MIXOFF(1)) = t1; *(uint4*)((char*)H + MIXOFF(2)) = t2; *(uint4*)((char*)H + MIXOFF(3)) = t3;
        *(uint4*)((char*)H + MIXOFF(4)) = t4; *(uint4*)((char*)H + MIXOFF(5)) = t5; *(uint4*)((char*)H + MIXOFF(6)) = t6; *(uint4*)((char*)H + MIXOFF(7)) = t7;
      }
    }
  }
  __syncthreads();
#undef ZACC
}

__global__ void __launch_bounds__(NTHREADS) hybrid_fwd(Params p) {
  extern __shared__ __attribute__((aligned(16))) unsigned char lds[];
  cg::grid_group grid = cg::this_grid();
  if (threadIdx.x < 4) ((unsigned*)(lds + LDS_XB))[threadIdx.x] = 0u;
  __syncthreads();
  const XcdBarrier xbar = xcd_barrier_post((unsigned*)(p.ws + WS_XB), (volatile LAS unsigned*)(lds + LDS_XB));
  const int wave_s = __builtin_amdgcn_readfirstlane((int)(threadIdx.x >> 6));
  unsigned tid_c = threadIdx.x;
  grid.sync();
  phase0(p, lds, (int)tid_c);
  xcd_barrier(xbar);
  for (int ph = 1; ph < p.ph_hi; ++ph) {
    {
      const int st_s = ph - 1, st_p = ph - 1 - SAMPLE_LEAD;
      const bool has_s = st_s >= 0 && st_s < 5 * DEPTH, has_p = st_p >= 0 && st_p < 5 * DEPTH;
      const int sub_s = st_s % 5;
      const bool s_first = has_s && (sub_s == 0 || sub_s == 4);
#pragma unroll 1
      for (int pass = 0; pass < 2; ++pass) {
        tid_c = (unsigned)(wave_s * 64) + __builtin_amdgcn_mbcnt_hi(~0u, __builtin_amdgcn_mbcnt_lo(~0u, 0u));
        asm volatile("" : "+v"(tid_c));
        const int tid = (int)tid_c;
        const int grp = (pass == 0) == s_first ? 1 : 0;
        if (grp ? !has_s : !has_p) continue;
        const int st = grp ? st_s : st_p, l = st / 5, sub = st % 5;
        int* ctr = (int*)(p.ws + WS_CTR) + ph * 2 + grp;
        if (sub == 0) {
          const int rbase = grp ? NPROMPT : 0, M = grp ? NROWS - NPROMPT : NPROMPT;
          pg8::Gemm g{(const pg8::bf16_t*)(p.ws + WS_H) + (size_t)rbase * DM, (const pg8::bf16_t*)(p.ws + WS_WIN) + (size_t)l * DIN * DM, M, DIN, DM};
          const bool share = (grp == 0) && has_s && sub_s == 4 && gridDim.x > 128;
          pg8::StaticOrder S;
          if (share) S.init(M, DIN, (int)gridDim.x - 64, (int)blockIdx.x >= 64 ? (int)blockIdx.x - 64 : (1 << 28));
          else S.init(M, DIN, (int)gridDim.x, (int)blockIdx.x);
          pg8::EpiWin E{(pg8::bf16_t*)(p.ws + WS_PROJ), (float*)(p.ws + WS_GF), p.out, (const float*)(p.ws + WS_LB) + l * 1024, l, rbase};
          pg8::gemm_phase<pg8::EpiWin, pg8::StaticOrder, false>((PG8_LAS unsigned char*)lds, g, S, E, nullptr, tid);
        }
        else if (sub == 1) phase_mix1(p, l, grp, ctr, lds, tid);
        else if (sub == 2) { const int u0 = grp ? 128 : 0, nu = grp ? 512 : 128; for (;;) { const int u = next_task(ctr, lds, tid); if (u >= nu) break; hgrn_scan_unit(p, l, u0 + u, lds, tid); } }
        else if (sub == 3) { const int t0 = grp ? 1024 : 0, nt = grp ? 128 : 1024; for (;;) { const int t = next_task(ctr, lds, tid); if (t >= nt) break; hgrn_passC(p, l, t0 + t, lds, tid); } }
        else if (!grp) { for (int t = blockIdx.x; t < 256; t += gridDim.x) chain_tile<2>(p, l, t * 64, lds, tid); }
        else { for (int t = blockIdx.x; t < 64; t += gridDim.x) chain_tile<1>(p, l, NPROMPT + t * 32, lds, tid); }
      }
    }
    if (ph == 1 || ph == 6) {
      int* ctr = (int*)(p.ws + WS_CTR) + 40 + (ph == 6);
      tid_c = (unsigned)(wave_s * 64) + __builtin_amdgcn_mbcnt_hi(~0u, __builtin_amdgcn_mbcnt_lo(~0u, 0u));
      asm volatile("" : "+v"(tid_c));
      const int tid = (int)tid_c;
      for (;;) { const int t = next_task(ctr, lds, tid); if (t >= 16 * DEC_B) break; kvconv_task(p, ph == 6, t, tid); }
    }
    if (ph + 1 < p.ph_hi) xcd_barrier(xbar);
  }
}

extern "C" void kernel_launch(void* const* d_in, const int* in_sizes, int n_in, void* d_out, int out_size, void* d_ws, size_t ws_size, hipStream_t stream) {
  static int grid_blocks = 0;
  if (!grid_blocks) {
    int dev = 0, cus = 0, per_cu = 0;
    hipGetDevice(&dev);
    hipDeviceGetAttribute(&cus, hipDeviceAttributeMultiprocessorCount, dev);
    hipFuncSetAttribute((const void*)hybrid_fwd, hipFuncAttributeMaxDynamicSharedMemorySize, LDS_BYTES);
    hipOccupancyMaxActiveBlocksPerMultiprocessor(&per_cu, (const void*)hybrid_fwd, NTHREADS, LDS_BYTES);
    if (per_cu < 1) { fprintf(stderr, "occupancy query returned %d\n", per_cu); per_cu = 1; }
    grid_blocks = cus * per_cu;
    if (ws_size < WS_END) fprintf(stderr, "workspace too small: %zu < %zu\n", ws_size, (size_t)WS_END);
  }
  Params p{};
  const float* const* in = (const float* const*)d_in;
  p.x_prompt = in[0]; p.x_sample = in[1]; p.mem_prompt = in[2]; p.cache_sb_k = in[3]; p.cache_sb_v = in[4];
  p.state_hgrn = in[5]; p.state_pool = in[6]; p.cache_mem_k = in[7]; p.cache_mem_v = in[8];
  p.norm_mix_pre = in[9]; p.norm_mix_post = in[10]; p.w_in = in[11]; p.lb_logits = in[12]; p.onorm_g = in[13];
  p.w_pool = in[14]; p.pool_scale = in[15]; p.w_out = in[16]; p.norm_x_pre = in[17]; p.norm_x_post = in[18];
  p.norm_mem = in[19]; p.w_xq = in[20]; p.w_xk = in[21]; p.w_xv = in[22]; p.w_xo = in[23];
  p.out = (float*)d_out; p.ws = (unsigned char*)d_ws;
  const int NPH = 1 + 5 * DEPTH + SAMPLE_LEAD;
  p.ph_lo = 0; p.ph_hi = NPH;
  (void)hipMemsetAsync((unsigned char*)d_ws + WS_XB, 0, XCD_BAR_WORDS * 4, stream);
  void* args[] = {&p};
  hipError_t e = hipLaunchCooperativeKernel((const void*)hybrid_fwd, dim3(grid_blocks), dim3(NTHREADS), args, LDS_BYTES, stream);
  if (e != hipSuccess) fprintf(stderr, "cooperative launch failed: %s (grid %d)\n", hipGetErrorString(e), grid_blocks);
}
```

```cpp
#include <hip/hip_runtime.h>
#include <hip/hip_cooperative_groups.h>
#include <cstdio>
namespace cg = cooperative_groups;

typedef unsigned short u16;
typedef __attribute__((ext_vector_type(8))) short bf16x8;
typedef __attribute__((ext_vector_type(16))) float f32x16;
#define DI __device__ __forceinline__
#define MFMA32(a, b, c) __builtin_amdgcn_mfma_f32_32x32x16_bf16((a), (b), (c), 0, 0, 0)
#define SBAR() __builtin_amdgcn_sched_barrier(0)

#ifndef GEMM_PD
#define GEMM_PD 3
#endif
#ifndef SAMPLE_LEAD
#define SAMPLE_LEAD 4
#endif

constexpr int DM = 1024, DIN = 3584, NROWS = 18432, NPROMPT = 16384;
constexpr int SEQ = 8192, DEC_B = 32, DEC_S = 64, PAST = 1024, DEPTH = 2;
constexpr int NTHREADS = 512;
constexpr int PITCH = 2064;
constexpr float EPS = 1e-6f;
constexpr int C_AQ = 0, C_AF = 512, C_AI = 1024, C_AG = 1536, C_BQ = 2048, C_BK = 2304, C_BV = 2560, C_BG = 2816, C_CU = 3072, C_CG = 3328;
constexpr size_t O_Y = 0;
constexpr size_t O_PSBK = (size_t)NROWS * DM;
constexpr size_t O_PSBV = O_PSBK + (size_t)DEPTH * 2 * SEQ * 256;
constexpr size_t O_PHS = O_PSBV + (size_t)DEPTH * 2 * SEQ * 256;
constexpr size_t O_PPOOL = O_PHS + (size_t)DEPTH * 2 * 4 * 16384;
constexpr size_t O_PMK = O_PPOOL + (size_t)DEPTH * 2 * 15 * 256;
constexpr size_t O_PMV = O_PMK + (size_t)DEPTH * 2 * 256 * 1024;
constexpr size_t O_SSBK = O_PMV + (size_t)DEPTH * 2 * 256 * 1024;
constexpr size_t O_SSBV = O_SSBK + (size_t)DEPTH * DEC_B * DEC_S * 256;
constexpr size_t O_SHS = O_SSBV + (size_t)DEPTH * DEC_B * DEC_S * 256;
constexpr size_t O_SPOOL = O_SHS + (size_t)DEPTH * DEC_B * 4 * 16384;
constexpr size_t WS_WIN = 0;
constexpr size_t WS_WSQ = WS_WIN + (size_t)DEPTH * DIN * DM * 2;
constexpr size_t WS_WPT = WS_WSQ + (size_t)DEPTH * 5 * DM * DM * 2;
constexpr size_t WS_LB = WS_WPT + (size_t)DEPTH * 4 * 64 * 64 * 2;
constexpr size_t WS_PROJ = WS_LB + (size_t)DEPTH * 2 * 512 * 4;
constexpr size_t WS_GF = WS_PROJ + (size_t)NROWS * DIN * 2;
constexpr size_t WS_MIX = WS_GF + (size_t)NROWS * 512 * 4;
constexpr size_t WS_DS = WS_MIX + (size_t)NROWS * DM * 2;
constexpr int NCHUNK = 1152;
constexpr size_t WS_DEC = WS_DS + (size_t)NCHUNK * 16384 * 4;
constexpr size_t WS_SPT = WS_DEC + (size_t)NCHUNK * 128 * 4;
constexpr size_t WS_H = WS_MIX;
constexpr size_t WS_CTR = WS_SPT + (size_t)NCHUNK * 16384 * 2;
constexpr size_t WS_XB = WS_CTR + 256;
constexpr size_t WS_KF = WS_XB + 16384;
constexpr size_t WS_VF = WS_KF + (size_t)DEPTH * 2 * 4 * 8 * 16 * 512 * 2;
constexpr size_t WS_KFS = WS_VF + (size_t)DEPTH * 2 * 4 * 8 * 16 * 512 * 2;
constexpr size_t WS_VFS = WS_KFS + (size_t)DEC_B * 4 * 8 * 16 * 512 * 2;
constexpr size_t WS_END = WS_VFS + (size_t)DEC_B * 4 * 8 * 16 * 512 * 2;
constexpr int LDS_PANEL = 64 * PITCH;
constexpr int LDS_RED = LDS_PANEL;
constexpr int LDS_TOT = LDS_RED + 2048;
constexpr int LDS_RMAX = LDS_TOT + 256;
constexpr int LDS_RSUM = LDS_RMAX + 2048;
constexpr int LDS_LINV = LDS_RSUM + 2048;
constexpr int LDS_TASK = LDS_LINV + 256;
constexpr int LDS_XB = LDS_TASK + 16;
constexpr int LDS_BYTES = LDS_XB + 16;

struct Params {
  const float* x_prompt; const float* x_sample; const float* mem_prompt;
  const float* cache_sb_k; const float* cache_sb_v; const float* state_hgrn; const float* state_pool;
  const float* cache_mem_k; const float* cache_mem_v;
  const float* norm_mix_pre; const float* norm_mix_post; const float* w_in; const float* lb_logits;
  const float* onorm_g; const float* w_pool; const float* pool_scale; const float* w_out;
  const float* norm_x_pre; const float* norm_x_post; const float* norm_mem;
  const float* w_xq; const float* w_xk; const float* w_xv; const float* w_xo;
  float* out; unsigned char* ws; int ph_lo, ph_hi;
};

namespace pg8 {
#define PG8_LAS __attribute__((address_space(3)))
typedef unsigned short bf16_t;
typedef short bf16x8 __attribute__((ext_vector_type(8)));
typedef float f32x4 __attribute__((ext_vector_type(4)));
typedef unsigned u32x4 __attribute__((ext_vector_type(4)));
constexpr int BM = 256, BK = 64, HALF = 128, HTB = HALF * BK * 2  , STAGE_BYTES = 8 * HTB, NXCD = 8, WGM = 8;

__host__ __device__ __forceinline__ int lds_byte(int r, int c) { const int st = (r >> 4) * 2 + (c >> 5), rr = r & 15, cc = c & 31, ob = rr * 64 + cc * 2; return st * 1024 + (ob ^ (((ob >> 9) & 1) << 5)); }
__host__ __device__ __forceinline__ void stage_rc(int b, int& R, int& C) { const int st = b / 1024, sb = b % 1024, swz = sb ^ (((sb >> 9) & 1) << 5); R = (st >> 1) * 16 + swz / 64; C = (st & 1) * 32 + (swz % 64) / 2; }
__host__ __device__ __forceinline__ int perm32(int rho) { const int n = rho >> 4, i = rho & 15; return 8 * (i >> 2) + 4 * n + (i & 3); }

struct Unit { int pm, pn; };
struct Gemm { const bf16_t* A; const bf16_t* Bt; int M, N, K; };

struct StaticOrder {
    int nM, nN, nwg, G, c;
    __host__ __device__ void init(int M, int N, int G_, int c_) { nM = M / BM; nN = N / BM; nwg = nM * nN; G = G_; c = c_; }
    __host__ __device__ bool next(int i, Unit& u) const {
        const long L = (long)i * G + c; if (L >= nwg) return false;
        int wgid = (int)L; { const int q = nwg / NXCD, r = nwg % NXCD, xcd = wgid % NXCD, off = wgid / NXCD; wgid = (xcd < r ? xcd * (q + 1) : r * (q + 1) + (xcd - r) * q) + off; }
        const int nig = WGM * nN, gid = wgid / nig, fm = gid * WGM, gsz = (nM - fm) < WGM ? (nM - fm) : WGM;
        u.pm = fm + ((wgid % nig) % gsz); u.pn = (wgid % nig) / gsz; return true;
    }
    __device__ __forceinline__ void a_ready(const Unit&) const {}
    __device__ __forceinline__ void done(const Unit&) const {}
};

__device__ __forceinline__ unsigned cvt_pk_bf16(float lo, float hi) { unsigned r; asm volatile("v_cvt_pk_bf16_f32 %0, %1, %2" : "=v"(r) : "v"(lo), "v"(hi)); return r; }
struct EpiWin {
    static constexpr bool PERM = true, AFTER_DRAIN = false;
    bf16_t* PROJ; float* GF; float* out; const float* LB; int l; int rbase;
    __device__ __forceinline__ void operator()(const f32x4 (&acc)[2][2][4][2], const Unit& u, int wr, int wc, int fr, int fq) const {
        const int region = u.pn;
        const int row0 = rbase + u.pm * BM + wr * 64 + fr, cl0 = wc * 32 + 8 * fq;
        const bool dosilu = region < 2 || region == 6 || region == 7 || region == 11 || region == 13;
        const float sc = region < 2 ? 0.08838834764831845f : (region == 8 ? 0.125f : 1.f);
#pragma unroll
        for (int bj = 0; bj < 2; ++bj) {
            const int cl = cl0 + bj * HALF;
            f32x4 la4[2], l1m4[2];
            if (region == 2 || region == 3) {
                const float* lp = LB + (region - 2) * 256 + cl;
                la4[0] = *(const f32x4*)lp; la4[1] = *(const f32x4*)(lp + 4); l1m4[0] = *(const f32x4*)(lp + 512); l1m4[1] = *(const f32x4*)(lp + 516);
            }
#pragma unroll
            for (int ai = 0; ai < 2; ++ai)
#pragma unroll
                for (int m = 0; m < 4; ++m) {
                    const int row = row0 + ai * HALF + m * 16;
                    float v[8];
#pragma unroll
                    for (int j = 0; j < 4; ++j) { v[j] = acc[ai][bj][m][0][j]; v[4 + j] = acc[ai][bj][m][1][j]; }
                    if (region == 2 || region == 3) {
                        float o[8];
#pragma unroll
                        for (int j = 0; j < 8; ++j) {
                            const float ls = fminf(v[j], 0.f) - __logf(1.f + __expf(-fabsf(v[j])));
                            const float la = la4[j >> 2][j & 3];
                            const float bb = l1m4[j >> 2][j & 3] + ls; const float mx = fmaxf(la, bb);
                            o[j] = mx + __logf(1.f + __expf(-fabsf(la - bb)));
                        }
                        float* gp = GF + (size_t)row * 512 + (region - 2) * 256 + cl;
                        *(f32x4*)gp = (f32x4){o[0], o[1], o[2], o[3]}; *(f32x4*)(gp + 4) = (f32x4){o[4], o[5], o[6], o[7]};
                    } else {
                        float t[8];
#pragma unroll
                        for (int j = 0; j < 8; ++j) t[j] = (dosilu ? v[j] * __builtin_amdgcn_rcpf(1.f + __expf(-v[j])) : v[j]) * sc;
                        u32x4 w; w.x = cvt_pk_bf16(t[0], t[1]); w.y = cvt_pk_bf16(t[2], t[3]); w.z = cvt_pk_bf16(t[4], t[5]); w.w = cvt_pk_bf16(t[6], t[7]);
                        *(u32x4*)(PROJ + (size_t)row * 3584 + region * 256 + cl) = w;
                        if (region == 9 || region == 10 || region == 12) {
                            const bool smp = row >= 16384;
                            const int b = smp ? (row - 16384) >> 6 : row >> 13, tt = smp ? (row - 16384) & 63 : row & 8191;
                            if (region != 12) {
                                const unsigned o = smp ? (unsigned)(region == 9 ? O_SSBK : O_SSBV) + (unsigned)((l * 32 + b) * 64 + tt) * 256u : (unsigned)(region == 9 ? O_PSBK : O_PSBV) + (unsigned)((l * 2 + b) * 8192 + tt) * 256u;
                                float* op = out + (o + (unsigned)cl);
                                *(f32x4*)op = (f32x4){v[0], v[1], v[2], v[3]}; *(f32x4*)(op + 4) = (f32x4){v[4], v[5], v[6], v[7]};
                            } else {
                                const int L = smp ? 64 : 8192;
                                if (tt >= L - 15) {
                                    const unsigned o = (smp ? (unsigned)O_SPOOL + (unsigned)(l * 32 + b) * 3840u : (unsigned)O_PPOOL + (unsigned)(l * 2 + b) * 3840u) + (unsigned)(tt - (L - 15)) * 256u;
                                    float* op = out + (o + (unsigned)cl);
                                    *(f32x4*)op = (f32x4){v[0], v[1], v[2], v[3]}; *(f32x4*)(op + 4) = (f32x4){v[4], v[5], v[6], v[7]};
                                }
                            }
                        }
                    }
                }
        }
    }
};

template <class Epi, class Sched, bool STAMP = false>
__device__ __forceinline__ void gemm_phase(PG8_LAS unsigned char* lds, const Gemm g, const Sched& S, const Epi& E, unsigned long long* stamps, int tid_in) {
    const int tid = tid_in, wid = __builtin_amdgcn_readfirstlane(tid >> 6), lane = tid & 63, wr = wid >> 2, wc = wid & 3, fr = lane & 15, fq = lane >> 4;
    const int K = g.K, nt = K / BK;
    int ts_lo = 0, ts_hi = 0, nts = 0; const unsigned long long rt_entry = STAMP ? (unsigned long long)wall_clock64() : 0ull;
#define PG8_STAMP() do { if (STAMP && wid == 0 && nts < 64) { const unsigned long long _c = (unsigned long long)clock64(); \
        ts_lo = (lane == nts) ? (int)(unsigned)_c : ts_lo; ts_hi = (lane == nts) ? (int)(unsigned)(_c >> 32) : ts_hi; ++nts; } } while (0)
    PG8_STAMP();
    unsigned voffA[2], voffB[2];
#pragma unroll
    for (int i = 0; i < 2; ++i) { int R, C; stage_rc(tid * 16 + i * 8192, R, C); const int Rb = Epi::PERM ? ((R & ~31) + perm32(R & 31)) : R;
        voffA[i] = (unsigned)(R * K + C) * 2u; voffB[i] = (unsigned)(Rb * K + C) * 2u; }
    const size_t kstep = (size_t)(BK * 2);
    const size_t hstep = (size_t)HALF * K * 2;
    const size_t tstep = 2 * hstep;
    const unsigned ldsw = (unsigned)wid * 1024u;
    const int aoff = lds_byte(wr * 64 + fr, fq * 8), boff = lds_byte(wc * 32 + fr, fq * 8);
#define PG8_SA(b, h) (((b) * 2 + (h)) * HTB)
#define PG8_SB(b, h) ((4 + (b) * 2 + (h)) * HTB)
#define PG8_STAGE(bufoff, gbase, voff) do { _Pragma("unroll") for (int _i = 0; _i < 2; ++_i) \
        __builtin_amdgcn_global_load_lds((const unsigned*)((const char*)(gbase) + (voff)[_i]), (PG8_LAS unsigned*)(lds + (bufoff) + ldsw + _i * 8192), 16, 0, 0); } while (0)
#define PG8_LDA(dst, b, h) do { _Pragma("unroll") for (int m = 0; m < 4; ++m) _Pragma("unroll") for (int k = 0; k < 2; ++k) dst[m][k] = *(const PG8_LAS bf16x8*)(lds + PG8_SA(b, h) + aoff + m * 2048 + k * 1024); } while (0)
#define PG8_LDB(dst, b, h) do { _Pragma("unroll") for (int n = 0; n < 2; ++n) _Pragma("unroll") for (int k = 0; k < 2; ++k) dst[n][k] = *(const PG8_LAS bf16x8*)(lds + PG8_SB(b, h) + boff + n * 2048 + k * 1024); } while (0)
#define PG8_MMA(ai, bj, At, Bt) do { __builtin_amdgcn_s_setprio(1); _Pragma("unroll") for (int m = 0; m < 4; ++m) _Pragma("unroll") for (int n = 0; n < 2; ++n) _Pragma("unroll") for (int k = 0; k < 2; ++k) \
        acc[ai][bj][m][n] = __builtin_amdgcn_mfma_f32_16x16x32_bf16(Bt[n][k], At[m][k], acc[ai][bj][m][n], 0, 0, 0); __builtin_amdgcn_s_setprio(0); } while (0)
#define PG8_WAIT_V(n) asm volatile("s_waitcnt vmcnt(" #n ")" ::: "memory")
#define PG8_WAIT_L(n) asm volatile("s_waitcnt lgkmcnt(" #n ")" ::: "memory")
#define PG8_BAR __builtin_amdgcn_s_barrier()
#define PG8_SCHED __builtin_amdgcn_sched_barrier(0)
    Unit cur, nxt; int ui = 0;
    if (!S.next(0, cur)) return;
    f32x4 acc[2][2][4][2];
#pragma unroll
    for (int a = 0; a < 2; ++a)
#pragma unroll
        for (int b = 0; b < 2; ++b)
#pragma unroll
            for (int m = 0; m < 4; ++m)
#pragma unroll
                for (int n = 0; n < 2; ++n) acc[a][b][m][n] = (f32x4){0.f, 0.f, 0.f, 0.f};
    bf16x8 At[4][2], B0[2][2], B1[2][2];
    const char* cA = (const char*)g.A + (size_t)cur.pm * tstep; const char* cB = (const char*)g.Bt + (size_t)cur.pn * tstep;
    S.a_ready(cur);
    PG8_STAGE(PG8_SB(0, 0), cB, voffB); PG8_STAGE(PG8_SA(0, 0), cA, voffA); PG8_STAGE(PG8_SB(0, 1), cB + hstep, voffB); PG8_STAGE(PG8_SA(0, 1), cA + hstep, voffA);
    if (wr == 1) PG8_BAR;
    PG8_WAIT_V(4); PG8_BAR;
    PG8_STAGE(PG8_SB(1, 0), cB + kstep, voffB); PG8_STAGE(PG8_SA(1, 0), cA + kstep, voffA); PG8_STAGE(PG8_SB(1, 1), cB + hstep + kstep, voffB);
    PG8_WAIT_V(6); PG8_BAR;
    PG8_STAMP();
    for (;;) {
        const bool has_next = S.next(ui + 1, nxt);
        const char* nA = has_next ? (const char*)g.A + (size_t)nxt.pm * tstep : cA; const char* nB = has_next ? (const char*)g.Bt + (size_t)nxt.pn * tstep : cB;
        for (int t = 0; t < nt; t += 2) {
            const bool last = (t == nt - 2);
            const char* a1 = cA + (size_t)(t + 1) * kstep;
            const char* a2 = last ? nA : cA + (size_t)(t + 2) * kstep; const char* b2 = last ? nB : cB + (size_t)(t + 2) * kstep;
            const char* a3 = a2 + kstep; const char* b3 = b2 + kstep;
            if (last && has_next) S.a_ready(nxt);
            PG8_LDB(B0, 0, 0); PG8_SCHED; PG8_LDA(At, 0, 0); PG8_STAGE(PG8_SA(1, 1), a1 + hstep, voffA);
            PG8_WAIT_L(8); PG8_BAR; PG8_WAIT_L(0); PG8_MMA(0, 0, At, B0); PG8_BAR; PG8_SCHED;
            PG8_LDB(B1, 0, 1); PG8_STAGE(PG8_SB(0, 0), b2, voffB);
            PG8_BAR; PG8_WAIT_L(0); PG8_MMA(0, 1, At, B1); PG8_BAR;
            PG8_LDA(At, 0, 1); PG8_STAGE(PG8_SA(0, 0), a2, voffA);
            PG8_BAR; PG8_WAIT_L(0); PG8_MMA(1, 0, At, B0); PG8_BAR; PG8_SCHED;
            PG8_STAGE(PG8_SB(0, 1), b2 + hstep, voffB);
            PG8_WAIT_V(6); PG8_BAR; PG8_MMA(1, 1, At, B1); PG8_BAR;
            PG8_LDB(B0, 1, 0); PG8_SCHED; PG8_LDA(At, 1, 0); PG8_STAGE(PG8_SA(0, 1), a2 + hstep, voffA);
            PG8_WAIT_L(8); PG8_BAR; PG8_WAIT_L(0); PG8_MMA(0, 0, At, B0); PG8_BAR; PG8_SCHED;
            PG8_LDB(B1, 1, 1); PG8_STAGE(PG8_SB(1, 0), b3, voffB);
            PG8_BAR; PG8_WAIT_L(0); PG8_MMA(0, 1, At, B1); PG8_BAR;
            PG8_LDA(At, 1, 1); PG8_STAGE(PG8_SA(1, 0), a3, voffA);
            PG8_BAR; PG8_WAIT_L(0); PG8_MMA(1, 0, At, B0); PG8_BAR; PG8_SCHED;
            PG8_STAGE(PG8_SB(1, 1), b3 + hstep, voffB);
            PG8_WAIT_V(6); PG8_BAR; PG8_MMA(1, 1, At, B1); PG8_BAR;
        }
        PG8_STAMP();
        if constexpr (!Epi::AFTER_DRAIN) { E(acc, cur, wr, wc, fr, fq); S.done(cur); }
        PG8_STAMP();
        if (!has_next) break;
#pragma unroll
        for (int a = 0; a < 2; ++a)
#pragma unroll
            for (int b = 0; b < 2; ++b)
#pragma unroll
                for (int m = 0; m < 4; ++m)
#pragma unroll
                    for (int n = 0; n < 2; ++n) acc[a][b][m][n] = (f32x4){0.f, 0.f, 0.f, 0.f};
        cur = nxt; cA = nA; cB = nB; ++ui;
    }
    PG8_WAIT_V(0);
    if (wr == 0) PG8_BAR;
    PG8_BAR;
    if constexpr (Epi::AFTER_DRAIN) { E.fused(acc, cur, wr, wc, fr, fq, lds, wid, lane); S.done(cur); }
    PG8_STAMP();
    if (STAMP && wid == 0) { stamps[lane] = lane < nts ? (((unsigned long long)(unsigned)ts_hi << 32) | (unsigned)ts_lo) : 0ull;
        if (lane == 62) stamps[62] = rt_entry; if (lane == 63) stamps[63] = (unsigned long long)wall_clock64(); }
#undef PG8_STAMP
#undef PG8_SA
#undef PG8_SB
#undef PG8_STAGE
#undef PG8_LDA
#undef PG8_LDB
#undef PG8_MMA
#undef PG8_WAIT_V
#undef PG8_WAIT_L
#undef PG8_BAR
#undef PG8_SCHED
}
}

#define XB_TMO      128
#define XB_XCNT(j)  (256  + 64 * (j))
#define XB_XSUB(j)  (1280 + 64 * (j))
#define XB_XGEN(j)  (2304 + 64 * (j))
#define XB_TOP      3328
#define XB_TOPGEN   3392
#define XCD_BAR_WORDS 3456
#define XB_SPIN_CAP (1u << 18)
#define LAS __attribute__((address_space(3)))

__device__ __forceinline__ unsigned xb_ld(unsigned* p)              { return __hip_atomic_load(p, __ATOMIC_RELAXED, __HIP_MEMORY_SCOPE_AGENT); }
__device__ __forceinline__ unsigned xb_add(unsigned* p, unsigned v) { return __hip_atomic_fetch_add(p, v, __ATOMIC_RELAXED, __HIP_MEMORY_SCOPE_AGENT); }
__device__ __forceinline__ unsigned xb_xcc_id() { return (unsigned)__builtin_amdgcn_s_getreg((3 << 11) | 20) & 0xFu; }
#define XB_SPIN(cond, bar) do { unsigned _sp = 0; while (cond) { __builtin_amdgcn_s_sleep(1); \
    if ((++_sp & 255u) == 0u) { if (xb_ld(&(bar)[XB_TMO])) break; if (_sp > XB_SPIN_CAP) { atomicAdd(&(bar)[XB_TMO], 1u); break; } } } } while (0)

struct XcdBarrier {
    unsigned* bar; unsigned x;
    volatile LAS unsigned* st;
};

__device__ __forceinline__ XcdBarrier xcd_barrier_post(unsigned* bar, volatile LAS unsigned* st) {
    XcdBarrier b; b.bar = bar; b.x = xb_xcc_id(); b.st = st;
    if (threadIdx.x == 0) (void)xb_add(&bar[XB_XCNT(b.x)], 1u);
    return b;
}
__device__ __forceinline__ void xcd_barrier_complete(unsigned* bar, unsigned x, unsigned& nloc, unsigned& nx) {
    const unsigned G = gridDim.x * gridDim.y * gridDim.z;
    unsigned sum, cnt, mine, sp = 0u;
    for (;;) {
        sum = 0u; cnt = 0u; mine = 0u;
#pragma unroll
        for (unsigned j = 0; j < 16; ++j) { const unsigned c = xb_ld(&bar[XB_XCNT(j)]); sum += c; cnt += (c > 0u) ? 1u : 0u; mine = (j == x) ? c : mine; }
        if (sum == G) break;
        __builtin_amdgcn_s_sleep(1);
        if ((++sp & 255u) == 0u) { if (xb_ld(&bar[XB_TMO])) break; if (sp > XB_SPIN_CAP) { atomicAdd(&bar[XB_TMO], 1u); break; } }
    }
    nloc = mine > 0u ? mine : 1u; nx = cnt > 0u ? cnt : 1u;
}

__device__ __forceinline__ void xcd_barrier(const XcdBarrier& b) {
    asm volatile("s_waitcnt vmcnt(0)" ::: "memory");
    __syncthreads();
    if (threadIdx.x == 0) {
        unsigned* bar = b.bar;
        __builtin_amdgcn_s_waitcnt(0);
        unsigned nloc = b.st[0], nx = b.st[1];
        if (nloc == 0u) { xcd_barrier_complete(bar, b.x, nloc, nx); b.st[0] = nloc; b.st[1] = nx; }
        const unsigned old = xb_add(&bar[XB_XSUB(b.x)], 1u);
        const unsigned gen = old / nloc;
        if (old + 1u == (gen + 1u) * nloc) {
            __builtin_amdgcn_fence(__ATOMIC_RELEASE, "agent");
            asm volatile("s_waitcnt vmcnt(0)" ::: "memory");
            const unsigned og = xb_add(&bar[XB_TOP], 1u);
            const unsigned tg = og / nx;
            if (og + 1u == (tg + 1u) * nx) xb_add(&bar[XB_TOPGEN], 1u);
            else XB_SPIN(xb_ld(&bar[XB_TOPGEN]) == tg, bar);
            __builtin_amdgcn_fence(__ATOMIC_ACQUIRE, "agent");
            xb_add(&bar[XB_XGEN(b.x)], 1u);
            asm volatile("s_waitcnt vmcnt(0)" ::: "memory");
        } else {
            XB_SPIN(xb_ld(&bar[XB_XGEN(b.x)]) == gen, bar);
            __builtin_amdgcn_fence(__ATOMIC_ACQUIRE, "agent");
            asm volatile("s_waitcnt vmcnt(0)" ::: "memory");
        }
    }
    __syncthreads();
}


DI u16 f2bf(float x) { unsigned u = __float_as_uint(x); u += 0x7fffu + ((u >> 16) & 1u); return (u16)(u >> 16); }
DI float bf2f(u16 v) { return __uint_as_float(((unsigned)v) << 16); }
DI unsigned pack2(float a, float b) { return (unsigned)f2bf(a) | ((unsigned)f2bf(b) << 16); }
DI int crow(int i, int h) { return (i & 3) + 8 * (i >> 2) + 4 * h; }
DI float silu(float v) { return v / (1.f + __expf(-v)); }
DI float wave_sum(float v) { for (int o = 32; o >= 1; o >>= 1) v += __shfl_xor(v, o); return v; }
DI float half_sum(float v) { for (int o = 16; o >= 1; o >>= 1) v += __shfl_xor(v, o); return v; }
DI bf16x8 cvt8(float4 a, float4 b) {
  union { bf16x8 v; unsigned u[4]; } r;
  r.u[0] = pack2(a.x, a.y); r.u[1] = pack2(a.z, a.w); r.u[2] = pack2(b.x, b.y); r.u[3] = pack2(b.z, b.w);
  return r.v;
}
DI void st_u16(void* base, unsigned boff, u16 v) { *(u16*)((char*)base + boff) = v; }
DI void st_f32(void* base, unsigned boff, float v) { *(float*)((char*)base + boff) = v; }
DI float ld_f32(const void* base, unsigned boff) { return *(const float*)((const char*)base + boff); }
DI u16 ld_u16(const void* base, unsigned boff) { return *(const u16*)((const char*)base + boff); }
DI unsigned opaque(unsigned x) { asm volatile("" : "+v"(x)); return x; }
DI int next_task(int* ctr, unsigned char* lds, int tid) {
  int* slot = (int*)(lds + LDS_TASK);
  __syncthreads();
  if (tid == 0) *slot = atomicAdd(ctr, 1);
  __syncthreads();
  return *slot;
}
DI f32x16 zero16() { f32x16 z; for (int i = 0; i < 16; ++i) z[i] = 0.f; return z; }

template <int NT, int MT>
DI void gemm_panel(const unsigned char* panel, const u16* __restrict__ Wt, int ncol0, f32x16 (&acc)[MT][NT], int lane) {
  const int r = lane & 31, h = lane >> 5;
  const char* bu = (const char*)(Wt + (size_t)(ncol0 >> 5) * 64 * 512);
  const unsigned loff = (unsigned)lane * 16u;
  const unsigned char* ap = panel + r * PITCH + 16 * h;
  constexpr int PD = (NT == 4) ? GEMM_PD : 6;
  bf16x8 B[8][NT];
#define LOADB(t, dst) { _Pragma("unroll") for (int nt = 0; nt < NT; ++nt) dst[nt] = *(const bf16x8*)(bu + (size_t)((nt * 64 + (t)) * 1024) + loff); }
#pragma unroll
  for (int t = 0; t < PD; ++t) LOADB(t, B[t]);
#pragma unroll 1
  for (int kb = 0; kb < 8; ++kb) {
#pragma unroll
    for (int s = 0; s < 8; ++s) {
      const int t2 = (kb * 8 + s + PD) & 63;
      LOADB(t2, B[(s + PD) & 7]);
      SBAR();
      const bf16x8 a0 = *(const bf16x8*)(ap + kb * 256 + s * 32);
      bf16x8 a1 = a0; if (MT == 2) a1 = *(const bf16x8*)(ap + 32 * PITCH + kb * 256 + s * 32);
#pragma unroll
      for (int nt = 0; nt < NT; ++nt) { acc[0][nt] = MFMA32(a0, B[s][nt], acc[0][nt]); if (MT == 2) acc[MT - 1][nt] = MFMA32(a1, B[s][nt], acc[MT - 1][nt]); }
      SBAR();
    }
  }
#undef LOADB
}

DI float half_reduce_scatter16(const float (&v)[16], int r) {
  const bool b4 = (r & 16) != 0, b3 = (r & 8) != 0, b2 = (r & 4) != 0, b1 = (r & 2) != 0;
  float a8[8], a4[4], a2[2];
#pragma unroll
  for (int j = 0; j < 8; ++j) { const float mine = b4 ? v[j + 8] : v[j], th = b4 ? v[j] : v[j + 8]; a8[j] = mine + __shfl_xor(th, 16); }
#pragma unroll
  for (int j = 0; j < 4; ++j) { const float mine = b3 ? a8[j + 4] : a8[j], th = b3 ? a8[j] : a8[j + 4]; a4[j] = mine + __shfl_xor(th, 8); }
#pragma unroll
  for (int j = 0; j < 2; ++j) { const float mine = b2 ? a4[j + 2] : a4[j], th = b2 ? a4[j] : a4[j + 2]; a2[j] = mine + __shfl_xor(th, 4); }
  const float mine = b1 ? a2[1] : a2[0], th = b1 ? a2[0] : a2[1];
  float a1 = mine + __shfl_xor(th, 2);
  a1 += __shfl_xor(a1, 1);
  return a1;
}
template <int MT>
DI void row_rstd(const f32x16 (&acc)[MT][4], float* red, float* tot, int w, int lane, int tid) {
  const int r = lane & 31, h = lane >> 5;
#pragma unroll
  for (int mt = 0; mt < MT; ++mt) {
    float v[16];
#pragma unroll
    for (int i = 0; i < 16; ++i) {
      float t = 0.f;
#pragma unroll
      for (int nt = 0; nt < 4; ++nt) t += acc[mt][nt][i] * acc[mt][nt][i];
      v[i] = t;
    }
    const float tsum = half_reduce_scatter16(v, r);
    if ((r & 1) == 0) red[w * 64 + mt * 32 + crow(r >> 1, h)] = tsum;
  }
  __syncthreads();
  if (tid < 64) { float s = 0.f; for (int ww = 0; ww < 8; ++ww) s += red[ww * 64 + tid]; tot[tid] = rsqrtf(s * (1.f / 1024.f) + EPS); }
  __syncthreads();
}

DI void load_norm_panel(const float* __restrict__ src, const float* __restrict__ gain, unsigned char* panel, int w, int lane) {
  float4 g[4];
#pragma unroll
  for (int j = 0; j < 4; ++j) g[j] = ((const float4*)gain)[lane + 64 * j];
#pragma unroll 1
  for (int rb = 0; rb < 2; ++rb) {
    float4 v[4][4];
#pragma unroll
    for (int rr = 0; rr < 4; ++rr)
#pragma unroll
      for (int j = 0; j < 4; ++j) v[rr][j] = ((const float4*)(src + (size_t)(w * 8 + rb * 4 + rr) * 1024))[lane + 64 * j];
    SBAR();
#pragma unroll
    for (int rr = 0; rr < 4; ++rr) {
      const int row = w * 8 + rb * 4 + rr;
      float ss = 0.f;
#pragma unroll
      for (int j = 0; j < 4; ++j) ss += v[rr][j].x * v[rr][j].x + v[rr][j].y * v[rr][j].y + v[rr][j].z * v[rr][j].z + v[rr][j].w * v[rr][j].w;
      ss = wave_sum(ss);
      const float rstd = rsqrtf(ss * (1.f / 1024.f) + EPS);
#pragma unroll
      for (int j = 0; j < 4; ++j) {
        uint2 o; o.x = pack2(v[rr][j].x * rstd * g[j].x, v[rr][j].y * rstd * g[j].y); o.y = pack2(v[rr][j].z * rstd * g[j].z, v[rr][j].w * rstd * g[j].w);
        *(uint2*)(panel + row * PITCH + (lane + 64 * j) * 8) = o;
      }
    }
  }
}

DI void norm_rows_to_global(const float* __restrict__ src, const float* __restrict__ gain, u16* __restrict__ dst, int w, int lane) {
  float4 g[4];
#pragma unroll
  for (int j = 0; j < 4; ++j) g[j] = ((const float4*)gain)[lane + 64 * j];
#pragma unroll 1
  for (int rb = 0; rb < 2; ++rb) {
    float4 v[4][4];
#pragma unroll
    for (int rr = 0; rr < 4; ++rr)
#pragma unroll
      for (int j = 0; j < 4; ++j) v[rr][j] = ((const float4*)(src + (size_t)(w * 8 + rb * 4 + rr) * 1024))[lane + 64 * j];
    SBAR();
#pragma unroll
    for (int rr = 0; rr < 4; ++rr) {
      const int row = w * 8 + rb * 4 + rr;
      float ss = 0.f;
#pragma unroll
      for (int j = 0; j < 4; ++j) ss += v[rr][j].x * v[rr][j].x + v[rr][j].y * v[rr][j].y + v[rr][j].z * v[rr][j].z + v[rr][j].w * v[rr][j].w;
      ss = wave_sum(ss);
      const float rstd = rsqrtf(ss * (1.f / 1024.f) + EPS);
#pragma unroll
      for (int j = 0; j < 4; ++j) {
        uint2 o; o.x = pack2(v[rr][j].x * rstd * g[j].x, v[rr][j].y * rstd * g[j].y); o.y = pack2(v[rr][j].z * rstd * g[j].z, v[rr][j].w * rstd * g[j].w);
        *(uint2*)(dst + (size_t)row * 1024 + (lane + 64 * j) * 4) = o;
      }
    }
  }
}

template <bool FRAG>
DI void convert_tile(const float* __restrict__ src, u16* __restrict__ dst, int K, int N, int k0, int n0, unsigned char* lds, int tid) {
  u16* T = (u16*)lds;
  {
    const int kk = tid >> 3, n8 = (tid & 7) * 8;
    const float4* s = (const float4*)(src + (size_t)(k0 + kk) * N + n0 + n8);
    const float4 a = s[0], bq = s[1];
    T[(n8 + 0) * 72 + kk] = f2bf(a.x); T[(n8 + 1) * 72 + kk] = f2bf(a.y); T[(n8 + 2) * 72 + kk] = f2bf(a.z); T[(n8 + 3) * 72 + kk] = f2bf(a.w);
    T[(n8 + 4) * 72 + kk] = f2bf(bq.x); T[(n8 + 5) * 72 + kk] = f2bf(bq.y); T[(n8 + 6) * 72 + kk] = f2bf(bq.z); T[(n8 + 7) * 72 + kk] = f2bf(bq.w);
  }
  __syncthreads();
  {
    const int n = tid >> 3, k8 = (tid & 7) * 8;
    const uint4 v = *(const uint4*)(T + n * 72 + k8);
    if (FRAG) {
      const int ng = n0 + n, kg = k0 + k8;
      const size_t off = (((size_t)(ng >> 5) * (K >> 4) + (kg >> 4)) * 64 + ((kg >> 3) & 1) * 32 + (ng & 31)) * 8;
      *(uint4*)(dst + off) = v;
    } else *(uint4*)(dst + (size_t)(n0 + n) * K + k0 + k8) = v;
  }
  __syncthreads();
}

template <bool FRAG>
DI void convert_strip(const float* __restrict__ src, u16* __restrict__ dst, int K, int N, int k0, int n0, unsigned char* lds, int tid) {
  const int kk = tid >> 3, n8 = (tid & 7) * 8;
  float4 a[4], bq[4];
#pragma unroll
  for (int q = 0; q < 4; ++q) { const float4* sp = (const float4*)(src + (size_t)(k0 + kk) * N + n0 + q * 64 + n8); a[q] = sp[0]; bq[q] = sp[1]; }
  SBAR();
#pragma unroll
  for (int q = 0; q < 4; ++q) {
    u16* T = (u16*)(lds + q * 9216);
    T[(n8 + 0) * 72 + kk] = f2bf(a[q].x); T[(n8 + 1) * 72 + kk] = f2bf(a[q].y); T[(n8 + 2) * 72 + kk] = f2bf(a[q].z); T[(n8 + 3) * 72 + kk] = f2bf(a[q].w);
    T[(n8 + 4) * 72 + kk] = f2bf(bq[q].x); T[(n8 + 5) * 72 + kk] = f2bf(bq[q].y); T[(n8 + 6) * 72 + kk] = f2bf(bq[q].z); T[(n8 + 7) * 72 + kk] = f2bf(bq[q].w);
  }
  __syncthreads();
  {
    const int n = tid >> 3, k8 = (tid & 7) * 8;
#pragma unroll
    for (int q = 0; q < 4; ++q) {
      const uint4 v = *(const uint4*)((const u16*)(lds + q * 9216) + n * 72 + k8);
      const int ng = n0 + q * 64 + n, kg = k0 + k8;
      if (FRAG) {
        const size_t off = (((size_t)(ng >> 5) * (K >> 4) + (kg >> 4)) * 64 + ((kg >> 3) & 1) * 32 + (ng & 31)) * 8;
        *(uint4*)(dst + off) = v;
      } else *(uint4*)(dst + (size_t)ng * K + kg) = v;
    }
  }
  __syncthreads();
}
__device__ __forceinline__ void phase0(const Params& p, unsigned char* lds, int tid) {
  constexpr int PER_L = 224 + 320;
  const int ntask = DEPTH * PER_L + DEPTH * 4 + 288;
  for (int task = blockIdx.x; task < ntask; task += gridDim.x) {
    if (task >= DEPTH * PER_L + DEPTH * 4) {
      const int R0 = (task - (DEPTH * PER_L + DEPTH * 4)) * 64;
      const float* src = R0 < NPROMPT ? p.x_prompt + (size_t)R0 * DM : p.x_sample + (size_t)(R0 - NPROMPT) * DM;
      norm_rows_to_global(src, p.norm_mix_pre, (u16*)(p.ws + WS_H) + (size_t)R0 * DM, __builtin_amdgcn_readfirstlane(tid >> 6), tid & 63);
    } else if (task < DEPTH * PER_L) {
      const int l = task / PER_L, rr = task % PER_L;
      if (rr < 224) {
        const int kt = rr / 14, nt = rr % 14;
        convert_strip<false>(p.w_in + (size_t)l * DM * DIN, (u16*)(p.ws + WS_WIN) + (size_t)l * DIN * DM, DM, DIN, kt * 64, nt * 256, lds, tid);
      } else {
        const int m = (rr - 224) >> 6, tt = (rr - 224) & 63;
        const float* src = (m == 0 ? p.w_out : m == 1 ? p.w_xq : m == 2 ? p.w_xk : m == 3 ? p.w_xv : p.w_xo) + (size_t)l * DM * DM;
        convert_strip<true>(src, (u16*)(p.ws + WS_WSQ) + (size_t)(l * 5 + m) * DM * DM, DM, DM, (tt >> 2) * 64, (tt & 3) * 256, lds, tid);
      }
    } else {
      const int j = task - DEPTH * PER_L;
      convert_tile<false>(p.w_pool + (size_t)j * 4096, (u16*)(p.ws + WS_WPT) + (size_t)j * 4096, 64, 64, 0, 0, lds, tid);
    }
  }
  if (blockIdx.x == 0) {
    if (tid < 64) ((int*)(p.ws + WS_CTR))[tid] = 0;
    float* LB = (float*)(p.ws + WS_LB);
    for (int c = tid; c < 512; c += NTHREADS) {
      float a[DEPTH], mx = -3.0e38f;
      for (int l = 0; l < DEPTH; ++l) { a[l] = p.lb_logits[l * 512 + c]; mx = fmaxf(mx, a[l]); }
      float s = 0.f; for (int l = 0; l < DEPTH; ++l) { a[l] = expf(a[l] - mx); s += a[l]; }
      float cum = 0.f; const float first = a[0] / s;
      for (int l = 0; l < DEPTH; ++l) { cum += a[l] / s; const float lb = fmaxf(cum - first, 0.f); LB[l * 1024 + c] = lb > 0.f ? logf(lb) : -1e30f; LB[l * 1024 + 512 + c] = log1pf(-lb); }
    }
  }
}

__device__ __forceinline__ void memkv_task(const Params& p, int j, unsigned char* lds, int tid_) {
  const int tid = (int)opaque((unsigned)tid_);
  const int w = __builtin_amdgcn_readfirstlane(tid >> 6), lane = tid & 63, r = lane & 31, h = lane >> 5;
  const int l = j >> 3, mt8 = j & 7;
  load_norm_panel(p.mem_prompt + (size_t)mt8 * 64 * DM, p.norm_mem + l * DM, lds, w, lane);
  __syncthreads();
  for (int kv = 0; kv < 2; ++kv) {
    f32x16 acc[2][4];
    for (int a = 0; a < 2; ++a) for (int c = 0; c < 4; ++c) acc[a][c] = zero16();
    gemm_panel<4, 2>(lds, (const u16*)(p.ws + WS_WSQ) + (size_t)(l * 5 + 2 + kv) * DM * DM, w * 128, acc, lane);
    float* dst = p.out + (kv ? O_PMV : O_PMK) + ((size_t)l * 512 + mt8 * 64) * DM;
    const unsigned so = opaque((unsigned)((4 * h) * DM + w * 128 + r) * 4u);
#pragma unroll
    for (int mt = 0; mt < 2; ++mt)
#pragma unroll
      for (int nt = 0; nt < 4; ++nt)
#pragma unroll
        for (int i = 0; i < 16; ++i) { st_f32(dst, so + (unsigned)((mt * 32 + (i & 3) + 8 * (i >> 2)) * DM + nt * 32) * 4u, acc[mt][nt][i]); if ((i & 7) == 7) SBAR(); }
    {
      const int b = mt8 >> 2, hh = w >> 1;
      const int lq = (int)opaque((unsigned)lane), r = lq & 31, h = lq >> 5;
      u16* fb = (u16*)(p.ws + (kv ? WS_VF : WS_KF)) + (size_t)((l * 2 + b) * 4 + hh) * 8 * 16 * 512;
#pragma unroll
      for (int mt = 0; mt < 2; ++mt)
#pragma unroll
        for (int nt = 0; nt < 4; ++nt)
#pragma unroll
          for (int i = 0; i < 16; ++i) {
            const int m = (mt8 & 3) * 64 + mt * 32 + crow(i, h);
            const int d = (w & 1) * 128 + nt * 32 + r;
            unsigned off;
            if (!kv) off = (unsigned)((((m >> 5) * 16 + (d >> 4)) * 64 + 32 * ((d >> 3) & 1) + (m & 31)) * 8 + (d & 7));
            else off = (unsigned)((((d >> 5) * 16 + (m >> 4)) * 64 + 32 * ((m >> 3) & 1) + (d & 31)) * 8 + (m & 7));
            st_u16(fb, off * 2u, f2bf(acc[mt][nt][i]));
            if ((i & 7) == 7) SBAR();
          }
    }
  }
  __syncthreads();
}

__device__ __forceinline__ void kvconv_task(const Params& p, int l, int task, int tid) {
  const int b = task >> 4, kv = (task >> 3) & 1, sub = task & 7;
  const float* src = (kv ? p.cache_mem_v : p.cache_mem_k) + (size_t)(l * DEC_B + b) * 256 * 1024;
  u16* dst = (u16*)(p.ws + (kv ? WS_VFS : WS_KFS)) + (size_t)b * 4 * 8 * 16 * 512;
  if (!kv) {
#pragma unroll 1
    for (int it = sub * 8; it < sub * 8 + 8; it += 8) {
      float4 a[8], c[8];
#pragma unroll
      for (int q = 0; q < 8; ++q) { const int pc = (it + q) * NTHREADS + tid; const float* sp = src + (size_t)pc * 8; a[q] = *(const float4*)sp; c[q] = *(const float4*)(sp + 4); }
      SBAR();
#pragma unroll
      for (int q = 0; q < 8; ++q) {
        const int pc = (it + q) * NTHREADS + tid;
        const int m = pc >> 7, hh = (pc >> 5) & 3, d8 = pc & 31;
        const unsigned off = (unsigned)((((hh * 8 + (m >> 5)) * 16 + (d8 >> 1)) * 64 + 32 * (d8 & 1) + (m & 31)) * 8);
        uint4 o; o.x = pack2(a[q].x, a[q].y); o.y = pack2(a[q].z, a[q].w); o.z = pack2(c[q].x, c[q].y); o.w = pack2(c[q].z, c[q].w);
        *(uint4*)(dst + off) = o;
      }
    }
  } else {
#pragma unroll 1
    for (int it = sub * 8; it < sub * 8 + 8; it += 2) {
      float v[2][8];
#pragma unroll
      for (int q = 0; q < 2; ++q) {
        const int pc = (it + q) * NTHREADS + tid;
        const int m8 = pc >> 10, cc = pc & 1023;
#pragma unroll
        for (int j = 0; j < 8; ++j) v[q][j] = src[(size_t)(m8 * 8 + j) * 1024 + cc];
      }
      SBAR();
#pragma unroll
      for (int q = 0; q < 2; ++q) {
        const int pc = (it + q) * NTHREADS + tid;
        const int m8 = pc >> 10, hh = (pc >> 8) & 3, d = pc & 255;
        const unsigned off = (unsigned)((((hh * 8 + (d >> 5)) * 16 + (m8 >> 1)) * 64 + 32 * (m8 & 1) + (d & 31)) * 8);
        uint4 o; o.x = pack2(v[q][0], v[q][1]); o.y = pack2(v[q][2], v[q][3]); o.z = pack2(v[q][4], v[q][5]); o.w = pack2(v[q][6], v[q][7]);
        *(uint4*)(dst + off) = o;
      }
    }
  }
}

DI void hgrn_load_G(const float* __restrict__ GF, int R0, int hd, float (&g)[16], float (&G)[16], float& GL, float& Gm, float* qtot, int tid) {
  const int k = tid & 127, q4 = tid >> 7;
  float run = 0.f;
#pragma unroll
  for (int j = 0; j < 16; ++j) g[j] = GF[(size_t)(R0 + q4 * 16 + j) * 512 + hd * 128 + k];
  SBAR();
#pragma unroll
  for (int j = 0; j < 16; ++j) { run += g[j]; G[j] = run; }
  qtot[q4 * 128 + k] = run;
  __syncthreads();
  const float q0 = qtot[k], q1 = qtot[128 + k], q2 = qtot[256 + k], q3 = qtot[384 + k];
  const float off = (q4 > 0 ? q0 : 0.f) + (q4 > 1 ? q1 : 0.f) + (q4 > 2 ? q2 : 0.f);
#pragma unroll
  for (int j = 0; j < 16; ++j) G[j] += off;
  GL = q0 + q1 + q2 + q3; Gm = q0 + q1;
}
DI void chunk_rows(int task, int& R0, int& hd) {
  if (task < 1024) { const int sh = task >> 7, c = task & 127; R0 = (sh >> 2) * SEQ + c * 64; hd = sh & 3; }
  else { const int sh = task - 1024; R0 = NPROMPT + (sh >> 2) * 64; hd = sh & 3; }
}

__device__ __forceinline__ void hgrn_passA(const Params& p, int task, unsigned char* lds, int tid) {
  const int w = __builtin_amdgcn_readfirstlane(tid >> 6), lane = tid & 63, r = lane & 31, h = lane >> 5;
  float* qtot = (float*)lds;
  u16* KT = (u16*)(lds + 2048);
  u16* VT = (u16*)(lds + 2048 + 128 * 144);
  const u16* PROJ = (const u16*)(p.ws + WS_PROJ);
  int R0, hd; chunk_rows(task, R0, hd);
  const int k = tid & 127, q4 = tid >> 7;
  u16 vraw[16];
#pragma unroll
  for (int j = 0; j < 16; ++j) vraw[j] = PROJ[(size_t)(R0 + q4 * 16 + j) * DIN + C_AI + hd * 128 + k];
  float g[16], G[16], GL, Gm;
  hgrn_load_G((const float*)(p.ws + WS_GF), R0, hd, g, G, GL, Gm, qtot, tid);
#pragma unroll
  for (int j = 0; j < 16; ++j) {
    const int s = q4 * 16 + j;
    KT[k * 72 + s] = f2bf((1.f - __expf(g[j])) * __expf(GL - G[j]));
    VT[k * 72 + s] = vraw[j];
  }
  if (q4 == 0) ((float*)(p.ws + WS_DEC))[(size_t)task * 128 + k] = __expf(GL);
  __syncthreads();
  const int vt = w >> 1, kt0 = (w & 1) * 2;
  f32x16 acc[2]; acc[0] = zero16(); acc[1] = zero16();
#pragma unroll
  for (int ss = 0; ss < 4; ++ss) {
    const bf16x8 a = *(const bf16x8*)(VT + (vt * 32 + r) * 72 + 16 * ss + 8 * h);
#pragma unroll
    for (int q = 0; q < 2; ++q) {
      const bf16x8 bb = *(const bf16x8*)(KT + ((kt0 + q) * 32 + r) * 72 + 16 * ss + 8 * h);
      acc[q] = MFMA32(a, bb, acc[q]);
    }
  }
  float* DS = (float*)(p.ws + WS_DS) + (size_t)task * 16384;
#pragma unroll
  for (int q = 0; q < 2; ++q)
#pragma unroll
    for (int i = 0; i < 16; ++i) DS[(vt * 32 + crow(i, h)) * 128 + (kt0 + q) * 32 + r] = acc[q][i];
  __syncthreads();
}

__device__ __forceinline__ void hgrn_scan_unit(const Params& p, int l, int unit, unsigned char* lds, int tid) {
  float* tmp = (float*)lds;
  const float* DS = (const float*)(p.ws + WS_DS);
  const float* DEC = (const float*)(p.ws + WS_DEC);
  u16* SPT = (u16*)(p.ws + WS_SPT);
  if (unit < 128) {
    const int sh = unit >> 4, v0 = (unit & 15) * 8;
    const int v = tid >> 6, k2 = (tid & 63) * 2;
    const int ka = tid >> 2, va = (tid & 3) * 2;
    float s0 = 0.f, s1 = 0.f;
    const unsigned eoff = (unsigned)((v0 + v) * 128 + k2);
    const float* dsb = DS + (size_t)(sh * 128) * 16384;
    const float* dcb = DEC + (size_t)(sh * 128) * 128;
    u16* spb = SPT + (size_t)(sh * 128) * 16384;
#pragma unroll 1
    for (int c0 = 0; c0 < 128; c0 += 16) {
      float2 d[16], dc[16];
#pragma unroll
      for (int j = 0; j < 16; ++j) { d[j] = *(const float2*)(dsb + (size_t)(c0 + j) * 16384 + eoff); dc[j] = *(const float2*)(dcb + (c0 + j) * 128 + k2); }
      SBAR();
#pragma unroll
      for (int j = 0; j < 16; ++j) {
        *(unsigned*)(spb + (size_t)(c0 + j) * 16384 + eoff) = pack2(s0, s1);
        s0 = dc[j].x * s0 + d[j].x; s1 = dc[j].y * s1 + d[j].y;
      }
    }
    tmp[v * 130 + k2] = s0; tmp[v * 130 + k2 + 1] = s1;
    __syncthreads();
    float2 o; o.x = tmp[va * 130 + ka]; o.y = tmp[(va + 1) * 130 + ka];
    *(float2*)(p.out + O_PHS + ((size_t)l * 8 + sh) * 16384 + (size_t)ka * 128 + v0 + va) = o;
    __syncthreads();
  } else {
    const int u = unit - 128, ss = u >> 2, v0 = (u & 3) * 32;
    const int task = 1024 + ss;
    const int ka = tid >> 2, va = (tid & 3) * 8;
    const int v = tid >> 4, k8 = (tid & 15) * 8;
    const float* st = p.state_hgrn + ((size_t)l * 128 + ss) * 16384 + (size_t)ka * 128 + v0 + va;
    const float4 x0 = *(const float4*)st, x1 = *(const float4*)(st + 4);
    const float* dp = DS + (size_t)task * 16384 + (size_t)(v0 + v) * 128 + k8;
    const float4 d0 = *(const float4*)dp, d1 = *(const float4*)(dp + 4);
    const float* cp = DEC + (size_t)task * 128 + k8;
    const float4 c0 = *(const float4*)cp, c1 = *(const float4*)(cp + 4);
    SBAR();
    tmp[(va + 0) * 129 + ka] = x0.x; tmp[(va + 1) * 129 + ka] = x0.y; tmp[(va + 2) * 129 + ka] = x0.z; tmp[(va + 3) * 129 + ka] = x0.w;
    tmp[(va + 4) * 129 + ka] = x1.x; tmp[(va + 5) * 129 + ka] = x1.y; tmp[(va + 6) * 129 + ka] = x1.z; tmp[(va + 7) * 129 + ka] = x1.w;
    __syncthreads();
    float sv[8];
#pragma unroll
    for (int j = 0; j < 8; ++j) sv[j] = tmp[v * 129 + k8 + j];
    uint4 pk; pk.x = pack2(sv[0], sv[1]); pk.y = pack2(sv[2], sv[3]); pk.z = pack2(sv[4], sv[5]); pk.w = pack2(sv[6], sv[7]);
    *(uint4*)(SPT + (size_t)task * 16384 + (size_t)(v0 + v) * 128 + k8) = pk;
    __syncthreads();
    tmp[v * 129 + k8 + 0] = c0.x * sv[0] + d0.x; tmp[v * 129 + k8 + 1] = c0.y * sv[1] + d0.y; tmp[v * 129 + k8 + 2] = c0.z * sv[2] + d0.z; tmp[v * 129 + k8 + 3] = c0.w * sv[3] + d0.w;
    tmp[v * 129 + k8 + 4] = c1.x * sv[4] + d1.x; tmp[v * 129 + k8 + 5] = c1.y * sv[5] + d1.y; tmp[v * 129 + k8 + 6] = c1.z * sv[6] + d1.z; tmp[v * 129 + k8 + 7] = c1.w * sv[7] + d1.w;
    __syncthreads();
    float4 o0, o1;
    o0.x = tmp[(va + 0) * 129 + ka]; o0.y = tmp[(va + 1) * 129 + ka]; o0.z = tmp[(va + 2) * 129 + ka]; o0.w = tmp[(va + 3) * 129 + ka];
    o1.x = tmp[(va + 4) * 129 + ka]; o1.y = tmp[(va + 5) * 129 + ka]; o1.z = tmp[(va + 6) * 129 + ka]; o1.w = tmp[(va + 7) * 129 + ka];
    float* fp = p.out + O_SHS + ((size_t)l * 128 + ss) * 16384 + (size_t)ka * 128 + v0 + va;
    *(float4*)fp = o0; *(float4*)(fp + 4) = o1;
    __syncthreads();
  }
}

__device__ __forceinline__ void hgrn_passC(const Params& p, int l, int task, unsigned char* lds, int tid) {
  const int w = __builtin_amdgcn_readfirstlane(tid >> 6), lane = tid & 63, r = lane & 31, h = lane >> 5;
  float* qtot = (float*)lds;
  u16* Qm = (u16*)(lds + 2048);
  u16* Km = (u16*)(lds + 2048 + 17408);
  u16* QS = (u16*)(lds + 2048 + 2 * 17408);
  u16* VT = (u16*)(lds + 2048 + 3 * 17408);
  u16* ATT = (u16*)(lds + 2048 + 3 * 17408 + 18432);
  float* psum = (float*)(lds + 2048 + 3 * 17408 + 18432 + 9216);
  const u16* PROJ = (const u16*)(p.ws + WS_PROJ);
  int R0, hd; chunk_rows(task, R0, hd);
  bf16x8 spf[8];
  {
    const u16* SPp = (const u16*)(p.ws + WS_SPT) + (size_t)task * 16384 + (size_t)((w & 3) * 32 + r) * 128 + 8 * h;
#pragma unroll
    for (int sk = 0; sk < 8; ++sk) spf[sk] = *(const bf16x8*)(SPp + 16 * sk);
  }
  const float og = p.onorm_g[l * 512 + hd * 128 + (w & 3) * 32 + r];
  u16 graw[16];
#pragma unroll
  for (int i = 0; i < 16; ++i) graw[i] = PROJ[(size_t)(R0 + (w >> 2) * 32 + crow(i, h)) * DIN + C_AG + hd * 128 + (w & 3) * 32 + r];
  u16 qraw[16], vraw[16];
  {
    const int k = tid & 127, q4 = tid >> 7;
#pragma unroll
    for (int j = 0; j < 16; ++j) { qraw[j] = PROJ[(size_t)(R0 + q4 * 16 + j) * DIN + C_AQ + hd * 128 + k]; vraw[j] = PROJ[(size_t)(R0 + q4 * 16 + j) * DIN + C_AI + hd * 128 + k]; }
  }
  float g[16], G[16], GL, Gm;
  hgrn_load_G((const float*)(p.ws + WS_GF), R0, hd, g, G, GL, Gm, qtot, tid);
  {
    const int k = tid & 127, q4 = tid >> 7;
#pragma unroll
    for (int j = 0; j < 16; ++j) {
      const int s = q4 * 16 + j;
      const float q = bf2f(qraw[j]);
      const float d1 = fminf(fmaxf(G[j] - Gm, -80.f), 80.f);
      Qm[s * 136 + k] = f2bf(q * __expf(d1));
      Km[s * 136 + k] = f2bf((1.f - __expf(g[j])) * __expf(-d1));
      QS[s * 136 + k] = f2bf(q * __expf(G[j]));
      VT[k * 72 + s] = vraw[j];
    }
  }
  __syncthreads();
  if (w < 4) {
    const int tt = w >> 1, st = w & 1;
    f32x16 a = zero16();
    if (st <= tt) {
#pragma unroll
      for (int sk = 0; sk < 8; ++sk) {
        const bf16x8 fa = *(const bf16x8*)(Qm + (tt * 32 + r) * 136 + 16 * sk + 8 * h);
        const bf16x8 fb = *(const bf16x8*)(Km + (st * 32 + r) * 136 + 16 * sk + 8 * h);
        a = MFMA32(fa, fb, a);
      }
    }
    const int s = st * 32 + r;
#pragma unroll
    for (int i = 0; i < 16; ++i) {
      const int t = tt * 32 + crow(i, h);
      ATT[t * 72 + s] = (st <= tt && s <= t) ? f2bf(a[i]) : (u16)0;
    }
  }
  __syncthreads();
  const int tt = w >> 2, vt = w & 3;
  f32x16 o = zero16();
#pragma unroll
  for (int ss = 0; ss < 4; ++ss) {
    const bf16x8 fa = *(const bf16x8*)(ATT + (tt * 32 + r) * 72 + 16 * ss + 8 * h);
    const bf16x8 fb = *(const bf16x8*)(VT + (vt * 32 + r) * 72 + 16 * ss + 8 * h);
    o = MFMA32(fa, fb, o);
  }
#pragma unroll
  for (int sk = 0; sk < 8; ++sk) {
    const bf16x8 fa = *(const bf16x8*)(QS + (tt * 32 + r) * 136 + 16 * sk + 8 * h);
    o = MFMA32(fa, spf[sk], o);
  }
  {
    float v2[16];
#pragma unroll
    for (int i = 0; i < 16; ++i) v2[i] = o[i] * o[i];
    const float tsum = half_reduce_scatter16(v2, r);
    if ((r & 1) == 0) psum[vt * 64 + tt * 32 + crow(r >> 1, h)] = tsum;
  }
  __syncthreads();
  const int v = vt * 32 + r;
  u16* MIX = (u16*)(p.ws + WS_MIX);
#pragma unroll
  for (int i = 0; i < 16; ++i) {
    const int t = tt * 32 + crow(i, h);
    const float ssq = psum[t] + psum[64 + t] + psum[128 + t] + psum[192 + t];
    const float rstd = rsqrtf(ssq * (1.f / 128.f) + EPS);
    const size_t row = (size_t)(R0 + t);
    MIX[row * DM + hd * 128 + v] = f2bf(o[i] * rstd * og * bf2f(graw[i]));
  }
  __syncthreads();
}

__device__ __forceinline__ void sb_wave(const Params& p, int l, int grp, int b, int head, int q0, int lane) {
  const int r = lane & 31, h = lane >> 5;
  const u16* PROJ = (const u16*)(p.ws + WS_PROJ);
  const int Rbase = grp ? NPROMPT + b * 64 : b * SEQ;
  const int past = grp ? PAST : 0;
  const float* ck = p.cache_sb_k + (size_t)(l * DEC_B + b) * PAST * 256;
  const float* cv = p.cache_sb_v + (size_t)(l * DEC_B + b) * PAST * 256;
  bf16x8 qf[4];
#pragma unroll
  for (int s = 0; s < 4; ++s) qf[s] = *(const bf16x8*)(PROJ + (size_t)(Rbase + q0 + r) * DIN + C_BQ + head * 64 + 16 * s + 8 * h);
  const int qpos = past + q0 + r;
  float carry = 0.f;
  f32x16 O[2]; O[0] = zero16(); O[1] = zero16();
  const int T0 = (past + q0) >> 5;
  unsigned raw[64];
#define SB_ISSUE(T_) do { const int Tn_ = (T_); \
    if (Tn_ * 32 >= past) { \
      const u16* kp_ = PROJ + (size_t)(Rbase + Tn_ * 32 - past + r) * DIN + C_BK + head * 64 + 8 * h; \
      _Pragma("unroll") for (int s_ = 0; s_ < 4; ++s_) { const uint4 t_ = *(const uint4*)(kp_ + 16 * s_); raw[4 * s_] = t_.x; raw[4 * s_ + 1] = t_.y; raw[4 * s_ + 2] = t_.z; raw[4 * s_ + 3] = t_.w; } \
      const u16* vp_ = PROJ + (size_t)(Rbase + Tn_ * 32 - past + 4 * h) * DIN + C_BV + head * 64 + r; \
      _Pragma("unroll") for (int e_ = 0; e_ < 32; ++e_) raw[16 + e_] = vp_[(size_t)(16 * (e_ >> 4) + 8 * ((e_ >> 2) & 1) + (e_ & 3)) * DIN + ((e_ >> 3) & 1) * 32]; \
    } else { \
      const float* kp_ = ck + (size_t)(Tn_ * 32 + r) * 256 + head * 64 + 8 * h; \
      _Pragma("unroll") for (int s_ = 0; s_ < 8; ++s_) { const uint4 t_ = *(const uint4*)(kp_ + 16 * (s_ >> 1) + 4 * (s_ & 1)); raw[4 * s_] = t_.x; raw[4 * s_ + 1] = t_.y; raw[4 * s_ + 2] = t_.z; raw[4 * s_ + 3] = t_.w; } \
      const float* vp_ = cv + (size_t)(Tn_ * 32 + 4 * h) * 256 + head * 64 + r; \
      _Pragma("unroll") for (int e_ = 0; e_ < 32; ++e_) raw[32 + e_] = __float_as_uint(vp_[(size_t)(16 * (e_ >> 4) + 8 * ((e_ >> 2) & 1) + (e_ & 3)) * 256 + ((e_ >> 3) & 1) * 32]); \
    } } while (0)
  SB_ISSUE(T0);
  for (int T = T0; T >= 0; --T) {
    const bool isnew = T * 32 >= past;
    union { bf16x8 v; unsigned u[4]; } kf[4], vf[2][2];
    if (isnew) {
#pragma unroll
      for (int s = 0; s < 4; ++s)
#pragma unroll
        for (int j = 0; j < 4; ++j) kf[s].u[j] = raw[4 * s + j];
#pragma unroll
      for (int s = 0; s < 2; ++s)
#pragma unroll
        for (int dt = 0; dt < 2; ++dt)
#pragma unroll
          for (int j = 0; j < 4; ++j) vf[s][dt].u[j] = (raw[16 + s * 16 + dt * 8 + 2 * j] & 0xffffu) | (raw[16 + s * 16 + dt * 8 + 2 * j + 1] << 16);
    } else {
#pragma unroll
      for (int s = 0; s < 4; ++s)
#pragma unroll
        for (int j = 0; j < 4; ++j) kf[s].u[j] = pack2(__uint_as_float(raw[8 * s + 2 * j]), __uint_as_float(raw[8 * s + 2 * j + 1]));
#pragma unroll
      for (int s = 0; s < 2; ++s)
#pragma unroll
        for (int dt = 0; dt < 2; ++dt)
#pragma unroll
          for (int j = 0; j < 4; ++j) vf[s][dt].u[j] = pack2(__uint_as_float(raw[32 + s * 16 + dt * 8 + 2 * j]), __uint_as_float(raw[32 + s * 16 + dt * 8 + 2 * j + 1]));
    }
    if (T > 0) SB_ISSUE(T - 1);
    SBAR();
    f32x16 z = zero16();
#pragma unroll
    for (int s = 0; s < 4; ++s) z = MFMA32(kf[s].v, qf[s], z);
    float lsm[16]; bool msk[16];
#pragma unroll
    for (int i = 0; i < 16; ++i) {
      msk[i] = (T * 32 + crow(i, h)) < qpos;
      const float sp = fmaxf(z[i], 0.f) + __logf(1.f + __expf(-fabsf(z[i])));
      lsm[i] = msk[i] ? -sp : 0.f;
    }
    float town[4], toth[4];
#pragma unroll
    for (int g = 0; g < 4; ++g) {
      lsm[4 * g + 2] += lsm[4 * g + 3]; lsm[4 * g + 1] += lsm[4 * g + 2]; lsm[4 * g + 0] += lsm[4 * g + 1];
      town[g] = lsm[4 * g];
    }
#pragma unroll
    for (int g = 0; g < 4; ++g) toth[g] = __shfl_xor(town[g], 32);
    float spair = 0.f;
    float ag[4];
#pragma unroll
    for (int g = 3; g >= 0; --g) { ag[g] = spair + (h == 0 ? toth[g] : 0.f); spair += town[g] + toth[g]; }
    union { bf16x8 v; unsigned u[4]; } pf[2];
#pragma unroll
    for (int i = 0; i < 16; i += 2) {
      const float w0 = msk[i] ? __expf(z[i] + lsm[i] + ag[i >> 2] + carry) : 0.f;
      const float w1 = msk[i + 1] ? __expf(z[i + 1] + lsm[i + 1] + ag[i >> 2] + carry) : 0.f;
      pf[i >> 3].u[(i & 7) >> 1] = pack2(w0, w1);
    }
    carry += spair;
#pragma unroll
    for (int s = 0; s < 2; ++s)
#pragma unroll
      for (int dt = 0; dt < 2; ++dt) O[dt] = MFMA32(pf[s].v, vf[s][dt].v, O[dt]);
    if (__all(carry < -104.f)) break;
  }
#undef SB_ISSUE
  u16* MIX = (u16*)(p.ws + WS_MIX);
#pragma unroll
  for (int dt = 0; dt < 2; ++dt)
#pragma unroll
    for (int i = 0; i < 16; ++i) {
      const size_t row = (size_t)(Rbase + q0 + crow(i, h));
      const int d = head * 64 + dt * 32 + r;
      const float gate = bf2f(PROJ[row * DIN + C_BG + d]);
      MIX[row * DM + 512 + d] = f2bf(O[dt][i] * gate);
    }
}

__device__ __forceinline__ void pool_tile(const Params& p, int l, int R0, unsigned char* lds, int tid) {
  const int w = __builtin_amdgcn_readfirstlane(tid >> 6), lane = tid & 63, r = lane & 31, h = lane >> 5;
  float* E = (float*)lds;
  const int g = w >> 1, mt = w & 1;
  float psc[2];
#pragma unroll
  for (int nt = 0; nt < 2; ++nt) psc[nt] = p.pool_scale[l * 256 + g * 64 + nt * 32 + r];
  u16 pg[2][16];
#pragma unroll
  for (int nt = 0; nt < 2; ++nt)
#pragma unroll
    for (int i = 0; i < 16; ++i) pg[nt][i] = ((const u16*)(p.ws + WS_PROJ))[(size_t)(R0 + mt * 32 + crow(i, h)) * DIN + C_CG + g * 64 + nt * 32 + r];
  u16* D = (u16*)(lds + 79 * 1024);
  const u16* PROJ = (const u16*)(p.ws + WS_PROJ);
  const int grp = R0 >= NPROMPT;
  const int b = grp ? (R0 - NPROMPT) >> 6 : R0 >> 13;
  const int t0 = grp ? 0 : (R0 & (SEQ - 1));
  const int past = grp ? PAST : 0;
  {
    const int c4 = (tid & 63) * 4, rg = tid >> 6;
    uint2 raw[10];
#pragma unroll
    for (int q = 0; q < 10; ++q) {
      const int j = rg + 8 * q, t = t0 - 15 + j;
      raw[q] = make_uint2(0u, 0u);
      if (j < 79 && t >= 0) raw[q] = *(const uint2*)(PROJ + (size_t)(R0 - t0 + t) * DIN + C_CU + c4);
    }
    SBAR();
#pragma unroll
    for (int q = 0; q < 10; ++q) {
      const int j = rg + 8 * q, t = t0 - 15 + j;
      if (j < 79) {
        float4 v;
        if (t >= 0) { v.x = bf2f((u16)(raw[q].x & 0xffff)); v.y = bf2f((u16)(raw[q].x >> 16)); v.z = bf2f((u16)(raw[q].y & 0xffff)); v.w = bf2f((u16)(raw[q].y >> 16)); }
        else if (grp) v = *(const float4*)(p.state_pool + ((size_t)(l * DEC_B + b) * 15 + (15 + t)) * 256 + c4);
        else v = make_float4(0.f, 0.f, 0.f, 0.f);
        *(float4*)(E + j * 256 + c4) = v;
      }
    }
  }
  __syncthreads();
  for (int e = tid; e < 64 * 256; e += NTHREADS) {
    const int t = e >> 8, c = e & 255;
    const int wdw = 2 << (c >> 6);
    float s = 0.f;
    for (int j = 0; j < wdw; ++j) s += E[(15 + t - j) * 256 + c];
    const int pos = past + t0 + t;
    const float cnt = (float)min(pos + 1, wdw);
    D[t * 264 + c] = f2bf(s / cnt - E[(15 + t) * 256 + c]);
  }
  __syncthreads();
  const u16* WP = (const u16*)(p.ws + WS_WPT) + (size_t)(l * 4 + g) * 4096;
  f32x16 acc[2]; acc[0] = zero16(); acc[1] = zero16();
#pragma unroll
  for (int s = 0; s < 4; ++s) {
    const bf16x8 a = *(const bf16x8*)(D + (mt * 32 + r) * 264 + g * 64 + 16 * s + 8 * h);
#pragma unroll
    for (int nt = 0; nt < 2; ++nt) {
      const bf16x8 bb = *(const bf16x8*)(WP + (nt * 32 + r) * 64 + 16 * s + 8 * h);
      acc[nt] = MFMA32(a, bb, acc[nt]);
    }
  }
  u16* MIX = (u16*)(p.ws + WS_MIX);
#pragma unroll
  for (int nt = 0; nt < 2; ++nt) {
    const int d = g * 64 + nt * 32 + r;
    const float sc = psc[nt];
#pragma unroll
    for (int i = 0; i < 16; ++i) {
      const size_t row = (size_t)(R0 + mt * 32 + crow(i, h));
      MIX[row * DM + 768 + d] = f2bf(acc[nt][i] * sc * bf2f(pg[nt][i]));
    }
  }
  __syncthreads();
}

__device__ __forceinline__ void phase_mix1(const Params& p, int l, int grp, int* ctr, unsigned char* lds, int tid_) {
  const int nmk = (grp == 0 && l == 0) ? 16 : 0;
  const int nsb = grp ? 32 : 256, npl = grp ? 32 : 256, npa = grp ? 128 : 1024;
  const int ntask = nmk + nsb + npl + npa;
  for (;;) {
    const int task = next_task(ctr, lds, tid_);
    if (task >= ntask) break;
    const int tid = (int)opaque((unsigned)tid_);
    const int w = __builtin_amdgcn_readfirstlane(tid >> 6), lane = tid & 63;
    if (task < nmk) memkv_task(p, task, lds, tid);
    else if (task < nmk + nsb) {
      const int t = task - nmk;
      if (!grp) { const int b = t >> 7, rem = t & 127; sb_wave(p, l, 0, b, rem >> 5, (rem & 31) * 256 + w * 32, lane); }
      else { sb_wave(p, l, 1, t, w >> 1, (w & 1) * 32, lane); }
    } else if (task < nmk + nsb + npl) pool_tile(p, l, ((grp ? 256 : 0) + task - nmk - nsb) * 64, lds, tid);
    else hgrn_passA(p, (grp ? 1024 : 0) + task - nmk - nsb - npl, lds, tid);
  }
}

template <int MT>
__device__ __forceinline__ void chain_tile(const Params& p, int l, int R0, unsigned char* lds, int tid_) {
  const int tid = (int)opaque((unsigned)tid_);
  const int w = __builtin_amdgcn_readfirstlane(tid >> 6), lane = tid & 63, r = lane & 31, h = lane >> 5;
  unsigned char* panel = lds;
  float* red = (float*)(lds + LDS_RED); float* tot = (float*)(lds + LDS_TOT);
  float* rmax = (float*)(lds + LDS_RMAX); float* rsum = (float*)(lds + LDS_RSUM); float* linv = (float*)(lds + LDS_LINV);
  const int grp = R0 >= NPROMPT;
  const int b = grp ? (R0 - NPROMPT) >> 6 : R0 >> 13;
  const u16* WSQ = (const u16*)(p.ws + WS_WSQ) + (size_t)l * 5 * DM * DM;
  float* Y = p.out + O_Y;
  const float* xsrc = (l == 0) ? (grp ? p.x_sample - (size_t)NPROMPT * DM : p.x_prompt) : (const float*)Y;
  const unsigned yo_ = ((unsigned)(R0 + 4 * h) * (unsigned)DM + (unsigned)(w * 128 + r)) * 4u;
  {
    const u16* MIX = (const u16*)(p.ws + WS_MIX) + (size_t)R0 * DM;
#pragma unroll 1
    for (int jb = 0; jb < 8 * MT; jb += 8) {
      const unsigned e0 = (unsigned)(tid + jb * NTHREADS);
#define MIXOFF(j) (unsigned)((((e0 + (j) * NTHREADS) >> 7) * DM + ((e0 + (j) * NTHREADS) & 127) * 8) * 2)
#define PANOFF(j) (((e0 + (j) * NTHREADS) >> 7) * PITCH + ((e0 + (j) * NTHREADS) & 127) * 16)
      const uint4 t0 = *(const uint4*)((const char*)MIX + MIXOFF(0)), t1 = *(const uint4*)((const char*)MIX + MIXOFF(1)), t2 = *(const uint4*)((const char*)MIX + MIXOFF(2)), t3 = *(const uint4*)((const char*)MIX + MIXOFF(3));
      const uint4 t4 = *(const uint4*)((const char*)MIX + MIXOFF(4)), t5 = *(const uint4*)((const char*)MIX + MIXOFF(5)), t6 = *(const uint4*)((const char*)MIX + MIXOFF(6)), t7 = *(const uint4*)((const char*)MIX + MIXOFF(7));
      SBAR();
      *(uint4*)(panel + PANOFF(0)) = t0; *(uint4*)(panel + PANOFF(1)) = t1; *(uint4*)(panel + PANOFF(2)) = t2; *(uint4*)(panel + PANOFF(3)) = t3;
      *(uint4*)(panel + PANOFF(4)) = t4; *(uint4*)(panel + PANOFF(5)) = t5; *(uint4*)(panel + PANOFF(6)) = t6; *(uint4*)(panel + PANOFF(7)) = t7;
    }
  }
  __syncthreads();
  f32x16 acc[MT][4];
#define ZACC() { _Pragma("unroll") for (int a_ = 0; a_ < MT; ++a_) _Pragma("unroll") for (int c_ = 0; c_ < 4; ++c_) acc[a_][c_] = zero16(); }
  ZACC();
  gemm_panel<4, MT>(panel, WSQ + (size_t)0 * DM * DM, w * 128, acc, lane);
  row_rstd<MT>(acc, red, tot, w, lane, tid);
  {
    const float* npost = p.norm_mix_post + l * DM;
    const unsigned yo = opaque(yo_);
#pragma unroll
    for (int nt = 0; nt < 4; ++nt) {
      const int col = w * 128 + nt * 32 + r; const float gn = npost[col];
      float xv[MT][16];
#pragma unroll
      for (int mt = 0; mt < MT; ++mt)
#pragma unroll
        for (int i = 0; i < 16; ++i) xv[mt][i] = ld_f32(xsrc, yo + (unsigned)((mt * 32 + (i & 3) + 8 * (i >> 2)) * DM + nt * 32) * 4u);
      SBAR();
#pragma unroll
      for (int mt = 0; mt < MT; ++mt)
#pragma unroll
        for (int i = 0; i < 16; ++i) {
          const unsigned bo = yo + (unsigned)((mt * 32 + (i & 3) + 8 * (i >> 2)) * DM + nt * 32) * 4u;
          const float x1 = xv[mt][i] + acc[mt][nt][i] * tot[4 * h + mt * 32 + (i & 3) + 8 * (i >> 2)] * gn;
          acc[mt][nt][i] = x1; st_f32(Y, bo, x1);
        }
      SBAR();
    }
  }
  row_rstd<MT>(acc, red, tot, w, lane, tid);
  {
    const float* g2 = p.norm_x_pre + l * DM;
    const unsigned pwo = opaque((unsigned)(4 * h * PITCH + (w * 128 + r) * 2));
#pragma unroll
    for (int nt = 0; nt < 4; ++nt) {
      const int col = w * 128 + nt * 32 + r; const float gn = g2[col];
#pragma unroll
      for (int mt = 0; mt < MT; ++mt)
#pragma unroll
        for (int i = 0; i < 16; ++i)
          *(u16*)(panel + pwo + (mt * 32 + (i & 3) + 8 * (i >> 2)) * PITCH + nt * 64) = f2bf(acc[mt][nt][i] * tot[4 * h + mt * 32 + (i & 3) + 8 * (i >> 2)] * gn);
    }
  }
  __syncthreads();
  ZACC();
  gemm_panel<4, MT>(panel, WSQ + (size_t)1 * DM * DM, w * 128, acc, lane);
  __syncthreads();
  { const unsigned pwo = opaque((unsigned)(4 * h * PITCH + (w * 128 + r) * 2));
#pragma unroll
  for (int nt = 0; nt < 4; ++nt) {
    const int col = w * 128 + nt * 32 + r; (void)col;
#pragma unroll
    for (int mt = 0; mt < MT; ++mt)
#pragma unroll
      for (int i = 0; i < 16; ++i)
        *(u16*)(panel + pwo + (mt * 32 + (i & 3) + 8 * (i >> 2)) * PITCH + nt * 64) = f2bf(acc[mt][nt][i] * 0.0625f);
  } }
  __syncthreads();
  {
#pragma unroll 1
    for (int hh = 0; hh < 4; ++hh) {
      f32x16 st[MT]; st[0] = zero16(); st[MT - 1] = zero16();
      bf16x8 kfr[16], vfr[16];
      {
        const u16* kfp = (MT == 2 ? (const u16*)(p.ws + WS_KF) + (size_t)((((l * 2 + b) * 4 + hh) * 8 + w) * 16) * 512
                                  : (const u16*)(p.ws + WS_KFS) + (size_t)(((b * 4 + hh) * 8 + w) * 16) * 512) + lane * 8;
        const u16* vfp = (MT == 2 ? (const u16*)(p.ws + WS_VF) + (size_t)((((l * 2 + b) * 4 + hh) * 8 + w) * 16) * 512
                                  : (const u16*)(p.ws + WS_VFS) + (size_t)(((b * 4 + hh) * 8 + w) * 16) * 512) + lane * 8;
#pragma unroll
        for (int ks = 0; ks < 16; ++ks) kfr[ks] = *(const bf16x8*)(kfp + ks * 512);
#pragma unroll
        for (int ks = 0; ks < 16; ++ks) vfr[ks] = *(const bf16x8*)(vfp + ks * 512);
        SBAR();
      }
#pragma unroll
      for (int ks = 0; ks < 16; ++ks) {
#pragma unroll
        for (int nt = 0; nt < MT; ++nt) {
          const bf16x8 bq = *(const bf16x8*)(panel + (nt * 32 + r) * PITCH + (hh * 256 + 16 * ks + 8 * h) * 2);
          st[nt] = MFMA32(kfr[ks], bq, st[nt]);
        }
      }
#pragma unroll
      for (int nt = 0; nt < MT; ++nt) {
        float m = st[nt][0];
#pragma unroll
        for (int i = 1; i < 16; ++i) m = fmaxf(m, st[nt][i]);
        m = fmaxf(m, __shfl_xor(m, 32));
        if (h == 0) rmax[w * 64 + nt * 32 + r] = m;
      }
      __syncthreads();
#pragma unroll
      for (int nt = 0; nt < MT; ++nt) {
        float gm = rmax[nt * 32 + r];
#pragma unroll
        for (int ww = 1; ww < 8; ++ww) gm = fmaxf(gm, rmax[ww * 64 + nt * 32 + r]);
        float sum = 0.f;
#pragma unroll
        for (int i = 0; i < 16; ++i) { const float pv = __expf(st[nt][i] - gm); st[nt][i] = pv; sum += pv; }
        sum += __shfl_xor(sum, 32);
        if (h == 0) rsum[w * 64 + nt * 32 + r] = sum;
#pragma unroll
        for (int g = 0; g < 4; ++g) {
          uint2 o; o.x = pack2(st[nt][4 * g], st[nt][4 * g + 1]); o.y = pack2(st[nt][4 * g + 2], st[nt][4 * g + 3]);
          *(uint2*)(panel + (nt * 32 + r) * PITCH + (hh * 256 + w * 32 + 8 * g + 4 * h) * 2) = o;
        }
      }
      __syncthreads();
      if (tid < 64) { float s = 0.f; for (int ww = 0; ww < 8; ++ww) s += rsum[ww * 64 + tid]; linv[tid] = 1.f / s; }
      f32x16 o2[MT]; o2[0] = zero16(); o2[MT - 1] = zero16();
#pragma unroll
      for (int s = 0; s < 16; ++s) {
#pragma unroll
        for (int mt = 0; mt < MT; ++mt) {
          const bf16x8 a = *(const bf16x8*)(panel + (mt * 32 + r) * PITCH + (hh * 256 + 16 * s + 8 * h) * 2);
          o2[mt] = MFMA32(a, vfr[s], o2[mt]);
        }
      }
      __syncthreads();
#pragma unroll
      for (int mt = 0; mt < MT; ++mt)
#pragma unroll
        for (int i = 0; i < 16; ++i) {
          const int q = mt * 32 + crow(i, h);
          *(u16*)(panel + q * PITCH + (hh * 256 + w * 32 + r) * 2) = f2bf(o2[mt][i] * linv[q]);
        }
    }
  }
  __syncthreads();
  ZACC();
  gemm_panel<4, MT>(panel, WSQ + (size_t)4 * DM * DM, w * 128, acc, lane);
  row_rstd<MT>(acc, red, tot, w, lane, tid);
  {
    const float* g3 = p.norm_x_post + l * DM;
    const unsigned yo = opaque(yo_);
#pragma unroll
    for (int nt = 0; nt < 4; ++nt) {
      const int col = w * 128 + nt * 32 + r; const float gn = g3[col];
      float xv[MT][16];
#pragma unroll
      for (int mt = 0; mt < MT; ++mt)
#pragma unroll
        for (int i = 0; i < 16; ++i) xv[mt][i] = ld_f32(Y, yo + (unsigned)((mt * 32 + (i & 3) + 8 * (i >> 2)) * DM + nt * 32) * 4u);
      SBAR();
#pragma unroll
      for (int mt = 0; mt < MT; ++mt)
#pragma unroll
        for (int i = 0; i < 16; ++i) {
          const unsigned bo = yo + (unsigned)((mt * 32 + (i & 3) + 8 * (i >> 2)) * DM + nt * 32) * 4u;
          const float x2 = xv[mt][i] + acc[mt][nt][i] * tot[4 * h + mt * 32 + (i & 3) + 8 * (i >> 2)] * gn;
          acc[mt][nt][i] = x2; st_f32(Y, bo, x2);
        }
      SBAR();
    }
  }
  if (l + 1 < DEPTH) {
    row_rstd<MT>(acc, red, tot, w, lane, tid);
    const float* g4 = p.norm_mix_pre + (l + 1) * DM;
    const unsigned pwo = opaque((unsigned)(4 * h * PITCH + (w * 128 + r) * 2));
#pragma unroll
    for (int nt = 0; nt < 4; ++nt) {
      const int col = w * 128 + nt * 32 + r; const float gn = g4[col];
#pragma unroll
      for (int mt = 0; mt < MT; ++mt)
#pragma unroll
        for (int i = 0; i < 16; ++i)
          *(u16*)(panel + pwo + (mt * 32 + (i & 3) + 8 * (i >> 2)) * PITCH + nt * 64) = f2bf(acc[mt][nt][i] * tot[4 * h + mt * 32 + (i & 3) + 8 * (i >> 2)] * gn);
    }
    __syncthreads();
    {
      u16* H = (u16*)(p.ws + WS_H) + (size_t)R0 * DM;
#pragma unroll 1
      for (int jb = 0; jb < 8 * MT; jb += 8) {
        const unsigned e0 = (unsigned)(tid + jb * NTHREADS);
        const uint4 t0 = *(const uint4*)(panel + PANOFF(0)), t1 = *(const uint4*)(panel + PANOFF(1)), t2 = *(const uint4*)(panel + PANOFF(2)), t3 = *(const uint4*)(panel + PANOFF(3));
        const uint4 t4 = *(const uint4*)(panel + PANOFF(4)), t5 = *(const uint4*)(panel + PANOFF(5)), t6 = *(const uint4*)(panel + PANOFF(6)), t7 = *(const uint4*)(panel + PANOFF(7));
        *(uint4*)((char*)H + MIXOFF(0)) = t0; *(uint4*)((char*)H + MIXOFF(1)) = t1; *(uint4*)((char*)H + MIXOFF(2)) = t2; *(uint4*)((char*)H + MIXOFF(3)) = t3;
        *(uint4*)((char*)H + MIXOFF(4)) = t4; *(uint4*)((char*)H + MIXOFF(5)) = t5; *(uint4*)((char*)H + MIXOFF(6)) = t6; *(uint4*)((char*)H + MIXOFF(7)) = t7;
      }
    }
  }
  __syncthreads();
#undef ZACC
}

__global__ void __launch_bounds__(NTHREADS) hybrid_fwd(Params p) {
  extern __shared__ __attribute__((aligned(16))) unsigned char lds[];
  cg::grid_group grid = cg::this_grid();
  if (threadIdx.x < 4) ((unsigned*)(lds + LDS_XB))[threadIdx.x] = 0u;
  __syncthreads();
  const XcdBarrier xbar = xcd_barrier_post((unsigned*)(p.ws + WS_XB), (volatile LAS unsigned*)(lds + LDS_XB));
  const int wave_s = __builtin_amdgcn_readfirstlane((int)(threadIdx.x >> 6));
  unsigned tid_c = threadIdx.x;
  grid.sync();
  phase0(p, lds, (int)tid_c);
  xcd_barrier(xbar);
  for (int ph = 1; ph < p.ph_hi; ++ph) {
    {
      const int st_s = ph - 1, st_p = ph - 1 - SAMPLE_LEAD;
      const bool has_s = st_s >= 0 && st_s < 5 * DEPTH, has_p = st_p >= 0 && st_p < 5 * DEPTH;
      const int sub_s = st_s % 5;
      const bool s_first = has_s && (sub_s == 0 || sub_s == 4);
#pragma unroll 1
      for (int pass = 0; pass < 2; ++pass) {
        tid_c = (unsigned)(wave_s * 64) + __builtin_amdgcn_mbcnt_hi(~0u, __builtin_amdgcn_mbcnt_lo(~0u, 0u));
        asm volatile("" : "+v"(tid_c));
        const int tid = (int)tid_c;
        const int grp = (pass == 0) == s_first ? 1 : 0;
        if (grp ? !has_s : !has_p) continue;
        const int st = grp ? st_s : st_p, l = st / 5, sub = st % 5;
        int* ctr = (int*)(p.ws + WS_CTR) + ph * 2 + grp;
        if (sub == 0) {
          const int rbase = grp ? NPROMPT : 0, M = grp ? NROWS - NPROMPT : NPROMPT;
          pg8::Gemm g{(const pg8::bf16_t*)(p.ws + WS_H) + (size_t)rbase * DM, (const pg8::bf16_t*)(p.ws + WS_WIN) + (size_t)l * DIN * DM, M, DIN, DM};
          const bool share = (grp == 0) && has_s && sub_s == 4 && gridDim.x > 128;
          pg8::StaticOrder S;
          if (share) S.init(M, DIN, (int)gridDim.x - 64, (int)blockIdx.x >= 64 ? (int)blockIdx.x - 64 : (1 << 28));
          else S.init(M, DIN, (int)gridDim.x, (int)blockIdx.x);
          pg8::EpiWin E{(pg8::bf16_t*)(p.ws + WS_PROJ), (float*)(p.ws + WS_GF), p.out, (const float*)(p.ws + WS_LB) + l * 1024, l, rbase};
          pg8::gemm_phase<pg8::EpiWin, pg8::StaticOrder, false>((PG8_LAS unsigned char*)lds, g, S, E, nullptr, tid);
        }
        else if (sub == 1) phase_mix1(p, l, grp, ctr, lds, tid);
        else if (sub == 2) { const int u0 = grp ? 128 : 0, nu = grp ? 512 : 128; for (;;) { const int u = next_task(ctr, lds, tid); if (u >= nu) break; hgrn_scan_unit(p, l, u0 + u, lds, tid); } }
        else if (sub == 3) { const int t0 = grp ? 1024 : 0, nt = grp ? 128 : 1024; for (;;) { const int t = next_task(ctr, lds, tid); if (t >= nt) break; hgrn_passC(p, l, t0 + t, lds, tid); } }
        else if (!grp) { for (int t = blockIdx.x; t < 256; t += gridDim.x) chain_tile<2>(p, l, t * 64, lds, tid); }
        else { for (int t = blockIdx.x; t < 64; t += gridDim.x) chain_tile<1>(p, l, NPROMPT + t * 32, lds, tid); }
      }
    }
    if (ph == 1 || ph == 6) {
      int* ctr = (int*)(p.ws + WS_CTR) + 40 + (ph == 6);
      tid_c = (unsigned)(wave_s * 64) + __builtin_amdgcn_mbcnt_hi(~0u, __builtin_amdgcn_mbcnt_lo(~0u, 0u));
      asm volatile("" : "+v"(tid_c));
      const int tid = (int)tid_c;
      for (;;) { const int t = next_task(ctr, lds, tid); if (t >= 16 * DEC_B) break; kvconv_task(p, ph == 6, t, tid); }
    }
    if (ph + 1 < p.ph_hi) xcd_barrier(xbar);
  }
}

extern "C" void kernel_launch(void* const* d_in, const int* in_sizes, int n_in, void* d_out, int out_size, void* d_ws, size_t ws_size, hipStream_t stream) {
  static int grid_blocks = 0;
  if (!grid_blocks) {
    int dev = 0, cus = 0, per_cu = 0;
    hipGetDevice(&dev);
    hipDeviceGetAttribute(&cus, hipDeviceAttributeMultiprocessorCount, dev);
    hipFuncSetAttribute((const void*)hybrid_fwd, hipFuncAttributeMaxDynamicSharedMemorySize, LDS_BYTES);
    hipOccupancyMaxActiveBlocksPerMultiprocessor(&per_cu, (const void*)hybrid_fwd, NTHREADS, LDS_BYTES);
    if (per_cu < 1) { fprintf(stderr, "occupancy query returned %d\n", per_cu); per_cu = 1; }
    grid_blocks = cus * per_cu;
    if (ws_size < WS_END) fprintf(stderr, "workspace too small: %zu < %zu\n", ws_size, (size_t)WS_END);
  }
  Params p{};
  const float* const* in = (const float* const*)d_in;
  p.x_prompt = in[0]; p.x_sample = in[1]; p.mem_prompt = in[2]; p.cache_sb_k = in[3]; p.cache_sb_v = in[4];
  p.state_hgrn = in[5]; p.state_pool = in[6]; p.cache_mem_k = in[7]; p.cache_mem_v = in[8];
  p.norm_mix_pre = in[9]; p.norm_mix_post = in[10]; p.w_in = in[11]; p.lb_logits = in[12]; p.onorm_g = in[13];
  p.w_pool = in[14]; p.pool_scale = in[15]; p.w_out = in[16]; p.norm_x_pre = in[17]; p.norm_x_post = in[18];
  p.norm_mem = in[19]; p.w_xq = in[20]; p.w_xk = in[21]; p.w_xv = in[22]; p.w_xo = in[23];
  p.out = (float*)d_out; p.ws = (unsigned char*)d_ws;
  const int NPH = 1 + 5 * DEPTH + SAMPLE_LEAD;
  p.ph_lo = 0; p.ph_hi = NPH;
  (void)hipMemsetAsync((unsigned char*)d_ws + WS_XB, 0, XCD_BAR_WORDS * 4, stream);
  void* args[] = {&p};
  hipError_t e = hipLaunchCooperativeKernel((const void*)hybrid_fwd, dim3(grid_blocks), dim3(NTHREADS), args, LDS_BYTES, stream);
  if (e != hipSuccess) fprintf(stderr, "cooperative launch failed: %s (grid %d)\n", hipGetErrorString(e), grid_blocks);
}
```
